# Optimizing an MI355X kernel written in HIP

```python
import jax, jax.numpy as jnp
from jax import lax
import numpy as np

D_MODEL = 1024
BATCH = 16
SEQ = 256
DEPTH = 4
DEC_BATCH = 2
DEC_SEQ = 1024
PAST_LEN = 256

GRID_W = 64
N_MIXERS = 4
N_MOD = 6
D_FF = 4 * D_MODEL
EPS = 1e-6
FFT_GROUPS = 8
RWKV_HS = 64
RWKV_H = D_MODEL // RWKV_HS
LORA_W = 64
LORA_A = 64
LORA_G = 128
GN_EPS = 64e-5
MLA_H = 8
D_NOPE = 128
D_ROPE = 64
D_V = 128
KV_RANK = 256
Q_RANK = 384
ROPE_BASE = 10000.0
MLA_SCALE = (D_NOPE + D_ROPE) ** -0.5
N_FFT_LAYERS = (DEPTH + 3) // 4
N_CONV_LAYERS = (DEPTH + 2) // 4
N_RWKV_LAYERS = (DEPTH + 1) // 4
N_MLA_LAYERS = DEPTH // 4

kernel_name = "hybrid_fourier_conv_rwkv7_mla_diffusion_step"


def rmsnorm(x, g):
    xf = x.astype(jnp.float32)
    y = xf * lax.rsqrt(jnp.mean(xf * xf, axis=-1, keepdims=True) + EPS)
    return (y * g).astype(x.dtype)


def modulation(cvec, w, b):
    m = jax.nn.silu(cvec) @ w + b
    return jnp.split(m[:, None, :], N_MOD, axis=-1)


def shift_neighbours(x):
    xp = jnp.pad(x, ((0, 0), (1, 1), (0, 0)))
    return xp[:, :-2], xp[:, 2:]


def fourier_mix(x, w_out):
    b, n, d = x.shape
    xg = x.astype(jnp.float32).reshape(b, n, FFT_GROUPS, d // FFT_GROUPS)
    f = jnp.fft.fft2(xg, axes=(1, 3), norm="ortho").real
    return f.reshape(b, n, d).astype(x.dtype) @ w_out


def short_conv_mix(x, w_in, w_conv, w_out):
    bg, cg, u = jnp.split(x @ w_in, 3, axis=-1)
    z = cg * u
    z_prev, z_next = shift_neighbours(z)
    conv = z_prev * w_conv[0] + z * w_conv[1] + z_next * w_conv[2]
    return (bg * conv) @ w_out


def wkv7_scan(s0, r, w, k, v, kk, a, reverse):
    def step(s, inp):
        rt, wt, kt, vt, kkt, at = inp
        sa = jnp.einsum('bhvk,bhk->bhv', s, -kkt)
        s = s * wt[:, :, None, :] + sa[..., None] * (kkt * at)[:, :, None, :] + vt[..., None] * kt[:, :, None, :]
        return s, jnp.einsum('bhvk,bhk->bhv', s, rt)
    xs = tuple(jnp.moveaxis(t, 1, 0) for t in (r, w, k, v, kk, a))
    s_fin, ys = lax.scan(step, s0, xs, reverse=reverse)
    return s_fin, jnp.moveaxis(ys, 0, 1)


def rwkv7_mix(x, s_init, mu, w_r, w_k, w_v, w_o, w0, w_l1, w_l2, a0, a_l1, a_l2,
              g_l1, g_l2, k_k, k_a, r_k, ln_g, ln_b):
    b, n, d = x.shape
    x_prev, x_next = shift_neighbours(x)
    dx = 0.5 * (x_prev + x_next) - x
    xr, xw, xk, xv, xa, xg = [x + dx * mu[i] for i in range(6)]
    heads = lambda t: t.reshape(b, n, RWKV_H, RWKV_HS).astype(jnp.float32)
    r = heads(xr @ w_r)
    k = heads(xk @ w_k)
    v = heads(xv @ w_v)
    kk = k * k_k.reshape(RWKV_H, RWKV_HS).astype(jnp.float32)
    kk = kk * lax.rsqrt(jnp.sum(kk * kk, axis=-1, keepdims=True) + 1e-12)
    k_a_h = k_a.reshape(RWKV_H, RWKV_HS).astype(jnp.float32)
    r_k_f = r_k.astype(jnp.float32)
    g = jax.nn.sigmoid(xg @ g_l1) @ g_l2
    outs, bonuses, finals = [], [], []
    for dirn in range(2):
        logw = -jax.nn.softplus(-(w0[dirn] + jnp.tanh(xw @ w_l1[dirn]) @ w_l2[dirn])) - 0.5
        decay = heads(jnp.exp(-jnp.exp(logw.astype(jnp.float32))))
        a = heads(jax.nn.sigmoid(a0[dirn] + (xa @ a_l1[dirn]) @ a_l2[dirn]))
        k_eff = k * (1.0 + (a - 1.0) * k_a_h)
        s_fin, yd = wkv7_scan(s_init[:, dirn].astype(jnp.float32), r, decay, k_eff, v, kk, a, dirn == 1)
        outs.append(yd)
        bonuses.append(jnp.sum(r * k_eff * r_k_f, axis=-1, keepdims=True) * v)
        finals.append(s_fin)
    y = outs[0] + outs[1]
    mean = jnp.mean(y, axis=-1, keepdims=True)
    var = jnp.mean(jnp.square(y - mean), axis=-1, keepdims=True)
    y = ((y - mean) * lax.rsqrt(var + GN_EPS)).reshape(b, n, d) * ln_g + ln_b
    y = y + (bonuses[0] + bonuses[1]).reshape(b, n, d)
    out = (y.astype(x.dtype) * g) @ w_o
    return out, jnp.stack(finals, axis=1)


def rope_2d(x):
    n = x.shape[1]
    rows = n // GRID_W
    row = jnp.repeat(jnp.arange(rows), GRID_W)
    col = jnp.tile(jnp.arange(GRID_W), rows)
    pos = jnp.stack([row, col], axis=-1).astype(jnp.float32)
    quarter = D_ROPE // 4
    inv = ROPE_BASE ** (-jnp.arange(quarter, dtype=jnp.float32) / quarter)
    ang = pos[:, :, None] * inv
    cos = jnp.cos(ang)[:, None]
    sin = jnp.sin(ang)[:, None]
    xr = x.astype(jnp.float32).reshape(x.shape[:-1] + (2, 2, quarter))
    x1, x2 = xr[..., 0, :], xr[..., 1, :]
    out = jnp.stack([x1 * cos - x2 * sin, x1 * sin + x2 * cos], axis=-2)
    return out.reshape(x.shape).astype(x.dtype)


def mla_queries(x, w_dq, g_q, w_uq, positional):
    b, n, _ = x.shape
    q = (rmsnorm(x @ w_dq, g_q) @ w_uq).reshape(b, n, MLA_H, D_NOPE + D_ROPE)
    q_nope, q_rope = q[..., :D_NOPE], q[..., D_NOPE:]
    if positional:
        q_rope = rope_2d(q_rope)
    return q_nope, q_rope


def mla_compress(x, w_dkv, g_kv, positional):
    ckr = x @ w_dkv
    ckv = rmsnorm(ckr[..., :KV_RANK], g_kv)
    k_rope = ckr[..., KV_RANK:]
    if positional:
        k_rope = rope_2d(k_rope[:, :, None, :])[:, :, 0, :]
    return ckv, k_rope


def mla_attend(q_nope, q_rope, ckv, k_rope, w_uk, w_uv, w_o):
    b, nk, _ = ckv.shape
    k_nope = (ckv @ w_uk).reshape(b, nk, MLA_H, D_NOPE)
    v = (ckv @ w_uv).reshape(b, nk, MLA_H, D_V)
    s = (jnp.einsum('bqhd,bkhd->bhqk', q_nope, k_nope)
         + jnp.einsum('bqhr,bkr->bhqk', q_rope, k_rope)).astype(jnp.float32) * MLA_SCALE
    p = jax.nn.softmax(s, axis=-1).astype(v.dtype)
    o = jnp.einsum('bhqk,bkhd->bqhd', p, v)
    return o.reshape(b, -1, MLA_H * D_V) @ w_o


def setup_inputs(seed: int = 0) -> dict:
    key = jax.random.key(seed)
    ks = iter(jax.random.split(key, 64))
    D = D_MODEL

    def nrm(shape, scale):
        return jax.random.normal(next(ks), shape, jnp.float32) * scale

    def gain(shape):
        return 1.0 + nrm(shape, 0.1)

    return {
        "x_prompt": nrm((BATCH, SEQ, D), 1.0),
        "x_sample": nrm((DEC_BATCH, DEC_SEQ, D), 1.0),
        "state_rwkv": nrm((DEC_BATCH, N_RWKV_LAYERS, 2, RWKV_H, RWKV_HS, RWKV_HS), 0.3),
        "cache_mla_ckv": nrm((DEC_BATCH, N_MLA_LAYERS, PAST_LEN, KV_RANK), 1.0),
        "cache_mla_krope": nrm((DEC_BATCH, N_MLA_LAYERS, PAST_LEN, D_ROPE), 1.0),
        "c": nrm((DEC_BATCH, D), 1.0),
        "c_ctx": nrm((D,), 1.0),
        "mod_w": nrm((DEPTH, D, N_MOD * D), D ** -0.5),
        "mod_b": nrm((DEPTH, N_MOD * D), 0.1),
        "norm_g": gain((DEPTH, 4, D)),
        "mlp_w1": nrm((DEPTH, D, D_FF), D ** -0.5),
        "mlp_w2": nrm((DEPTH, D_FF, D), D_FF ** -0.5),
        "fft_w_out": nrm((N_FFT_LAYERS, D, D), D ** -0.5),
        "conv_w_in": nrm((N_CONV_LAYERS, D, 3 * D), D ** -0.5),
        "conv_w": nrm((N_CONV_LAYERS, 3, D), 3 ** -0.5),
        "conv_w_out": nrm((N_CONV_LAYERS, D, D), D ** -0.5),
        "rwkv_mu": jax.random.uniform(next(ks), (N_RWKV_LAYERS, 6, D), jnp.float32),
        "rwkv_w_r": nrm((N_RWKV_LAYERS, D, D), D ** -0.5),
        "rwkv_w_k": nrm((N_RWKV_LAYERS, D, D), D ** -0.5),
        "rwkv_w_v": nrm((N_RWKV_LAYERS, D, D), D ** -0.5),
        "rwkv_w_o": nrm((N_RWKV_LAYERS, D, D), D ** -0.5),
        "rwkv_w0": nrm((N_RWKV_LAYERS, 2, D), 0.5),
        "rwkv_w_l1": nrm((N_RWKV_LAYERS, 2, D, LORA_W), D ** -0.5),
        "rwkv_w_l2": nrm((N_RWKV_LAYERS, 2, LORA_W, D), 0.3 * LORA_W ** -0.5),
        "rwkv_a0": nrm((N_RWKV_LAYERS, 2, D), 0.5),
        "rwkv_a_l1": nrm((N_RWKV_LAYERS, 2, D, LORA_A), D ** -0.5),
        "rwkv_a_l2": nrm((N_RWKV_LAYERS, 2, LORA_A, D), 0.3 * LORA_A ** -0.5),
        "rwkv_g_l1": nrm((N_RWKV_LAYERS, D, LORA_G), D ** -0.5),
        "rwkv_g_l2": nrm((N_RWKV_LAYERS, LORA_G, D), LORA_G ** -0.5),
        "rwkv_k_k": gain((N_RWKV_LAYERS, D)),
        "rwkv_k_a": gain((N_RWKV_LAYERS, D)),
        "rwkv_r_k": nrm((N_RWKV_LAYERS, RWKV_H, RWKV_HS), 0.1),
        "rwkv_ln_g": gain((N_RWKV_LAYERS, D)),
        "rwkv_ln_b": nrm((N_RWKV_LAYERS, D), 0.02),
        "mla_w_dq": nrm((N_MLA_LAYERS, D, Q_RANK), D ** -0.5),
        "mla_g_q": gain((N_MLA_LAYERS, Q_RANK)),
        "mla_w_uq": nrm((N_MLA_LAYERS, Q_RANK, MLA_H * (D_NOPE + D_ROPE)), Q_RANK ** -0.5),
        "mla_w_dkv": nrm((N_MLA_LAYERS, D, KV_RANK + D_ROPE), D ** -0.5),
        "mla_g_kv": gain((N_MLA_LAYERS, KV_RANK)),
        "mla_w_uk": nrm((N_MLA_LAYERS, KV_RANK, MLA_H * D_NOPE), KV_RANK ** -0.5),
        "mla_w_uv": nrm((N_MLA_LAYERS, KV_RANK, MLA_H * D_V), KV_RANK ** -0.5),
        "mla_w_o": nrm((N_MLA_LAYERS, MLA_H * D_V, D), (MLA_H * D_V) ** -0.5),
    }


def reference(x_prompt, x_sample, state_rwkv, cache_mla_ckv, cache_mla_krope, c, c_ctx,
              mod_w, mod_b, norm_g, mlp_w1, mlp_w2,
              fft_w_out, conv_w_in, conv_w, conv_w_out,
              rwkv_mu, rwkv_w_r, rwkv_w_k, rwkv_w_v, rwkv_w_o, rwkv_w0, rwkv_w_l1, rwkv_w_l2,
              rwkv_a0, rwkv_a_l1, rwkv_a_l2, rwkv_g_l1, rwkv_g_l2, rwkv_k_k, rwkv_k_a, rwkv_r_k,
              rwkv_ln_g, rwkv_ln_b,
              mla_w_dq, mla_g_q, mla_w_uq, mla_w_dkv, mla_g_kv, mla_w_uk, mla_w_uv, mla_w_o):
    xp, xs = x_prompt, x_sample
    new_rwkv, new_ckv, new_krope = [], [], []
    for i in range(DEPTH):
        kind, j = i % N_MIXERS, i // N_MIXERS
        g4 = norm_g[i]
        m_ctx = modulation(c_ctx[None, :], mod_w[i], mod_b[i])
        m_lat = modulation(c, mod_w[i], mod_b[i])
        hp = rmsnorm(xp, g4[0]) * (1.0 + m_ctx[1]) + m_ctx[0]
        hs = rmsnorm(xs, g4[0]) * (1.0 + m_lat[1]) + m_lat[0]
        if kind == 0:
            op = fourier_mix(hp, fft_w_out[j])
            os_ = fourier_mix(hs, fft_w_out[j])
        elif kind == 1:
            op = short_conv_mix(hp, conv_w_in[j], conv_w[j], conv_w_out[j])
            os_ = short_conv_mix(hs, conv_w_in[j], conv_w[j], conv_w_out[j])
        elif kind == 2:
            rp = (rwkv_mu[j], rwkv_w_r[j], rwkv_w_k[j], rwkv_w_v[j], rwkv_w_o[j], rwkv_w0[j],
                  rwkv_w_l1[j], rwkv_w_l2[j], rwkv_a0[j], rwkv_a_l1[j], rwkv_a_l2[j],
                  rwkv_g_l1[j], rwkv_g_l2[j], rwkv_k_k[j], rwkv_k_a[j], rwkv_r_k[j],
                  rwkv_ln_g[j], rwkv_ln_b[j])
            s_zero = jnp.zeros((xp.shape[0], 2, RWKV_H, RWKV_HS, RWKV_HS), jnp.float32)
            op, s_ctx = rwkv7_mix(hp, s_zero, *rp)
            new_rwkv.append(s_ctx)
            os_, _ = rwkv7_mix(hs, state_rwkv[:, j], *rp)
        else:
            qn_p, qr_p = mla_queries(hp, mla_w_dq[j], mla_g_q[j], mla_w_uq[j], False)
            ckv_p, kr_p = mla_compress(hp, mla_w_dkv[j], mla_g_kv[j], False)
            new_ckv.append(ckv_p)
            new_krope.append(kr_p)
            op = mla_attend(qn_p, qr_p, ckv_p, kr_p, mla_w_uk[j], mla_w_uv[j], mla_w_o[j])
            qn_s, qr_s = mla_queries(hs, mla_w_dq[j], mla_g_q[j], mla_w_uq[j], True)
            ckv_s, kr_s = mla_compress(hs, mla_w_dkv[j], mla_g_kv[j], True)
            ckv_all = jnp.concatenate([cache_mla_ckv[:, j], ckv_s], axis=1)
            kr_all = jnp.concatenate([cache_mla_krope[:, j], kr_s], axis=1)
            os_ = mla_attend(qn_s, qr_s, ckv_all, kr_all, mla_w_uk[j], mla_w_uv[j], mla_w_o[j])
        xp = xp + m_ctx[2] * rmsnorm(op, g4[1])
        xs = xs + m_lat[2] * rmsnorm(os_, g4[1])
        hp = rmsnorm(xp, g4[2]) * (1.0 + m_ctx[4]) + m_ctx[3]
        hs = rmsnorm(xs, g4[2]) * (1.0 + m_lat[4]) + m_lat[3]
        fp = jnp.square(jax.nn.relu(hp @ mlp_w1[i])) @ mlp_w2[i]
        fs = jnp.square(jax.nn.relu(hs @ mlp_w1[i])) @ mlp_w2[i]
        xp = xp + m_ctx[5] * rmsnorm(fp, g4[3])
        xs = xs + m_lat[5] * rmsnorm(fs, g4[3])
    new_state_rwkv = jnp.stack(new_rwkv, axis=1)
    new_cache_mla_ckv = jnp.stack(new_ckv, axis=1)
    new_cache_mla_krope = jnp.stack(new_krope, axis=1)
    return (xp, xs, new_state_rwkv, new_cache_mla_ckv, new_cache_mla_krope)
```

```cpp
#include <hip/hip_runtime.h>
#include <hip/hip_cooperative_groups.h>
#include <cstdio>
#include <cstdint>
namespace cg = cooperative_groups;

typedef unsigned short bf16_t;
typedef short bf16x8 __attribute__((ext_vector_type(8)));
typedef float f32x4 __attribute__((ext_vector_type(4)));
typedef float f32x2 __attribute__((ext_vector_type(2)));

struct Params { const float* in[42]; float* out; char* ws; };

constexpr size_t SZ_ACT = 6144ull * 1024ull;
constexpr size_t OFF_MOD = 0;
constexpr size_t OFF_CTR = OFF_MOD + 4 * 3 * 6144 * 4;
constexpr size_t OFF_W1T = OFF_CTR + 256;
constexpr size_t OFF_W2T = OFF_W1T + 4ull * 4096 * 1024 * 2;
constexpr size_t OFF_FFTWT = OFF_W2T + 4ull * 4096 * 1024 * 2;
constexpr size_t OFF_CINT = OFF_FFTWT + 1024 * 1024 * 2;
constexpr size_t OFF_COUTT = OFF_CINT + 3072 * 1024 * 2;
constexpr size_t OFF_RW1T = OFF_COUTT + 1024 * 1024 * 2;
constexpr size_t OFF_RWW2T = OFF_RW1T + 3456 * 1024 * 2;
constexpr size_t OFF_RWA2T = OFF_RWW2T + 2 * 1024 * 64 * 2;
constexpr size_t OFF_RWG2T = OFF_RWA2T + 2 * 1024 * 64 * 2;
constexpr size_t OFF_RWOT = OFF_RWG2T + 1024 * 128 * 2;
constexpr size_t OFF_MDQKVT = OFF_RWOT + 1024 * 1024 * 2;
constexpr size_t OFF_MUQT = OFF_MDQKVT + 768 * 1024 * 2;
constexpr size_t OFF_MUKT = OFF_MUQT + 1536 * 384 * 2;
constexpr size_t OFF_MUVT = OFF_MUKT + 1024 * 256 * 2;
constexpr size_t OFF_MOT = OFF_MUVT + 1024 * 256 * 2;
constexpr size_t OFF_DFTC = OFF_MOT + 1024 * 1024 * 2;
constexpr size_t OFF_DFTP256 = OFF_DFTC + 256 * 128 * 2;
constexpr size_t OFF_DFTP1024 = OFF_DFTP256 + 256 * 512 * 2;
constexpr size_t OFF_CKVALL = OFF_DFTP1024 + 1024 * 2048 * 2;
constexpr size_t OFF_KRALL = OFF_CKVALL + 6656 * 256 * 2;
constexpr size_t OFF_H = OFF_KRALL + 6656 * 64 * 2;
constexpr size_t OFF_O = OFF_H + SZ_ACT * 2;
constexpr size_t OFF_HID = OFF_O + SZ_ACT * 4;
constexpr size_t OFF_RA = OFF_HID + SZ_ACT * 8;
constexpr size_t OFF_RB = OFF_RA + SZ_ACT * 12;
constexpr size_t OFF_LB = OFF_RB + SZ_ACT * 16;
constexpr size_t WS_TOTAL = OFF_LB + 6144ull * 384 * 2;
constexpr size_t OFF_YT = OFF_RA;
constexpr size_t OFF_F = OFF_RA + SZ_ACT * 4;
constexpr size_t OFF_BCU = OFF_RA;
constexpr size_t OFF_A2 = OFF_RA + SZ_ACT * 6;
constexpr size_t OFF_XM = OFF_RA;
constexpr size_t OFF_KEFF = OFF_RA;
constexpr size_t OFF_NB = OFF_RA + SZ_ACT * 4;
constexpr size_t OFF_G = OFF_RA + SZ_ACT * 8;
constexpr size_t OFF_QC = OFF_RA;
constexpr size_t OFF_QN = OFF_QC + 6144ull * 704 * 4;
constexpr size_t OFF_Q = OFF_QN + 6144ull * 384 * 2;
constexpr size_t OFF_KN = OFF_Q + 6144ull * 1536 * 2;
constexpr size_t OFF_VT = OFF_KN + 6656ull * 1024 * 2;
constexpr size_t OFF_R = OFF_RB;
constexpr size_t OFF_V = OFF_RB + SZ_ACT * 4;
constexpr size_t OFF_K = OFF_RB + SZ_ACT * 8;
constexpr size_t OFF_KK = OFF_RB + SZ_ACT * 12;
constexpr size_t OFF_Y0 = OFF_K;
constexpr size_t OFF_Y1 = OFF_O;
constexpr size_t OFF_WDEC = OFF_HID;
constexpr size_t OUT_STATE = 6291456, OUT_CKV = 8388608, OUT_KROPE = 9437184;

__device__ __forceinline__ unsigned short f2bf(float f) { unsigned u = __float_as_uint(f); u += 0x7fffu + ((u >> 16) & 1u); return (unsigned short)(u >> 16); }
typedef __bf16 bf16x2_t __attribute__((ext_vector_type(2)));
__device__ __forceinline__ unsigned pack2(float a, float b) { const f32x2 v = {a, b}; const bf16x2_t r = __builtin_convertvector(v, bf16x2_t); return __builtin_bit_cast(unsigned, r); }
__device__ __forceinline__ float bflo(unsigned u) { return __uint_as_float(u << 16); }
__device__ __forceinline__ float bfhi(unsigned u) { return __uint_as_float(u & 0xffff0000u); }
__device__ __forceinline__ float wave_sum(float v) {
#pragma unroll
  for (int o = 32; o > 0; o >>= 1) v += __shfl_xor(v, o);
  return v;
}
__device__ __forceinline__ float quad_sum(float v) {
  v += __int_as_float(__builtin_amdgcn_update_dpp(0, __float_as_int(v), 0xB1, 0xF, 0xF, true));
  v += __int_as_float(__builtin_amdgcn_update_dpp(0, __float_as_int(v), 0x4E, 0xF, 0xF, true));
  return v;
}
__device__ __forceinline__ float sigmoidf_(float x) { return 1.f / (1.f + __expf(-x)); }
__device__ __forceinline__ int row_group(int row) { return row < 4096 ? 0 : 1 + ((row - 4096) >> 10); }

template <bool SWAP, class Epi>
__device__ __forceinline__ void gemm_tile(const bf16_t* __restrict__ A, int lda, const bf16_t* __restrict__ Bt, int ldb, int K, char* lds, Epi&& epi) {
  int tid = threadIdx.x; asm volatile("" : "+v"(tid));
  const int lane = tid & 63, wid = tid >> 6, wr = wid >> 1, wc = wid & 1;
  const int lrow = tid >> 3, lch = tid & 7;
  const bf16_t* ap = A + (size_t)lrow * lda + lch * 8;
  const bf16_t* bp = Bt + (size_t)lrow * ldb + lch * 8;
  const int soff = lrow * 128 + ((lch ^ ((lrow >> 1) & 7)) << 4);
  const int quad = lane >> 4, l15 = lane & 15, sw = l15 >> 1;
  const int aoff = (wr * 64 + l15) * 128, boff = 16384 + (wc * 64 + l15) * 128;
  f32x4 acc[4][4];
#pragma unroll
  for (int i = 0; i < 4; ++i)
#pragma unroll
    for (int j = 0; j < 4; ++j) acc[i][j] = (f32x4){0.f, 0.f, 0.f, 0.f};
  uint4 ra0, ra1, ra2, ra3, rb0, rb1, rb2, rb3;
#define GT_LOAD() do { ra0 = *(const uint4*)(ap); ra1 = *(const uint4*)(ap + (size_t)32 * lda); ra2 = *(const uint4*)(ap + (size_t)64 * lda); ra3 = *(const uint4*)(ap + (size_t)96 * lda); \
                       rb0 = *(const uint4*)(bp); rb1 = *(const uint4*)(bp + (size_t)32 * ldb); rb2 = *(const uint4*)(bp + (size_t)64 * ldb); rb3 = *(const uint4*)(bp + (size_t)96 * ldb); } while (0)
#define GT_STORE(base) do { char* _b = (base) + soff; *(uint4*)(_b) = ra0; *(uint4*)(_b + 4096) = ra1; *(uint4*)(_b + 8192) = ra2; *(uint4*)(_b + 12288) = ra3; \
                            *(uint4*)(_b + 16384) = rb0; *(uint4*)(_b + 20480) = rb1; *(uint4*)(_b + 24576) = rb2; *(uint4*)(_b + 28672) = rb3; } while (0)
  GT_LOAD();
  GT_STORE(lds);
  __syncthreads();
  const int nk = K >> 6;
  for (int kt = 0; kt < nk; ++kt) {
    char* cur = lds + (kt & 1) * 32768;
    const bool more = kt + 1 < nk;
    if (more) { ap += 64; bp += 64; GT_LOAD(); }
#pragma unroll
    for (int ks = 0; ks < 2; ++ks) {
      const int ch = ((ks * 4 + quad) ^ sw) << 4;
      bf16x8 af[4], bfr[4];
#pragma unroll
      for (int mi = 0; mi < 4; ++mi) af[mi] = *(const bf16x8*)(cur + aoff + mi * 2048 + ch);
#pragma unroll
      for (int ni = 0; ni < 4; ++ni) bfr[ni] = *(const bf16x8*)(cur + boff + ni * 2048 + ch);
#pragma unroll
      for (int mi = 0; mi < 4; ++mi)
#pragma unroll
        for (int ni = 0; ni < 4; ++ni)
          acc[mi][ni] = SWAP ? __builtin_amdgcn_mfma_f32_16x16x32_bf16(bfr[ni], af[mi], acc[mi][ni], 0, 0, 0)
                             : __builtin_amdgcn_mfma_f32_16x16x32_bf16(af[mi], bfr[ni], acc[mi][ni], 0, 0, 0);
    }
    if (more) GT_STORE(lds + ((kt + 1) & 1) * 32768);
    __syncthreads();
  }
  epi(acc, wr * 64, wc * 64);
}

#define PH_BEGIN_NOWS int tid_ = threadIdx.x; int bid_ = blockIdx.x; asm volatile("" : "+v"(tid_), "+s"(bid_));
#define PH_BEGIN PH_BEGIN_NOWS char* ws_ = p.ws; asm volatile("" : "+s"(ws_));
__device__ __forceinline__ void conv_T(const float* __restrict__ src, int K, int N, bf16_t* __restrict__ dst, int ldd, int& base, char* lds) {
  PH_BEGIN_NOWS
  const int tn = N >> 6, nt = (K >> 6) * tn, G = gridDim.x, tid = tid_;
  float (*tile)[65] = (float (*)[65])lds;
  int first = ((int)bid_ - base) % G; if (first < 0) first += G;
  for (int t = first; t < nt; t += G) {
    const int kt = t / tn, nti = t - kt * tn;
    const float* s = src + (size_t)(kt * 64) * N + nti * 64;
    const int c = tid & 63, r0 = tid >> 6;
#pragma unroll
    for (int i = 0; i < 16; ++i) tile[r0 + 4 * i][c] = s[(size_t)(r0 + 4 * i) * N + c];
    __syncthreads();
    const int n = tid >> 2, kc = (tid & 3) * 16;
    unsigned w[8];
#pragma unroll
    for (int j = 0; j < 8; ++j) w[j] = pack2(tile[kc + 2 * j][n], tile[kc + 2 * j + 1][n]);
    bf16_t* d = dst + (size_t)(nti * 64 + n) * ldd + kt * 64 + kc;
    *(uint4*)d = make_uint4(w[0], w[1], w[2], w[3]);
    *(uint4*)(d + 8) = make_uint4(w[4], w[5], w[6], w[7]);
    __syncthreads();
  }
  base = (base + nt) % G;
}

__device__ __forceinline__ void phase_prep(const Params& p, char* lds) {
  PH_BEGIN
  char* ws = ws_;
  const int tid = tid_, gt = bid_ * 256 + tid, nthr = gridDim.x * 256;
  if (bid_ == 0 && tid < 64) ((unsigned*)(ws + OFF_CTR))[tid] = 0u;
  {
    float* sl = (float*)lds;
    float* red = (float*)(lds + 12288);
    bool have = false;
    for (int item = bid_; item < 384; item += gridDim.x) {
      if (!have) {
        for (int i = tid; i < 3072; i += 256) {
          const int g = i >> 10, k = i & 1023;
          const float cv = g == 0 ? p.in[6][k] : p.in[5][(g - 1) * 1024 + k];
          sl[i] = cv / (1.f + __expf(-cv));
        }
        have = true;
        __syncthreads();
      }
      const int l = item / 96, n0 = (item % 96) * 64, lane = tid & 63, w = tid >> 6;
      const float* mw = p.in[7] + (size_t)l * 1024 * 6144 + n0 + lane;
      float a0 = 0.f, a1 = 0.f, a2 = 0.f;
#pragma unroll 16
      for (int k = w * 256; k < w * 256 + 256; ++k) {
        const float wv = mw[(size_t)k * 6144];
        a0 += sl[k] * wv; a1 += sl[1024 + k] * wv; a2 += sl[2048 + k] * wv;
      }
      red[(w * 3 + 0) * 64 + lane] = a0; red[(w * 3 + 1) * 64 + lane] = a1; red[(w * 3 + 2) * 64 + lane] = a2;
      __syncthreads();
      if (tid < 192) {
        const int g = tid >> 6;
        const float s = red[(0 * 3 + g) * 64 + lane] + red[(1 * 3 + g) * 64 + lane] + red[(2 * 3 + g) * 64 + lane] + red[(3 * 3 + g) * 64 + lane];
        ((float*)(ws + OFF_MOD))[(l * 3 + g) * 6144 + n0 + lane] = s + p.in[8][l * 6144 + n0 + lane];
      }
      __syncthreads();
    }
    __syncthreads();
  }
  {
    bf16_t* dc = (bf16_t*)(ws + OFF_DFTC);
    for (int i = gt; i < 256 * 128; i += nthr) {
      const int np = i >> 7, c = i & 127, half = np >> 7, cp = np & 127, m = (c * cp) & 127;
      const float x = (float)m * (1.f / 128.f);
      const float v = half ? __builtin_amdgcn_sinf(x) : __builtin_amdgcn_cosf(x);
      dc[i] = f2bf(v * 0.08838834764831845f);
    }
    bf16_t* d256 = (bf16_t*)(ws + OFF_DFTP256);
    for (int i = gt; i < 256 * 512; i += nthr) {
      const int np = i >> 9, c = i & 511, half = c >> 8, pos = c & 255, m = (pos * np) & 255;
      const float x = (float)m * (1.f / 256.f);
      const float v = half ? -__builtin_amdgcn_sinf(x) : __builtin_amdgcn_cosf(x);
      d256[i] = f2bf(v * 0.0625f);
    }
    bf16_t* d1024 = (bf16_t*)(ws + OFF_DFTP1024);
    for (int i = gt; i < 1024 * 2048; i += nthr) {
      const int np = i >> 11, c = i & 2047, half = c >> 10, pos = c & 1023, m = (pos * np) & 1023;
      const float x = (float)m * (1.f / 1024.f);
      const float v = half ? -__builtin_amdgcn_sinf(x) : __builtin_amdgcn_cosf(x);
      d1024[i] = f2bf(v * 0.03125f);
    }
  }
  {
    bf16_t* ck = (bf16_t*)(ws + OFF_CKVALL);
    for (int i = gt; i < 2 * 256 * 256; i += nthr) {
      const int b = i >> 16, r = i & 65535;
      ck[(size_t)(4096 + b * 1280) * 256 + r] = f2bf(p.in[3][i]);
    }
    bf16_t* kr = (bf16_t*)(ws + OFF_KRALL);
    for (int i = gt; i < 2 * 256 * 64; i += nthr) {
      const int b = i >> 14, r = i & 16383;
      kr[(size_t)(4096 + b * 1280) * 64 + r] = f2bf(p.in[4][i]);
    }
    bf16_t* pad = (bf16_t*)(ws + OFF_MDQKVT) + 704 * 1024;
    for (int i = gt; i < 64 * 1024; i += nthr) pad[i] = 0;
  }
  int base = 0;
  for (int l = 0; l < 4; ++l) {
    conv_T(p.in[10] + (size_t)l * 1024 * 4096, 1024, 4096, (bf16_t*)(ws + OFF_W1T) + (size_t)l * 4096 * 1024, 1024, base, lds);
    conv_T(p.in[11] + (size_t)l * 4096 * 1024, 4096, 1024, (bf16_t*)(ws + OFF_W2T) + (size_t)l * 4096 * 1024, 4096, base, lds);
  }
  conv_T(p.in[12], 1024, 1024, (bf16_t*)(ws + OFF_FFTWT), 1024, base, lds);
  conv_T(p.in[13], 1024, 3072, (bf16_t*)(ws + OFF_CINT), 1024, base, lds);
  conv_T(p.in[15], 1024, 1024, (bf16_t*)(ws + OFF_COUTT), 1024, base, lds);
  {
    bf16_t* r1 = (bf16_t*)(ws + OFF_RW1T);
    conv_T(p.in[17], 1024, 1024, r1, 1024, base, lds);
    conv_T(p.in[18], 1024, 1024, r1 + 1024 * 1024, 1024, base, lds);
    conv_T(p.in[19], 1024, 1024, r1 + 2048 * 1024, 1024, base, lds);
    conv_T(p.in[22], 1024, 64, r1 + 3072 * 1024, 1024, base, lds);
    conv_T(p.in[22] + 1024 * 64, 1024, 64, r1 + (3072 + 64) * 1024, 1024, base, lds);
    conv_T(p.in[25], 1024, 64, r1 + (3072 + 128) * 1024, 1024, base, lds);
    conv_T(p.in[25] + 1024 * 64, 1024, 64, r1 + (3072 + 192) * 1024, 1024, base, lds);
    conv_T(p.in[27], 1024, 128, r1 + (3072 + 256) * 1024, 1024, base, lds);
    conv_T(p.in[23], 64, 1024, (bf16_t*)(ws + OFF_RWW2T), 64, base, lds);
    conv_T(p.in[23] + 64 * 1024, 64, 1024, (bf16_t*)(ws + OFF_RWW2T) + 1024 * 64, 64, base, lds);
    conv_T(p.in[26], 64, 1024, (bf16_t*)(ws + OFF_RWA2T), 64, base, lds);
    conv_T(p.in[26] + 64 * 1024, 64, 1024, (bf16_t*)(ws + OFF_RWA2T) + 1024 * 64, 64, base, lds);
    conv_T(p.in[28], 128, 1024, (bf16_t*)(ws + OFF_RWG2T), 128, base, lds);
    conv_T(p.in[20], 1024, 1024, (bf16_t*)(ws + OFF_RWOT), 1024, base, lds);
  }
  conv_T(p.in[34], 1024, 384, (bf16_t*)(ws + OFF_MDQKVT), 1024, base, lds);
  conv_T(p.in[37], 1024, 320, (bf16_t*)(ws + OFF_MDQKVT) + 384 * 1024, 1024, base, lds);
  conv_T(p.in[36], 384, 1536, (bf16_t*)(ws + OFF_MUQT), 384, base, lds);
  conv_T(p.in[39], 256, 1024, (bf16_t*)(ws + OFF_MUKT), 256, base, lds);
  conv_T(p.in[40], 256, 1024, (bf16_t*)(ws + OFF_MUVT), 256, base, lds);
  conv_T(p.in[41], 1024, 1024, (bf16_t*)(ws + OFF_MOT), 1024, base, lds);
}

__device__ __forceinline__ void phase_row(const Params& p, bool from_input, bool upd, int ul, int ugate, int ugn, bool wh, int hl, int hgn, int hshift) {
  PH_BEGIN
  const int lane = tid_ & 63, gw = bid_ * 4 + (tid_ >> 6), nw = gridDim.x * 4;
  float* X = p.out;
  const float* O = (const float*)(ws_ + OFF_O);
  bf16_t* H = (bf16_t*)(ws_ + OFF_H);
  const float* modv = (const float*)(ws_ + OFF_MOD);
  const float* ng = p.in[9];
  for (int row = gw; row < 6144; row += nw) {
    const int g = row_group(row);
    const float* xr = from_input ? (row < 4096 ? p.in[0] + (size_t)row * 1024 : p.in[1] + (size_t)(row - 4096) * 1024) : X + (size_t)row * 1024;
    f32x4 x[4];
#pragma unroll
    for (int i = 0; i < 4; ++i) x[i] = *(const f32x4*)(xr + lane * 4 + 256 * i);
    if (upd) {
      f32x4 ov[4]; float ss = 0.f;
#pragma unroll
      for (int i = 0; i < 4; ++i) { ov[i] = *(const f32x4*)(O + (size_t)row * 1024 + lane * 4 + 256 * i); ss += ov[i][0] * ov[i][0] + ov[i][1] * ov[i][1] + ov[i][2] * ov[i][2] + ov[i][3] * ov[i][3]; }
      ss = wave_sum(ss);
      const float rs = rsqrtf(ss * (1.f / 1024.f) + 1e-6f);
      const float* gn = ng + (ul * 4 + ugn) * 1024;
      const float* gate = modv + ((ul * 3 + g) * 6 + ugate) * 1024;
#pragma unroll
      for (int i = 0; i < 4; ++i) {
        const f32x4 gv = *(const f32x4*)(gn + lane * 4 + 256 * i), gt = *(const f32x4*)(gate + lane * 4 + 256 * i);
        x[i] += gt * (ov[i] * rs * gv);
      }
    }
    if (upd || from_input) {
#pragma unroll
      for (int i = 0; i < 4; ++i) *(f32x4*)(X + (size_t)row * 1024 + lane * 4 + 256 * i) = x[i];
    }
    if (wh) {
      float ss = 0.f;
#pragma unroll
      for (int i = 0; i < 4; ++i) ss += x[i][0] * x[i][0] + x[i][1] * x[i][1] + x[i][2] * x[i][2] + x[i][3] * x[i][3];
      ss = wave_sum(ss);
      const float rs = rsqrtf(ss * (1.f / 1024.f) + 1e-6f);
      const float* gn = ng + (hl * 4 + hgn) * 1024;
      const float* sh = modv + ((hl * 3 + g) * 6 + hshift) * 1024;
#pragma unroll
      for (int i = 0; i < 4; ++i) {
        const int c = lane * 4 + 256 * i;
        const f32x4 gv = *(const f32x4*)(gn + c), shv = *(const f32x4*)(sh + c), scv = *(const f32x4*)(sh + 1024 + c);
        const f32x4 h = x[i] * rs * gv * (1.f + scv) + shv;
        *(uint2*)(H + (size_t)row * 1024 + c) = make_uint2(pack2(h[0], h[1]), pack2(h[2], h[3]));
      }
    }
  }
}

__device__ __forceinline__ void phase_rwkv_mix(const Params& p) {
  PH_BEGIN
  const int lane = tid_ & 63, gw = bid_ * 4 + (tid_ >> 6), nw = gridDim.x * 4;
  const float* X = p.out;
  bf16_t* XM = (bf16_t*)(ws_ + OFF_XM);
  const float* modv = (const float*)(ws_ + OFF_MOD);
  const float* gn = p.in[9] + (2 * 4 + 0) * 1024;
  const float* mu = p.in[16];
  for (int row = gw; row < 6144; row += nw) {
    const int g = row_group(row);
    const int pos = row < 4096 ? (row & 255) : ((row - 4096) & 1023), n = row < 4096 ? 256 : 1024;
    const bool hasp = pos > 0, hasn = pos < n - 1;
    const float* sh = modv + ((2 * 3 + g) * 6 + 0) * 1024;
    f32x4 xc[4], xp[4], xn[4];
    float sc_ = 0.f, sp_ = 0.f, sn_ = 0.f;
#pragma unroll
    for (int i = 0; i < 4; ++i) {
      const int c = lane * 4 + 256 * i;
      xc[i] = *(const f32x4*)(X + (size_t)row * 1024 + c);
      xp[i] = hasp ? *(const f32x4*)(X + (size_t)(row - 1) * 1024 + c) : (f32x4){0.f, 0.f, 0.f, 0.f};
      xn[i] = hasn ? *(const f32x4*)(X + (size_t)(row + 1) * 1024 + c) : (f32x4){0.f, 0.f, 0.f, 0.f};
#pragma unroll
      for (int j = 0; j < 4; ++j) { sc_ += xc[i][j] * xc[i][j]; sp_ += xp[i][j] * xp[i][j]; sn_ += xn[i][j] * xn[i][j]; }
    }
    sc_ = wave_sum(sc_); sp_ = wave_sum(sp_); sn_ = wave_sum(sn_);
    const float rc = rsqrtf(sc_ * (1.f / 1024.f) + 1e-6f), rp = rsqrtf(sp_ * (1.f / 1024.f) + 1e-6f), rn = rsqrtf(sn_ * (1.f / 1024.f) + 1e-6f);
#pragma unroll
    for (int i = 0; i < 4; ++i) {
      const int c = lane * 4 + 256 * i;
      const f32x4 gv = *(const f32x4*)(gn + c), shv = *(const f32x4*)(sh + c), scv = *(const f32x4*)(sh + 1024 + c);
      const f32x4 gm = gv * (1.f + scv);
      const f32x4 hc = xc[i] * rc * gm + shv;
      f32x4 hp = xp[i] * rp * gm + shv, hn = xn[i] * rn * gm + shv;
      if (!hasp) hp = (f32x4){0.f, 0.f, 0.f, 0.f};
      if (!hasn) hn = (f32x4){0.f, 0.f, 0.f, 0.f};
      const f32x4 dx = 0.5f * (hp + hn) - hc;
#pragma unroll
      for (int m = 0; m < 6; ++m) {
        const f32x4 muv = *(const f32x4*)(mu + m * 1024 + c);
        const f32x4 o = hc + dx * muv;
        *(uint2*)(XM + (size_t)m * SZ_ACT + (size_t)row * 1024 + c) = make_uint2(pack2(o[0], o[1]), pack2(o[2], o[3]));
      }
    }
  }
}

__device__ __forceinline__ void phase_conv_elt(const Params& p) {
  PH_BEGIN
  const int lane = tid_ & 63, gw = bid_ * 4 + (tid_ >> 6), nw = gridDim.x * 4;
  const bf16_t* BCU = (const bf16_t*)(ws_ + OFF_BCU);
  bf16_t* A2 = (bf16_t*)(ws_ + OFF_A2);
  const float* cw = p.in[14];
  for (int row = gw; row < 6144; row += nw) {
    const int pos = row < 4096 ? (row & 255) : ((row - 4096) & 1023), n = row < 4096 ? 256 : 1024;
    const bool hasp = pos > 0, hasn = pos < n - 1;
#pragma unroll
    for (int i = 0; i < 2; ++i) {
      const int c = lane * 8 + 512 * i;
      const bf16_t* rb = BCU + (size_t)row * 3072 + c;
      const uint4 bg = *(const uint4*)rb, cg = *(const uint4*)(rb + 1024), u = *(const uint4*)(rb + 2048);
      uint4 cgp = make_uint4(0, 0, 0, 0), up = cgp, cgn = cgp, un = cgp;
      if (hasp) { cgp = *(const uint4*)(rb - 3072 + 1024); up = *(const uint4*)(rb - 3072 + 2048); }
      if (hasn) { cgn = *(const uint4*)(rb + 3072 + 1024); un = *(const uint4*)(rb + 3072 + 2048); }
      const unsigned bgw[4] = {bg.x, bg.y, bg.z, bg.w}, cgw[4] = {cg.x, cg.y, cg.z, cg.w}, uw[4] = {u.x, u.y, u.z, u.w};
      const unsigned cgpw[4] = {cgp.x, cgp.y, cgp.z, cgp.w}, upw[4] = {up.x, up.y, up.z, up.w}, cgnw[4] = {cgn.x, cgn.y, cgn.z, cgn.w}, unw[4] = {un.x, un.y, un.z, un.w};
      unsigned ow[4];
#pragma unroll
      for (int j = 0; j < 4; ++j) {
        const int cc = c + 2 * j;
        const float w00 = cw[cc], w01 = cw[cc + 1], w10 = cw[1024 + cc], w11 = cw[1024 + cc + 1], w20 = cw[2048 + cc], w21 = cw[2048 + cc + 1];
        const float z0 = bflo(cgw[j]) * bflo(uw[j]), z1 = bfhi(cgw[j]) * bfhi(uw[j]);
        const float zp0 = bflo(cgpw[j]) * bflo(upw[j]), zp1 = bfhi(cgpw[j]) * bfhi(upw[j]);
        const float zn0 = bflo(cgnw[j]) * bflo(unw[j]), zn1 = bfhi(cgnw[j]) * bfhi(unw[j]);
        const float o0 = bflo(bgw[j]) * (zp0 * w00 + z0 * w10 + zn0 * w20);
        const float o1 = bfhi(bgw[j]) * (zp1 * w01 + z1 * w11 + zn1 * w21);
        ow[j] = pack2(o0, o1);
      }
      *(uint4*)(A2 + (size_t)row * 1024 + c) = make_uint4(ow[0], ow[1], ow[2], ow[3]);
    }
  }
}

__device__ __forceinline__ void phase_postscan(const Params& p) {
  PH_BEGIN
  const int lane = tid_ & 63, gw = bid_ * 4 + (tid_ >> 6), nw = gridDim.x * 4;
  const float* Y0 = (const float*)(ws_ + OFF_Y0);
  const float* Y1 = (const float*)(ws_ + OFF_Y1);
  const float* R = (const float*)(ws_ + OFF_R);
  const float* V = (const float*)(ws_ + OFF_V);
  const float* G = (const float*)(ws_ + OFF_G);
  const bf16_t* KE = (const bf16_t*)(ws_ + OFF_KEFF);
  bf16_t* Z = (bf16_t*)(ws_ + OFF_H);
  const float* rk = p.in[31]; const float* lng = p.in[32]; const float* lnb = p.in[33];
  for (int row = gw; row < 6144; row += nw) {
    const size_t b = (size_t)row * 1024 + lane * 16;
    float y[16], bon = 0.f, s = 0.f;
#pragma unroll
    for (int i = 0; i < 4; ++i) {
      const f32x4 a = *(const f32x4*)(Y0 + b + 4 * i), c = *(const f32x4*)(Y1 + b + 4 * i), r = *(const f32x4*)(R + b + 4 * i);
      const uint2 k0 = *(const uint2*)(KE + b + 4 * i), k1 = *(const uint2*)(KE + SZ_ACT + b + 4 * i);
      const f32x4 rkv = *(const f32x4*)(rk + lane * 16 + 4 * i);
      const float ke[4] = {bflo(k0.x) + bflo(k1.x), bfhi(k0.x) + bfhi(k1.x), bflo(k0.y) + bflo(k1.y), bfhi(k0.y) + bfhi(k1.y)};
#pragma unroll
      for (int j = 0; j < 4; ++j) { y[4 * i + j] = a[j] + c[j]; s += y[4 * i + j]; bon += r[j] * ke[j] * rkv[j]; }
    }
    s = quad_sum(s); bon = quad_sum(bon);
    const float mean = s * (1.f / 64.f);
    float vs = 0.f;
#pragma unroll
    for (int j = 0; j < 16; ++j) { const float d = y[j] - mean; vs += d * d; }
    vs = quad_sum(vs);
    const float rstd = rsqrtf(vs * (1.f / 64.f) + 64e-5f);
    unsigned ow[8];
#pragma unroll
    for (int i = 0; i < 4; ++i) {
      const f32x4 v = *(const f32x4*)(V + b + 4 * i), gg = *(const f32x4*)(G + b + 4 * i);
      const f32x4 lg = *(const f32x4*)(lng + lane * 16 + 4 * i), lb = *(const f32x4*)(lnb + lane * 16 + 4 * i);
      float o[4];
#pragma unroll
      for (int j = 0; j < 4; ++j) o[j] = ((y[4 * i + j] - mean) * rstd * lg[j] + lb[j] + bon * v[j]) * gg[j];
      ow[2 * i] = pack2(o[0], o[1]); ow[2 * i + 1] = pack2(o[2], o[3]);
    }
    *(uint4*)(Z + b) = make_uint4(ow[0], ow[1], ow[2], ow[3]);
    *(uint4*)(Z + b + 8) = make_uint4(ow[4], ow[5], ow[6], ow[7]);
  }
}

__device__ __forceinline__ void phase_mla_rows(const Params& p) {
  PH_BEGIN
  const int lane = tid_ & 63, gw = bid_ * 4 + (tid_ >> 6), nw = gridDim.x * 4;
  const float* QC = (const float*)(ws_ + OFF_QC);
  bf16_t* QN = (bf16_t*)(ws_ + OFF_QN);
  bf16_t* CK = (bf16_t*)(ws_ + OFF_CKVALL);
  bf16_t* KR = (bf16_t*)(ws_ + OFF_KRALL);
  const float* gq = p.in[35]; const float* gkv = p.in[38];
  for (int row = gw; row < 6144; row += nw) {
    const float* q = QC + (size_t)row * 704;
    int keyrow = row;
    if (row >= 4096) { const int r = row - 4096; keyrow = 4096 + (r >> 10) * 1280 + 256 + (r & 1023); }
    float qv[6], ss = 0.f;
#pragma unroll
    for (int i = 0; i < 6; ++i) { qv[i] = q[lane + 64 * i]; ss += qv[i] * qv[i]; }
    ss = wave_sum(ss);
    float rs = rsqrtf(ss * (1.f / 384.f) + 1e-6f);
#pragma unroll
    for (int i = 0; i < 6; ++i) QN[(size_t)row * 384 + lane + 64 * i] = f2bf(qv[i] * rs * gq[lane + 64 * i]);
    float cv[4]; ss = 0.f;
#pragma unroll
    for (int i = 0; i < 4; ++i) { cv[i] = q[384 + lane + 64 * i]; ss += cv[i] * cv[i]; }
    ss = wave_sum(ss);
    rs = rsqrtf(ss * (1.f / 256.f) + 1e-6f);
#pragma unroll
    for (int i = 0; i < 4; ++i) {
      const float o = cv[i] * rs * gkv[lane + 64 * i];
      CK[(size_t)keyrow * 256 + lane + 64 * i] = f2bf(o);
      if (row < 4096) p.out[OUT_CKV + (size_t)row * 256 + lane + 64 * i] = o;
    }
    float kv = q[640 + lane];
    if (row < 4096) {
      p.out[OUT_KROPE + (size_t)row * 64 + lane] = kv;
    } else {
      const int pp = (row - 4096) & 1023;
      const float posv = (lane >> 5) ? (float)(pp & 63) : (float)(pp >> 6);
      const float inv = exp2f(-(float)(lane & 15) * 0.8304820237218406f);
      const float rev = posv * inv * 0.15915494309189535f;
      const float sn = __builtin_amdgcn_sinf(rev), cs = __builtin_amdgcn_cosf(rev);
      const float other = __shfl_xor(kv, 16);
      kv = (lane & 16) ? (other * sn + kv * cs) : (kv * cs - other * sn);
    }
    KR[(size_t)keyrow * 64 + lane] = f2bf(kv);
  }
}

#define ACC_T f32x4 (&acc)[4][4]
#define LANE_VARS const int lane = tid_ & 63, l15 = lane & 15, quad = lane >> 4; (void)l15; (void)quad;

__device__ __forceinline__ void phase_gemm_f32(const bf16_t* A, int lda, const bf16_t* Bt, int ldb, int K, int ntm, int ntn, float* Out, int ldo, int nvalid, char* lds) {
  PH_BEGIN_NOWS
  asm volatile("" : "+s"(A), "+s"(Bt), "+s"(Out));
  LANE_VARS
  for (int t = bid_; t < ntm * ntn; t += gridDim.x) {
    const int tm = t % ntm, tn = t / ntm;
    gemm_tile<true>(A + (size_t)tm * 128 * lda, lda, Bt + (size_t)tn * 128 * ldb, ldb, K, lds, [&](ACC_T, int r0, int c0) __attribute__((always_inline)) {
#pragma unroll
      for (int mi = 0; mi < 4; ++mi)
#pragma unroll
        for (int ni = 0; ni < 4; ++ni) {
          const int row = tm * 128 + r0 + mi * 16 + l15, col = tn * 128 + c0 + ni * 16 + quad * 4;
          if (col < nvalid) *(f32x4*)(Out + (size_t)row * ldo + col) = acc[mi][ni];
        }
    });
  }
}

template <int ACT>
__device__ __forceinline__ void phase_gemm_bf16(const bf16_t* A, int lda, const bf16_t* Bt, int ldb, int K, int ntm, int ntn, bf16_t* Out, int ldo, char* lds) {
  PH_BEGIN_NOWS
  asm volatile("" : "+s"(A), "+s"(Bt), "+s"(Out));
  LANE_VARS
  for (int t = bid_; t < ntm * ntn; t += gridDim.x) {
    const int tm = t % ntm, tn = t / ntm;
    gemm_tile<true>(A + (size_t)tm * 128 * lda, lda, Bt + (size_t)tn * 128 * ldb, ldb, K, lds, [&](ACC_T, int r0, int c0) __attribute__((always_inline)) {
#pragma unroll
      for (int mi = 0; mi < 4; ++mi)
#pragma unroll
        for (int ni = 0; ni < 4; ++ni) {
          const int row = tm * 128 + r0 + mi * 16 + l15, col = tn * 128 + c0 + ni * 16 + quad * 4;
          f32x4 v = acc[mi][ni];
          if (ACT == 1) {
#pragma unroll
            for (int j = 0; j < 4; ++j) { const float r = fmaxf(v[j], 0.f); v[j] = r * r; }
          }
          *(uint2*)(Out + (size_t)row * ldo + col) = make_uint2(pack2(v[0], v[1]), pack2(v[2], v[3]));
        }
    });
  }
}

__device__ __forceinline__ void phase_chan_dft(const Params& p, char* lds) {
  PH_BEGIN
  LANE_VARS
  const bf16_t* H = (const bf16_t*)(ws_ + OFF_H);
  const bf16_t* TB = (const bf16_t*)(ws_ + OFF_DFTC);
  bf16_t* YT = (bf16_t*)(ws_ + OFF_YT);
  for (int t = bid_; t < 48 * 16; t += gridDim.x) {
    const int tm = t % 48, tn = t / 48, g = tn >> 1, half = tn & 1;
    const int trow = tm * 128;
    bf16_t* base; int n, pos0;
    if (trow < 4096) { n = 256; pos0 = trow & 255; base = YT + (size_t)(trow >> 8) * (1024 * 512); }
    else { n = 1024; pos0 = (trow - 4096) & 1023; base = YT + (size_t)16 * 1024 * 512 + (size_t)((trow - 4096) >> 10) * (1024 * 2048); }
    gemm_tile<false>(H + (size_t)trow * 1024 + g * 128, 1024, TB + (size_t)half * 128 * 128, 128, 128, lds, [&](ACC_T, int r0, int c0) __attribute__((always_inline)) {
#pragma unroll
      for (int mi = 0; mi < 4; ++mi)
#pragma unroll
        for (int ni = 0; ni < 4; ++ni) {
          const int pos = pos0 + r0 + mi * 16 + quad * 4, cp = c0 + ni * 16 + l15;
          const f32x4 v = acc[mi][ni];
          *(uint2*)(base + (size_t)(g * 128 + cp) * (2 * n) + half * n + pos) = make_uint2(pack2(v[0], v[1]), pack2(v[2], v[3]));
        }
    });
  }
}

__device__ __forceinline__ void phase_pos_dft(const Params& p, char* lds) {
  PH_BEGIN
  LANE_VARS
  const bf16_t* YT = (const bf16_t*)(ws_ + OFF_YT);
  bf16_t* F = (bf16_t*)(ws_ + OFF_F);
  for (int u = bid_; u < 384; u += gridDim.x) {
    const bf16_t *A, *Bt; int ld, K, orow, tn;
    if (u < 128) {
      const int s2 = u >> 6, tm = (u >> 3) & 7; tn = u & 7;
      A = (const bf16_t*)(ws_ + OFF_DFTP1024) + (size_t)tm * 128 * 2048; ld = 2048; K = 2048;
      Bt = YT + (size_t)16 * 1024 * 512 + (size_t)s2 * 1024 * 2048 + (size_t)tn * 128 * 2048;
      orow = 4096 + s2 * 1024 + tm * 128;
    } else {
      const int v = u - 128, s = v >> 4, tm = (v >> 3) & 1; tn = v & 7;
      A = (const bf16_t*)(ws_ + OFF_DFTP256) + (size_t)tm * 128 * 512; ld = 512; K = 512;
      Bt = YT + (size_t)s * 1024 * 512 + (size_t)tn * 128 * 512;
      orow = s * 256 + tm * 128;
    }
    gemm_tile<true>(A, ld, Bt, ld, K, lds, [&](ACC_T, int r0, int c0) __attribute__((always_inline)) {
#pragma unroll
      for (int mi = 0; mi < 4; ++mi)
#pragma unroll
        for (int ni = 0; ni < 4; ++ni) {
          const int row = orow + r0 + mi * 16 + l15, col = tn * 128 + c0 + ni * 16 + quad * 4;
          const f32x4 v = acc[mi][ni];
          *(uint2*)(F + (size_t)row * 1024 + col) = make_uint2(pack2(v[0], v[1]), pack2(v[2], v[3]));
        }
    });
  }
}

__device__ __forceinline__ void phase_rwkv_gemm1(const Params& p, char* lds) {
  PH_BEGIN
  LANE_VARS
  const bf16_t* XM = (const bf16_t*)(ws_ + OFF_XM);
  const bf16_t* Bt = (const bf16_t*)(ws_ + OFF_RW1T);
  float* R = (float*)(ws_ + OFF_R); float* V = (float*)(ws_ + OFF_V); float* Kb = (float*)(ws_ + OFF_K); float* KK = (float*)(ws_ + OFF_KK);
  bf16_t* LB = (bf16_t*)(ws_ + OFF_LB);
  const float* k_k = p.in[29];
  for (int t = bid_; t < 48 * 27; t += gridDim.x) {
    const int tm = t % 48, tn = t / 48;
    int sel, kind;
    if (tn < 8) { sel = 0; kind = 0; } else if (tn < 16) { sel = 2; kind = 1; } else if (tn < 24) { sel = 3; kind = 2; }
    else { kind = 3; sel = tn == 24 ? 1 : (tn == 25 ? 4 : 5); }
    gemm_tile<true>(XM + (size_t)sel * SZ_ACT + (size_t)tm * 128 * 1024, 1024, Bt + (size_t)tn * 128 * 1024, 1024, 1024, lds, [&](ACC_T, int r0, int c0) __attribute__((always_inline)) {
      if (kind == 1) {
        const int cb = (tn - 8) * 128 + c0;
#pragma unroll
        for (int mi = 0; mi < 4; ++mi) {
          const int row = tm * 128 + r0 + mi * 16 + l15;
          f32x4 kk[4]; float ss = 0.f;
#pragma unroll
          for (int ni = 0; ni < 4; ++ni) {
            const int col = cb + ni * 16 + quad * 4;
            const f32x4 kkw = *(const f32x4*)(k_k + col);
            kk[ni] = acc[mi][ni] * kkw;
            ss += kk[ni][0] * kk[ni][0] + kk[ni][1] * kk[ni][1] + kk[ni][2] * kk[ni][2] + kk[ni][3] * kk[ni][3];
            *(f32x4*)(Kb + (size_t)row * 1024 + col) = acc[mi][ni];
          }
          ss += __shfl_xor(ss, 16); ss += __shfl_xor(ss, 32);
          const float rn = rsqrtf(ss + 1e-12f);
#pragma unroll
          for (int ni = 0; ni < 4; ++ni) *(f32x4*)(KK + (size_t)row * 1024 + cb + ni * 16 + quad * 4) = kk[ni] * rn;
          __builtin_amdgcn_sched_barrier(0);
        }
      } else if (kind == 3) {
        const int cb = (tn - 24) * 128 + c0;
#pragma unroll
        for (int mi = 0; mi < 4; ++mi)
#pragma unroll
          for (int ni = 0; ni < 4; ++ni) {
            const int row = tm * 128 + r0 + mi * 16 + l15, col = cb + ni * 16 + quad * 4;
            f32x4 v = acc[mi][ni];
            if (tn == 24) { v[0] = tanhf(v[0]); v[1] = tanhf(v[1]); v[2] = tanhf(v[2]); v[3] = tanhf(v[3]); }
            else if (tn == 26) { v[0] = sigmoidf_(v[0]); v[1] = sigmoidf_(v[1]); v[2] = sigmoidf_(v[2]); v[3] = sigmoidf_(v[3]); }
            *(uint2*)(LB + (size_t)row * 384 + col) = make_uint2(pack2(v[0], v[1]), pack2(v[2], v[3]));
            __builtin_amdgcn_sched_barrier(0);
          }
      } else {
        float* dst = kind == 0 ? R : V;
        const int cb = (kind == 0 ? tn : tn - 16) * 128 + c0;
#pragma unroll
        for (int mi = 0; mi < 4; ++mi)
#pragma unroll
          for (int ni = 0; ni < 4; ++ni)
            *(f32x4*)(dst + (size_t)(tm * 128 + r0 + mi * 16 + l15) * 1024 + cb + ni * 16 + quad * 4) = acc[mi][ni];
      }
    });
  }
}

__device__ __forceinline__ void phase_rwkv_gemm2(const Params& p, char* lds) {
  PH_BEGIN
  LANE_VARS
  const bf16_t* LB = (const bf16_t*)(ws_ + OFF_LB);
  const float* Kb = (const float*)(ws_ + OFF_K); const float* KK = (const float*)(ws_ + OFF_KK);
  float* WD = (float*)(ws_ + OFF_WDEC); float* G = (float*)(ws_ + OFF_G);
  bf16_t* KE = (bf16_t*)(ws_ + OFF_KEFF); bf16_t* NB = (bf16_t*)(ws_ + OFF_NB);
  const float* k_a = p.in[30];
  for (int t = bid_; t < 48 * 40; t += gridDim.x) {
    const int tm = t % 48, tq = t / 48, grp = tq >> 3, tn = tq & 7;
    const bf16_t* Bt; int K;
    if (grp < 2) { Bt = (const bf16_t*)(ws_ + OFF_RWW2T) + (size_t)grp * 1024 * 64; K = 64; }
    else if (grp < 4) { Bt = (const bf16_t*)(ws_ + OFF_RWA2T) + (size_t)(grp - 2) * 1024 * 64; K = 64; }
    else { Bt = (const bf16_t*)(ws_ + OFF_RWG2T); K = 128; }
    gemm_tile<true>(LB + (size_t)tm * 128 * 384 + grp * 64, 384, Bt + (size_t)tn * 128 * K, K, K, lds, [&](ACC_T, int r0, int c0) __attribute__((always_inline)) {
#pragma unroll
      for (int mi = 0; mi < 4; ++mi)
#pragma unroll
        for (int ni = 0; ni < 4; ++ni) {
          const int row = tm * 128 + r0 + mi * 16 + l15, col = tn * 128 + c0 + ni * 16 + quad * 4;
          const size_t idx = (size_t)row * 1024 + col;
          f32x4 v = acc[mi][ni];
          if (grp < 2) {
            const f32x4 w0 = *(const f32x4*)(p.in[21] + grp * 1024 + col);
            auto dec = [](float w0v, float vv) {
              const float z = -(w0v + vv);
              const float sp = fmaxf(z, 0.f) + __logf(1.f + __expf(-fabsf(z)));
              return __expf(-__expf(-sp - 0.5f));
            };
            *(f32x4*)(WD + (size_t)grp * SZ_ACT + idx) = (f32x4){dec(w0[0], v[0]), dec(w0[1], v[1]), dec(w0[2], v[2]), dec(w0[3], v[3])};
          } else if (grp < 4) {
            const int d = grp - 2;
            const f32x4 a0 = *(const f32x4*)(p.in[24] + d * 1024 + col), ka = *(const f32x4*)(k_a + col);
            const f32x4 kv = *(const f32x4*)(Kb + idx), kkv = *(const f32x4*)(KK + idx);
            const f32x4 a = (f32x4){sigmoidf_(a0[0] + v[0]), sigmoidf_(a0[1] + v[1]), sigmoidf_(a0[2] + v[2]), sigmoidf_(a0[3] + v[3])};
            const f32x4 ke = kv * (1.f + (a - 1.f) * ka);
            const f32x4 nb = -kkv * a;
            *(uint2*)(KE + (size_t)d * SZ_ACT + idx) = make_uint2(pack2(ke[0], ke[1]), pack2(ke[2], ke[3]));
            *(uint2*)(NB + (size_t)d * SZ_ACT + idx) = make_uint2(pack2(nb[0], nb[1]), pack2(nb[2], nb[3]));
          } else {
            *(f32x4*)(G + idx) = v;
          }
          __builtin_amdgcn_sched_barrier(0);
        }
    });
  }
}

__device__ __forceinline__ void phase_mla_up(const Params& p, char* lds) {
  PH_BEGIN
  LANE_VARS
  const bf16_t* QN = (const bf16_t*)(ws_ + OFF_QN);
  const bf16_t* CK = (const bf16_t*)(ws_ + OFF_CKVALL);
  bf16_t* Q = (bf16_t*)(ws_ + OFF_Q); bf16_t* KN = (bf16_t*)(ws_ + OFF_KN); bf16_t* VT = (bf16_t*)(ws_ + OFF_VT);
  const float qs = 0.07216878364870323f * 1.4426950408889634f;
  for (int t = bid_; t < 576 + 416 + 416; t += gridDim.x) {
    if (t < 576) {
      const int tm = t % 48, tn = t / 48;
      gemm_tile<true>(QN + (size_t)tm * 128 * 384, 384, (const bf16_t*)(ws_ + OFF_MUQT) + (size_t)tn * 128 * 384, 384, 384, lds, [&](ACC_T, int r0, int c0) __attribute__((always_inline)) {
        const int cb = tn * 128 + c0;
        const bool ropeblk = (cb % 192) == 128;
#pragma unroll
        for (int mi = 0; mi < 4; ++mi) {
          const int row = tm * 128 + r0 + mi * 16 + l15;
          f32x4 v[4];
#pragma unroll
          for (int ni = 0; ni < 4; ++ni) v[ni] = acc[mi][ni] * qs;
          if (ropeblk && row >= 4096) {
            const int pp = (row - 4096) & 1023;
#pragma unroll
            for (int ax = 0; ax < 2; ++ax) {
              const float posv = ax ? (float)(pp & 63) : (float)(pp >> 6);
#pragma unroll
              for (int j = 0; j < 4; ++j) {
                const float inv = exp2f(-(float)(quad * 4 + j) * 0.8304820237218406f);
                const float rev = posv * inv * 0.15915494309189535f;
                const float sn = __builtin_amdgcn_sinf(rev), cs = __builtin_amdgcn_cosf(rev);
                const float x1 = v[2 * ax][j], x2 = v[2 * ax + 1][j];
                v[2 * ax][j] = x1 * cs - x2 * sn; v[2 * ax + 1][j] = x1 * sn + x2 * cs;
              }
            }
          }
#pragma unroll
          for (int ni = 0; ni < 4; ++ni)
            *(uint2*)(Q + (size_t)row * 1536 + cb + ni * 16 + quad * 4) = make_uint2(pack2(v[ni][0], v[ni][1]), pack2(v[ni][2], v[ni][3]));
        }
      });
    } else if (t < 576 + 416) {
      const int u = t - 576, tm = u % 52, tn = u / 52;
      gemm_tile<true>(CK + (size_t)tm * 128 * 256, 256, (const bf16_t*)(ws_ + OFF_MUKT) + (size_t)tn * 128 * 256, 256, 256, lds, [&](ACC_T, int r0, int c0) __attribute__((always_inline)) {
#pragma unroll
        for (int mi = 0; mi < 4; ++mi)
#pragma unroll
          for (int ni = 0; ni < 4; ++ni) {
            const f32x4 v = acc[mi][ni];
            *(uint2*)(KN + (size_t)(tm * 128 + r0 + mi * 16 + l15) * 1024 + tn * 128 + c0 + ni * 16 + quad * 4) = make_uint2(pack2(v[0], v[1]), pack2(v[2], v[3]));
          }
      });
    } else {
      const int u = t - 576 - 416, tm = u % 52, tn = u / 52;
      const int krow = tm * 128;
      bf16_t* base; int ldv, kp0;
      if (krow < 4096) { base = VT + (size_t)(krow >> 8) * 262144; ldv = 256; kp0 = krow & 255; }
      else { const int r = krow - 4096, s2 = r / 1280; base = VT + 4194304 + (size_t)s2 * 1310720; ldv = 1280; kp0 = r - s2 * 1280; }
      gemm_tile<false>(CK + (size_t)tm * 128 * 256, 256, (const bf16_t*)(ws_ + OFF_MUVT) + (size_t)tn * 128 * 256, 256, 256, lds, [&](ACC_T, int r0, int c0) __attribute__((always_inline)) {
#pragma unroll
        for (int mi = 0; mi < 4; ++mi)
#pragma unroll
          for (int ni = 0; ni < 4; ++ni) {
            const f32x4 v = acc[mi][ni];
            const int n = tn * 128 + c0 + ni * 16 + l15, kp = kp0 + r0 + mi * 16 + quad * 4;
            *(uint2*)(base + (size_t)n * ldv + kp) = make_uint2(pack2(v[0], v[1]), pack2(v[2], v[3]));
          }
      });
    }
  }
}

__device__ __forceinline__ void phase_scan(const Params& p, char* lds) {
  PH_BEGIN
  const int tid = tid_, lane = tid & 63, wid = tid >> 6;
  unsigned* ctr = (unsigned*)(ws_ + OFF_CTR);
  const float* R = (const float*)(ws_ + OFF_R); const float* V = (const float*)(ws_ + OFF_V); const float* KK = (const float*)(ws_ + OFF_KK);
  volatile int& s_item = *(volatile int*)(lds + 57344);
  float* vb = (float*)lds;
  float* yb = (float*)(lds + 49152);
  const int vrow = wid * 16 + (lane >> 2), kq = lane & 3;
  const int lsi = tid >> 4, lc4 = (tid & 15) * 4;
  for (;;) {
    if (tid == 0) s_item = (int)atomicAdd(ctr, 1u);
    __syncthreads();
    const int item = s_item;
    __syncthreads();
    if (item >= 576) break;
    int n, tok0, h, dir; const float* sinit = nullptr; float* sfin = nullptr;
    if (item < 64) { const int s2 = item >> 5; h = (item >> 1) & 15; dir = item & 1; n = 1024; tok0 = 4096 + s2 * 1024; sinit = p.in[2] + (size_t)((s2 * 2 + dir) * 16 + h) * 4096; }
    else { const int j = item - 64, s = j >> 5; h = (j >> 1) & 15; dir = j & 1; n = 256; tok0 = s * 256; sfin = p.out + OUT_STATE + (size_t)((s * 2 + dir) * 16 + h) * 4096; }
    const float* WD = (const float*)(ws_ + OFF_WDEC) + (size_t)dir * SZ_ACT;
    const bf16_t* KE = (const bf16_t*)(ws_ + OFF_KEFF) + (size_t)dir * SZ_ACT;
    const bf16_t* NB = (const bf16_t*)(ws_ + OFF_NB) + (size_t)dir * SZ_ACT;
    float* Y = (float*)(ws_ + (dir ? OFF_Y1 : OFF_Y0));
    f32x2 S[8];
#pragma unroll
    for (int i = 0; i < 8; ++i) S[i] = sinit ? *(const f32x2*)(sinit + vrow * 64 + kq * 16 + 2 * i) : (f32x2){0.f, 0.f};
    const int nch = n >> 4;
    f32x4 lr, lw, lke, lkk, lnb, lv;
    auto gload = [&](int c) {
      const int tt = c * 16 + lsi, tm = dir ? (n - 1 - tt) : tt;
      const size_t idx = (size_t)(tok0 + tm) * 1024 + h * 64 + lc4;
      lr = *(const f32x4*)(R + idx); lw = *(const f32x4*)(WD + idx); lkk = *(const f32x4*)(KK + idx); lv = *(const f32x4*)(V + idx);
      const uint2 a = *(const uint2*)(KE + idx), b = *(const uint2*)(NB + idx);
      lke = (f32x4){bflo(a.x), bfhi(a.x), bflo(a.y), bfhi(a.y)};
      lnb = (f32x4){bflo(b.x), bfhi(b.x), bflo(b.y), bfhi(b.y)};
    };
    auto lstore = [&](int buf) {
      float* d = vb + buf * 6144 + lsi * 384 + lc4;
      *(f32x4*)(d) = lr; *(f32x4*)(d + 64) = lw; *(f32x4*)(d + 128) = lke; *(f32x4*)(d + 192) = lkk; *(f32x4*)(d + 256) = lnb; *(f32x4*)(d + 320) = lv;
    };
    gload(0); lstore(0);
    __syncthreads();
    for (int c = 0; c < nch; ++c) {
      const int buf = c & 1;
      if (c + 1 < nch) gload(c + 1);
      const float* cb = vb + buf * 6144;
      float* ycb = yb + buf * 1024;
#pragma unroll 4
      for (int s = 0; s < 16; ++s) {
        const float* sv = cb + s * 384 + kq * 16;
        f32x2 a2 = {0.f, 0.f};
#pragma unroll
        for (int i = 0; i < 4; ++i) {
          const f32x4 k4 = *(const f32x4*)(sv + 192 + 4 * i);
          a2 += S[2 * i] * (f32x2){k4[0], k4[1]};
          a2 += S[2 * i + 1] * (f32x2){k4[2], k4[3]};
        }
        const float sa = quad_sum(a2[0] + a2[1]);
        const float vv = cb[s * 384 + 320 + vrow];
        const f32x2 sa2 = {sa, sa}, vv2 = {vv, vv};
        f32x2 y2 = {0.f, 0.f};
#pragma unroll
        for (int i = 0; i < 4; ++i) {
          const f32x4 w4 = *(const f32x4*)(sv + 64 + 4 * i), b4 = *(const f32x4*)(sv + 256 + 4 * i), e4 = *(const f32x4*)(sv + 128 + 4 * i), r4 = *(const f32x4*)(sv + 4 * i);
          S[2 * i] = S[2 * i] * (f32x2){w4[0], w4[1]} + sa2 * (f32x2){b4[0], b4[1]} + vv2 * (f32x2){e4[0], e4[1]};
          S[2 * i + 1] = S[2 * i + 1] * (f32x2){w4[2], w4[3]} + sa2 * (f32x2){b4[2], b4[3]} + vv2 * (f32x2){e4[2], e4[3]};
          y2 += S[2 * i] * (f32x2){r4[0], r4[1]};
          y2 += S[2 * i + 1] * (f32x2){r4[2], r4[3]};
        }
        const float y = quad_sum(y2[0] + y2[1]);
        if (kq == 0) ycb[s * 64 + vrow] = y;
      }
      if (c + 1 < nch) lstore(buf ^ 1);
      __syncthreads();
      {
        const int tt = c * 16 + lsi, tm = dir ? (n - 1 - tt) : tt;
        *(f32x4*)(Y + (size_t)(tok0 + tm) * 1024 + h * 64 + lc4) = *(const f32x4*)(ycb + lsi * 64 + lc4);
      }
    }
    if (sfin) {
#pragma unroll
      for (int i = 0; i < 8; ++i) *(f32x2*)(sfin + vrow * 64 + kq * 16 + 2 * i) = S[i];
    }
    __syncthreads();
  }
}

__device__ __forceinline__ void phase_attn(const Params& p) {
  PH_BEGIN
  const int lane = tid_ & 63, l15 = lane & 15, quad = lane >> 4;
  unsigned* ctr = (unsigned*)(ws_ + OFF_CTR) + 1;
  const bf16_t* Q = (const bf16_t*)(ws_ + OFF_Q); const bf16_t* KN = (const bf16_t*)(ws_ + OFF_KN);
  const bf16_t* KR = (const bf16_t*)(ws_ + OFF_KRALL); const bf16_t* VT = (const bf16_t*)(ws_ + OFF_VT);
  bf16_t* OA = (bf16_t*)(ws_ + OFF_H);
  for (;;) {
    int item = 0;
    if (lane == 0) item = (int)atomicAdd(ctr, 1u);
    item = __builtin_amdgcn_readfirstlane(item);
    if (item >= 3072) break;
    int h, qrow0, nkeys, keybase; const bf16_t* vt;
    if (item < 1024) { const int s2 = item >> 9; h = (item >> 6) & 7; qrow0 = 4096 + s2 * 1024 + (item & 63) * 16; nkeys = 1280; keybase = 4096 + s2 * 1280; vt = VT + 4194304 + (size_t)s2 * 1310720; }
    else { const int j = item - 1024, s = j >> 7; h = (j >> 4) & 7; qrow0 = s * 256 + (j & 15) * 16; nkeys = 256; keybase = s * 256; vt = VT + (size_t)s * 262144; }
    vt += (size_t)(h * 128) * nkeys;
    bf16x8 qf[6];
#pragma unroll
    for (int ks = 0; ks < 6; ++ks) qf[ks] = *(const bf16x8*)(Q + (size_t)(qrow0 + l15) * 1536 + h * 192 + ks * 32 + quad * 8);
    f32x4 oacc[8];
#pragma unroll
    for (int i = 0; i < 8; ++i) oacc[i] = (f32x4){0.f, 0.f, 0.f, 0.f};
    float m = -1e30f, lsum = 0.f;
    for (int c = 0; c < nkeys; c += 32) {
      f32x4 st[2];
#pragma unroll
      for (int kt = 0; kt < 2; ++kt) {
        const size_t kr = (size_t)(keybase + c + kt * 16 + l15);
        st[kt] = (f32x4){0.f, 0.f, 0.f, 0.f};
#pragma unroll
        for (int ks = 0; ks < 4; ++ks) {
          const bf16x8 kf = *(const bf16x8*)(KN + kr * 1024 + h * 128 + ks * 32 + quad * 8);
          st[kt] = __builtin_amdgcn_mfma_f32_16x16x32_bf16(kf, qf[ks], st[kt], 0, 0, 0);
        }
#pragma unroll
        for (int ks = 0; ks < 2; ++ks) {
          const bf16x8 kf = *(const bf16x8*)(KR + kr * 64 + ks * 32 + quad * 8);
          st[kt] = __builtin_amdgcn_mfma_f32_16x16x32_bf16(kf, qf[4 + ks], st[kt], 0, 0, 0);
        }
      }
      float cm = fmaxf(fmaxf(fmaxf(st[0][0], st[0][1]), fmaxf(st[0][2], st[0][3])), fmaxf(fmaxf(st[1][0], st[1][1]), fmaxf(st[1][2], st[1][3])));
      cm = fmaxf(cm, __shfl_xor(cm, 16)); cm = fmaxf(cm, __shfl_xor(cm, 32));
      const float mn = fmaxf(m, cm), alpha = exp2f(m - mn);
      m = mn;
      float ps = 0.f; float pv[8];
#pragma unroll
      for (int e = 0; e < 8; ++e) { pv[e] = exp2f(st[e >> 2][e & 3] - mn); ps += pv[e]; }
      lsum = lsum * alpha + ps;
      union { bf16x8 v; unsigned u[4]; } pb;
      pb.u[0] = pack2(pv[0], pv[1]); pb.u[1] = pack2(pv[2], pv[3]); pb.u[2] = pack2(pv[4], pv[5]); pb.u[3] = pack2(pv[6], pv[7]);
#pragma unroll
      for (int dvt = 0; dvt < 8; ++dvt) {
        const bf16_t* vp = vt + (size_t)(dvt * 16 + l15) * nkeys + c + quad * 4;
        union { bf16x8 v; uint2 u[2]; } vf;
        vf.u[0] = *(const uint2*)vp; vf.u[1] = *(const uint2*)(vp + 16);
        oacc[dvt] = __builtin_amdgcn_mfma_f32_16x16x32_bf16(vf.v, pb.v, oacc[dvt] * alpha, 0, 0, 0);
      }
    }
    lsum += __shfl_xor(lsum, 16); lsum += __shfl_xor(lsum, 32);
    const float il = 1.f / lsum;
#pragma unroll
    for (int dvt = 0; dvt < 8; ++dvt) {
      const f32x4 o = oacc[dvt] * il;
      *(uint2*)(OA + (size_t)(qrow0 + l15) * 1024 + h * 128 + dvt * 16 + quad * 4) = make_uint2(pack2(o[0], o[1]), pack2(o[2], o[3]));
    }
  }
}

#define SC_TOL 0.2f
#define DBG_MIXER_UPD true
#define SKIPMASK 0x0ull
#ifdef SELFCHECK
__device__ __forceinline__ unsigned hsh(unsigned x) { x ^= x >> 16; x *= 0x7feb352dU; x ^= x >> 15; x *= 0x846ca68bU; x ^= x >> 16; return x; }
__device__ __forceinline__ float b2f(bf16_t h) { return __uint_as_float(((unsigned)h) << 16); }
__device__ __forceinline__ void rep(const Params& p, int id, float got, float ref, float atol) {
  float e = fabsf(got - ref) / (fabsf(ref) + atol);
  if (!(e == e) || e > 1e9f) e = 1e9f;
  atomicMax((unsigned*)(p.ws + OFF_CTR) + 8 + id, __float_as_uint(e));
}
__device__ __forceinline__ float dotA(const bf16_t* a, const float* w, int ldw, int K) { float s = 0.f; for (int k = 0; k < K; ++k) s += b2f(a[k]) * w[(size_t)k * ldw]; return s; }
#define GID (bid_ * 256 + tid_)
#define NTHR (gridDim.x * 256)
__device__ __forceinline__ int seq_start(int row) { return row < 4096 ? (row & ~255) : 4096 + ((row - 4096) & ~1023); }
__device__ __forceinline__ int seq_len(int row) { return row < 4096 ? 256 : 1024; }
__device__ __forceinline__ int key_row(int row) { if (row < 4096) return row; const int r = row - 4096; return 4096 + (r >> 10) * 1280 + 256 + (r & 1023); }

__device__ __forceinline__ void chk_modv(const Params& p) {
  PH_BEGIN
  for (int i = GID; i < 4 * 3 * 6144; i += NTHR) {
    const int l = i / 18432, g = (i / 6144) % 3, n = i % 6144;
    float s = 0.f;
    for (int k = 0; k < 1024; ++k) { const float c = g == 0 ? p.in[6][k] : p.in[5][(g - 1) * 1024 + k]; s += c / (1.f + expf(-c)) * p.in[7][((size_t)l * 1024 + k) * 6144 + n]; }
    rep(p, 0, ((const float*)(ws_ + OFF_MOD))[i], s + p.in[8][l * 6144 + n], 0.2f);
  }
}
__device__ __forceinline__ void chk_h(const Params& p, int id, int l, int gi, int shi) {
  PH_BEGIN
  const int s = GID; if (s >= 512) return;
  const int row = hsh(s * 2 + id * 7919) % 6144, col = hsh(s * 2 + 1 + id * 7919) & 1023, g = row_group(row);
  const float* x = p.out + (size_t)row * 1024;
  float ss = 0.f; for (int k = 0; k < 1024; ++k) ss += x[k] * x[k];
  const float rs = 1.f / sqrtf(ss / 1024.f + 1e-6f);
  const float* mv = (const float*)(ws_ + OFF_MOD) + ((l * 3 + g) * 6 + shi) * 1024;
  const float ref = x[col] * rs * p.in[9][(l * 4 + gi) * 1024 + col] * (1.f + mv[1024 + col]) + mv[col];
  rep(p, id, b2f(((const bf16_t*)(ws_ + OFF_H))[(size_t)row * 1024 + col]), ref, 0.3f);
}
__device__ __forceinline__ void chk_o(const Params& p, int id, const bf16_t* A, int K, const float* W) {
  PH_BEGIN
  const int s = GID; if (s >= 512) return;
  const int row = hsh(s * 2 + id * 7919) % 6144, col = hsh(s * 2 + 1 + id * 7919) & 1023;
  rep(p, id, ((const float*)(ws_ + OFF_O))[(size_t)row * 1024 + col], dotA(A + (size_t)row * K, W + col, 1024, K), 0.3f);
}
__device__ __forceinline__ void chk_hid(const Params& p, int id, int l) {
  PH_BEGIN
  const int s = GID; if (s >= 512) return;
  const int row = hsh(s * 2 + id * 7919) % 6144, col = hsh(s * 2 + 1 + id * 7919) & 4095;
  float d = dotA((const bf16_t*)(ws_ + OFF_H) + (size_t)row * 1024, p.in[10] + (size_t)l * 1024 * 4096 + col, 4096, 1024);
  d = fmaxf(d, 0.f); d *= d;
  rep(p, id, b2f(((const bf16_t*)(ws_ + OFF_HID))[(size_t)row * 4096 + col]), d, 0.5f);
}
__device__ __forceinline__ void chk_fft(const Params& p, int id) {
  PH_BEGIN
  const int s = GID; if (s >= 128) return;
  const int row = hsh(s * 2 + id * 7919) % 6144, col = hsh(s * 2 + 1 + id * 7919) & 1023;
  const int s0 = seq_start(row), n = seq_len(row), tp = row - s0, g = col >> 7, cp = col & 127;
  const bf16_t* H = (const bf16_t*)(ws_ + OFF_H);
  float acc = 0.f;
  for (int t = 0; t < n; ++t) {
    const float a = (float)((t * tp) % n) / (float)n;
    for (int c = 0; c < 128; ++c) {
      const float b = (float)((c * cp) & 127) / 128.f;
      acc += b2f(H[(size_t)(s0 + t) * 1024 + g * 128 + c]) * cosf(6.283185307179586f * (a + b));
    }
  }
  rep(p, id, b2f(((const bf16_t*)(ws_ + OFF_F))[(size_t)row * 1024 + col]), acc / sqrtf(128.f * n), 0.3f);
}
__device__ __forceinline__ void chk_bcu(const Params& p, int id) {
  PH_BEGIN
  const int s = GID; if (s >= 512) return;
  const int row = hsh(s * 2 + id * 7919) % 6144, col = hsh(s * 2 + 1 + id * 7919) % 3072;
  rep(p, id, b2f(((const bf16_t*)(ws_ + OFF_BCU))[(size_t)row * 3072 + col]), dotA((const bf16_t*)(ws_ + OFF_H) + (size_t)row * 1024, p.in[13] + col, 3072, 1024), 0.3f);
}
__device__ __forceinline__ void chk_a2(const Params& p, int id) {
  PH_BEGIN
  const int s = GID; if (s >= 512) return;
  const int row = hsh(s * 2 + id * 7919) % 6144, col = hsh(s * 2 + 1 + id * 7919) & 1023;
  const bf16_t* B = (const bf16_t*)(ws_ + OFF_BCU);
  const int pos = row - seq_start(row), n = seq_len(row);
  auto z = [&](int r) { return b2f(B[(size_t)r * 3072 + 1024 + col]) * b2f(B[(size_t)r * 3072 + 2048 + col]); };
  float cv = z(row) * p.in[14][1024 + col];
  if (pos > 0) cv += z(row - 1) * p.in[14][col];
  if (pos < n - 1) cv += z(row + 1) * p.in[14][2048 + col];
  rep(p, id, b2f(((const bf16_t*)(ws_ + OFF_A2))[(size_t)row * 1024 + col]), b2f(B[(size_t)row * 3072 + col]) * cv, 0.3f);
}
__device__ __forceinline__ void chk_xm(const Params& p, int id) {
  PH_BEGIN
  const int s = GID; if (s >= 512) return;
  const int row = hsh(s * 2 + id * 7919) % 6144, col = hsh(s * 2 + 1 + id * 7919) & 1023, m = s % 6, g = row_group(row);
  const int pos = row - seq_start(row), n = seq_len(row);
  const float* mv = (const float*)(ws_ + OFF_MOD) + ((2 * 3 + g) * 6 + 0) * 1024;
  auto hval = [&](int r) {
    const float* x = p.out + (size_t)r * 1024; float ss = 0.f; for (int k = 0; k < 1024; ++k) ss += x[k] * x[k];
    return x[col] / sqrtf(ss / 1024.f + 1e-6f) * p.in[9][(2 * 4 + 0) * 1024 + col] * (1.f + mv[1024 + col]) + mv[col]; };
  const float hc = hval(row), hp = pos > 0 ? hval(row - 1) : 0.f, hn = pos < n - 1 ? hval(row + 1) : 0.f;
  const float ref = hc + (0.5f * (hp + hn) - hc) * p.in[16][m * 1024 + col];
  rep(p, id, b2f(((const bf16_t*)(ws_ + OFF_XM))[(size_t)m * SZ_ACT + (size_t)row * 1024 + col]), ref, 0.3f);
}
__device__ __forceinline__ void chk_rw1(const Params& p, int id0) {
  PH_BEGIN
  const int s = GID; if (s >= 512) return;
  const int row = hsh(s * 2 + id0 * 7919) % 6144, col = hsh(s * 2 + 1 + id0 * 7919) & 1023;
  const bf16_t* XM = (const bf16_t*)(ws_ + OFF_XM);
  rep(p, id0 + 0, ((const float*)(ws_ + OFF_R))[(size_t)row * 1024 + col], dotA(XM + 0 * SZ_ACT + (size_t)row * 1024, p.in[17] + col, 1024, 1024), 0.3f);
  rep(p, id0 + 1, ((const float*)(ws_ + OFF_K))[(size_t)row * 1024 + col], dotA(XM + 2 * SZ_ACT + (size_t)row * 1024, p.in[18] + col, 1024, 1024), 0.3f);
  rep(p, id0 + 2, ((const float*)(ws_ + OFF_V))[(size_t)row * 1024 + col], dotA(XM + 3 * SZ_ACT + (size_t)row * 1024, p.in[19] + col, 1024, 1024), 0.3f);
  const int lc = col % 384; float lr;
  if (lc < 128) lr = tanhf(dotA(XM + 1 * SZ_ACT + (size_t)row * 1024, p.in[22] + (size_t)(lc >> 6) * 1024 * 64 + (lc & 63), 64, 1024));
  else if (lc < 256) lr = dotA(XM + 4 * SZ_ACT + (size_t)row * 1024, p.in[25] + (size_t)((lc - 128) >> 6) * 1024 * 64 + (lc & 63), 64, 1024);
  else { lr = dotA(XM + 5 * SZ_ACT + (size_t)row * 1024, p.in[27] + (lc - 256), 128, 1024); lr = 1.f / (1.f + expf(-lr)); }
  rep(p, id0 + 3, b2f(((const bf16_t*)(ws_ + OFF_LB))[(size_t)row * 384 + lc]), lr, 0.2f);
  const float* Kb = (const float*)(ws_ + OFF_K) + (size_t)row * 1024 + (col & ~63);
  float ss = 0.f; for (int c = 0; c < 64; ++c) { const float v = Kb[c] * p.in[29][(col & ~63) + c]; ss += v * v; }
  rep(p, id0 + 4, ((const float*)(ws_ + OFF_KK))[(size_t)row * 1024 + col], Kb[col & 63] * p.in[29][col] / sqrtf(ss + 1e-12f), 0.03f);
}
__device__ __forceinline__ void chk_rw2(const Params& p, int id0) {
  PH_BEGIN
  const int s = GID; if (s >= 512) return;
  const int row = hsh(s * 2 + id0 * 7919) % 6144, col = hsh(s * 2 + 1 + id0 * 7919) & 1023, d = s & 1;
  const bf16_t* LB = (const bf16_t*)(ws_ + OFF_LB) + (size_t)row * 384;
  const size_t idx = (size_t)row * 1024 + col;
  const float z = p.in[21][d * 1024 + col] + dotA(LB + d * 64, p.in[23] + (size_t)d * 64 * 1024 + col, 1024, 64);
  const float logw = -log1pf(expf(-z)) - 0.5f;
  rep(p, id0 + 0, ((const float*)(ws_ + OFF_WDEC))[(size_t)d * SZ_ACT + idx], expf(-expf(logw)), 0.2f);
  const float a = 1.f / (1.f + expf(-(p.in[24][d * 1024 + col] + dotA(LB + 128 + d * 64, p.in[26] + (size_t)d * 64 * 1024 + col, 1024, 64))));
  const float kv = ((const float*)(ws_ + OFF_K))[idx], kkv = ((const float*)(ws_ + OFF_KK))[idx];
  rep(p, id0 + 1, b2f(((const bf16_t*)(ws_ + OFF_KEFF))[(size_t)d * SZ_ACT + idx]), kv * (1.f + (a - 1.f) * p.in[30][col]), 0.3f);
  rep(p, id0 + 2, b2f(((const bf16_t*)(ws_ + OFF_NB))[(size_t)d * SZ_ACT + idx]), -kkv * a, 0.02f);
  rep(p, id0 + 3, ((const float*)(ws_ + OFF_G))[idx], dotA(LB + 256, p.in[28] + col, 1024, 128), 0.2f);
}
__device__ __forceinline__ void chk_scan(const Params& p, int id0) {
  PH_BEGIN
  const int s = GID; if (s >= 64) return;
  const int item = s < 8 ? s * 7 : 64 + (hsh(s) % 512), v = hsh(s + 77) & 63;
  int n, tok0, h, dir; const float* sinit = nullptr; const float* sfin = nullptr;
  if (item < 64) { const int s2 = item >> 5; h = (item >> 1) & 15; dir = item & 1; n = 1024; tok0 = 4096 + s2 * 1024; sinit = p.in[2] + (size_t)((s2 * 2 + dir) * 16 + h) * 4096; }
  else { const int j = item - 64, sq = j >> 5; h = (j >> 1) & 15; dir = j & 1; n = 256; tok0 = sq * 256; sfin = p.out + OUT_STATE + (size_t)((sq * 2 + dir) * 16 + h) * 4096; }
  const float* R = (const float*)(ws_ + OFF_R); const float* V = (const float*)(ws_ + OFF_V); const float* KK = (const float*)(ws_ + OFF_KK);
  const float* WD = (const float*)(ws_ + OFF_WDEC) + (size_t)dir * SZ_ACT;
  const bf16_t* KE = (const bf16_t*)(ws_ + OFF_KEFF) + (size_t)dir * SZ_ACT; const bf16_t* NB = (const bf16_t*)(ws_ + OFF_NB) + (size_t)dir * SZ_ACT;
  const float* Y = (const float*)(ws_ + (dir ? OFF_Y1 : OFF_Y0));
  float S[64];
#pragma unroll
  for (int k = 0; k < 64; ++k) S[k] = sinit ? sinit[v * 64 + k] : 0.f;
  for (int tt = 0; tt < n; ++tt) {
    const int t = dir ? n - 1 - tt : tt; const size_t b = (size_t)(tok0 + t) * 1024 + h * 64;
    float sa = 0.f;
#pragma unroll
    for (int k = 0; k < 64; ++k) sa += S[k] * KK[b + k];
    const float vv = V[b + v]; float y = 0.f;
#pragma unroll
    for (int k = 0; k < 64; ++k) { S[k] = S[k] * WD[b + k] + sa * b2f(NB[b + k]) + vv * b2f(KE[b + k]); y += S[k] * R[b + k]; }
    rep(p, id0, Y[b + v], y, 0.05f);
  }
  if (sfin) {
#pragma unroll
    for (int k = 0; k < 64; ++k) rep(p, id0 + 1, sfin[v * 64 + k], S[k], 0.05f);
  }
}
__device__ __forceinline__ void chk_z(const Params& p, int id) {
  PH_BEGIN
  const int s = GID; if (s >= 512) return;
  const int row = hsh(s * 2 + id * 7919) % 6144, col = hsh(s * 2 + 1 + id * 7919) & 1023, hb = col & ~63;
  const size_t b = (size_t)row * 1024 + hb;
  const float* Y0 = (const float*)(ws_ + OFF_Y0); const float* Y1 = (const float*)(ws_ + OFF_Y1); const float* R = (const float*)(ws_ + OFF_R);
  const bf16_t* KE = (const bf16_t*)(ws_ + OFF_KEFF);
  float mean = 0.f, bon = 0.f;
  for (int c = 0; c < 64; ++c) { mean += Y0[b + c] + Y1[b + c]; bon += R[b + c] * (b2f(KE[b + c]) + b2f(KE[SZ_ACT + b + c])) * p.in[31][hb + c]; }
  mean /= 64.f; float var = 0.f;
  for (int c = 0; c < 64; ++c) { const float d = Y0[b + c] + Y1[b + c] - mean; var += d * d; }
  var /= 64.f;
  const size_t i = (size_t)row * 1024 + col;
  const float ref = ((Y0[i] + Y1[i] - mean) / sqrtf(var + 64e-5f) * p.in[32][col] + p.in[33][col] + bon * ((const float*)(ws_ + OFF_V))[i]) * ((const float*)(ws_ + OFF_G))[i];
  rep(p, id, b2f(((const bf16_t*)(ws_ + OFF_H))[i]), ref, 0.2f);
}
__device__ __forceinline__ void chk_qc(const Params& p, int id) {
  PH_BEGIN
  const int s = GID; if (s >= 512) return;
  const int row = hsh(s * 2 + id * 7919) % 6144, col = hsh(s * 2 + 1 + id * 7919) % 704;
  const bf16_t* a = (const bf16_t*)(ws_ + OFF_H) + (size_t)row * 1024;
  const float ref = col < 384 ? dotA(a, p.in[34] + col, 384, 1024) : dotA(a, p.in[37] + (col - 384), 320, 1024);
  rep(p, id, ((const float*)(ws_ + OFF_QC))[(size_t)row * 704 + col], ref, 0.3f);
}
__device__ __forceinline__ float rope_ref(float x, float partner, int r  , int pp) {
  const int ax = r >> 5, part = (r >> 4) & 1, i = r & 15;
  const float ang = (ax ? (float)(pp & 63) : (float)(pp >> 6)) * powf(10000.f, -(float)i / 16.f);
  return part == 0 ? x * cosf(ang) - partner * sinf(ang) : partner * sinf(ang) + x * cosf(ang);
}
__device__ __forceinline__ void chk_mlarows(const Params& p, int id0) {
  PH_BEGIN
  const int s = GID; if (s >= 512) return;
  const int row = hsh(s * 2 + id0 * 7919) % 6144, c0 = hsh(s * 2 + 1 + id0 * 7919);
  const float* q = (const float*)(ws_ + OFF_QC) + (size_t)row * 704;
  float ss = 0.f; for (int k = 0; k < 384; ++k) ss += q[k] * q[k];
  int col = c0 % 384;
  rep(p, id0, b2f(((const bf16_t*)(ws_ + OFF_QN))[(size_t)row * 384 + col]), q[col] / sqrtf(ss / 384.f + 1e-6f) * p.in[35][col], 0.3f);
  ss = 0.f; for (int k = 0; k < 256; ++k) ss += q[384 + k] * q[384 + k];
  col = c0 & 255;
  const float cr = q[384 + col] / sqrtf(ss / 256.f + 1e-6f) * p.in[38][col];
  rep(p, id0 + 1, b2f(((const bf16_t*)(ws_ + OFF_CKVALL))[(size_t)key_row(row) * 256 + col]), cr, 0.3f);
  if (row < 4096) rep(p, id0 + 1, p.out[OUT_CKV + (size_t)row * 256 + col], cr, 0.3f);
  col = c0 & 63;
  float kr = q[640 + col];
  if (row >= 4096) kr = rope_ref(kr, q[640 + (col ^ 16)], col, (row - 4096) & 1023);
  else rep(p, id0 + 2, p.out[OUT_KROPE + (size_t)row * 64 + col], kr, 0.3f);
  rep(p, id0 + 2, b2f(((const bf16_t*)(ws_ + OFF_KRALL))[(size_t)key_row(row) * 64 + col]), kr, 0.3f);
}
__device__ __forceinline__ void chk_up(const Params& p, int id0) {
  PH_BEGIN
  const int s = GID; if (s >= 512) return;
  const int row = hsh(s * 2 + id0 * 7919) % 6144, c0 = hsh(s * 2 + 1 + id0 * 7919);
  const float qs = 0.07216878364870323f * 1.4426950408889634f;
  int col = c0 % 1536;
  const bf16_t* qn = (const bf16_t*)(ws_ + OFF_QN) + (size_t)row * 384;
  float d = dotA(qn, p.in[36] + col, 1536, 384) * qs;
  const int r = col % 192 - 128;
  if (r >= 0 && row >= 4096) d = rope_ref(d, dotA(qn, p.in[36] + (col ^ 16), 1536, 384) * qs, r, (row - 4096) & 1023);
  rep(p, id0, b2f(((const bf16_t*)(ws_ + OFF_Q))[(size_t)row * 1536 + col]), d, 0.03f);
  const int kr = hsh(s + 1234567) % 6656; col = c0 & 1023;
  const bf16_t* ck = (const bf16_t*)(ws_ + OFF_CKVALL) + (size_t)kr * 256;
  rep(p, id0 + 1, b2f(((const bf16_t*)(ws_ + OFF_KN))[(size_t)kr * 1024 + col]), dotA(ck, p.in[39] + col, 1024, 256), 0.3f);
  const bf16_t* VT = (const bf16_t*)(ws_ + OFF_VT);
  size_t vi;
  if (kr < 4096) vi = (size_t)(kr >> 8) * 262144 + (size_t)col * 256 + (kr & 255);
  else { const int rr = kr - 4096, s2 = rr / 1280; vi = 4194304 + (size_t)s2 * 1310720 + (size_t)col * 1280 + (rr - s2 * 1280); }
  rep(p, id0 + 2, b2f(VT[vi]), dotA(ck, p.in[40] + col, 1024, 256), 0.3f);
}
__device__ __forceinline__ void chk_attn(const Params& p, int id) {
  PH_BEGIN
  const int s = GID; if (s >= 128) return;
  const int row = hsh(s * 2 + id * 7919) % 6144, c0 = hsh(s * 2 + 1 + id * 7919), h = c0 & 7, dv = (c0 >> 3) & 127;
  int kb, nk; const bf16_t* vt;
  const bf16_t* VT = (const bf16_t*)(ws_ + OFF_VT);
  if (row < 4096) { kb = row & ~255; nk = 256; vt = VT + (size_t)(row >> 8) * 262144 + (size_t)(h * 128 + dv) * 256; }
  else { const int s2 = (row - 4096) >> 10; kb = 4096 + s2 * 1280; nk = 1280; vt = VT + 4194304 + (size_t)s2 * 1310720 + (size_t)(h * 128 + dv) * 1280; }
  const bf16_t* q = (const bf16_t*)(ws_ + OFF_Q) + (size_t)row * 1536 + h * 192;
  const bf16_t* KN = (const bf16_t*)(ws_ + OFF_KN); const bf16_t* KR = (const bf16_t*)(ws_ + OFF_KRALL);
  float m = -1e30f, l = 0.f, o = 0.f;
  for (int j = 0; j < nk; ++j) {
    float sc = 0.f;
    for (int d = 0; d < 128; ++d) sc += b2f(q[d]) * b2f(KN[(size_t)(kb + j) * 1024 + h * 128 + d]);
    for (int d = 0; d < 64; ++d) sc += b2f(q[128 + d]) * b2f(KR[(size_t)(kb + j) * 64 + d]);
    const float mn = fmaxf(m, sc), al = exp2f(m - mn), pj = exp2f(sc - mn);
    l = l * al + pj; o = o * al + pj * b2f(vt[j]); m = mn;
  }
  rep(p, id, b2f(((const bf16_t*)(ws_ + OFF_H))[(size_t)row * 1024 + h * 128 + dv]), o / l, 0.03f);
}
__device__ __forceinline__ void chk_yt(const Params& p, int id) {
  PH_BEGIN
  const int s = GID; if (s >= 512) return;
  const int row = hsh(s * 2 + id * 7919) % 6144, col = hsh(s * 2 + 1 + id * 7919) & 1023, half = s & 1;
  const int s0 = seq_start(row), n = seq_len(row), pos = row - s0, g = col >> 7, cp = col & 127;
  const bf16_t* H = (const bf16_t*)(ws_ + OFF_H);
  float acc = 0.f;
  for (int c = 0; c < 128; ++c) { const float b = (float)((c * cp) & 127) / 128.f; acc += b2f(H[(size_t)row * 1024 + g * 128 + c]) * (half ? sinf(6.283185307179586f * b) : cosf(6.283185307179586f * b)); }
  const bf16_t* YT = (const bf16_t*)(ws_ + OFF_YT);
  const bf16_t* base = row < 4096 ? YT + (size_t)(row >> 8) * (1024 * 512) : YT + (size_t)16 * 1024 * 512 + (size_t)((row - 4096) >> 10) * (1024 * 2048);
  rep(p, id, b2f(base[(size_t)col * (2 * n) + half * n + pos]), acc / sqrtf(128.f), 0.3f);
}
__device__ __forceinline__ void chk_tab(const Params& p) {
  PH_BEGIN
  const int s = GID; if (s >= 2048) return;
  const unsigned hh = hsh(s * 3 + 11);
  { const int np = hh & 255, c = (hh >> 8) & 127, half = np >> 7, cp = np & 127; const float b = (float)((c * cp) & 127) / 128.f * 6.283185307179586f;
    rep(p, 45, b2f(((const bf16_t*)(ws_ + OFF_DFTC))[np * 128 + c]), (half ? sinf(b) : cosf(b)) / sqrtf(128.f), 0.02f); }
  { const int np = hh & 255, c = (hh >> 8) & 511, half = c >> 8, pos = c & 255; const float b = (float)((pos * np) & 255) / 256.f * 6.283185307179586f;
    rep(p, 46, b2f(((const bf16_t*)(ws_ + OFF_DFTP256))[np * 512 + c]), (half ? -sinf(b) : cosf(b)) / 16.f, 0.01f); }
  { const int np = hh & 1023, c = (hh >> 10) & 2047, half = c >> 10, pos = c & 1023; const float b = (float)((pos * np) & 1023) / 1024.f * 6.283185307179586f;
    rep(p, 47, b2f(((const bf16_t*)(ws_ + OFF_DFTP1024))[np * 2048 + c]), (half ? -sinf(b) : cosf(b)) / 32.f, 0.005f); }
}
#ifndef CHKMASK
#define CHKMASK 0x7F
#endif
#define CHK(grp, call) do { if (CHKMASK & (1 << (grp))) { call; grid.sync(); } } while (0)
#else
#define CHK(grp, call) do { } while (0)
#endif

#ifndef PH_LO
#define PH_LO 0
#endif
#ifndef PH_HI
#define PH_HI 1000
#endif
__global__ void __launch_bounds__(256, 2) mega(Params p) {
  __shared__ __attribute__((aligned(16))) char lds[65536];
  cg::grid_group grid = cg::this_grid();
  char* ws = p.ws;
  bf16_t* H = (bf16_t*)(ws + OFF_H);
  float* O = (float*)(ws + OFF_O);
  bf16_t* HID = (bf16_t*)(ws + OFF_HID);
  phase_prep(p, lds);
  grid.sync();
  CHK(0, chk_modv(p));
  CHK(0, chk_tab(p));
  phase_row(p, true, false, 0, 0, 0, true, 0, 0, 0);
  grid.sync();
  CHK(0, chk_h(p, 1, 0, 0, 0));
#pragma unroll
  for (int l = 0; l < 4; ++l) {
    if (l == 0) {
      phase_chan_dft(p, lds); grid.sync();
      CHK(1, chk_yt(p, 44));
      phase_pos_dft(p, lds); grid.sync();
      CHK(1, chk_fft(p, 2));
      phase_gemm_f32((const bf16_t*)(ws + OFF_F), 1024, (const bf16_t*)(ws + OFF_FFTWT), 1024, 1024, 48, 8, O, 1024, 1024, lds); grid.sync();
      CHK(2, chk_o(p, 3, (const bf16_t*)(ws + OFF_F), 1024, p.in[12]));
    } else if (l == 1) {
      phase_gemm_bf16<0>(H, 1024, (const bf16_t*)(ws + OFF_CINT), 1024, 1024, 48, 24, (bf16_t*)(ws + OFF_BCU), 3072, lds); grid.sync();
      CHK(3, chk_bcu(p, 8));
      phase_conv_elt(p); grid.sync();
      CHK(3, chk_a2(p, 9));
      phase_gemm_f32((const bf16_t*)(ws + OFF_A2), 1024, (const bf16_t*)(ws + OFF_COUTT), 1024, 1024, 48, 8, O, 1024, 1024, lds); grid.sync();
      CHK(2, chk_o(p, 10, (const bf16_t*)(ws + OFF_A2), 1024, p.in[15]));
    } else if (l == 2) {
      phase_rwkv_mix(p); grid.sync();
      CHK(4, chk_xm(p, 14));
      phase_rwkv_gemm1(p, lds); grid.sync();
      CHK(4, chk_rw1(p, 15));
      phase_rwkv_gemm2(p, lds); grid.sync();
      CHK(4, chk_rw2(p, 20));
      phase_scan(p, lds); grid.sync();
      CHK(5, chk_scan(p, 24));
      phase_postscan(p); grid.sync();
      CHK(6, chk_z(p, 26));
      phase_gemm_f32(H, 1024, (const bf16_t*)(ws + OFF_RWOT), 1024, 1024, 48, 8, O, 1024, 1024, lds); grid.sync();
      CHK(2, chk_o(p, 27, H, 1024, p.in[20]));
    } else {
      phase_gemm_f32(H, 1024, (const bf16_t*)(ws + OFF_MDQKVT), 1024, 1024, 48, 6, (float*)(ws + OFF_QC), 704, 704, lds); grid.sync();
      CHK(7, chk_qc(p, 32));
      phase_mla_rows(p); grid.sync();
      CHK(7, chk_mlarows(p, 33));
      phase_mla_up(p, lds); grid.sync();
      CHK(7, chk_up(p, 36));
      phase_attn(p); grid.sync();
      CHK(8, chk_attn(p, 39));
      phase_gemm_f32(H, 1024, (const bf16_t*)(ws + OFF_MOT), 1024, 1024, 48, 8, O, 1024, 1024, lds); grid.sync();
      CHK(2, chk_o(p, 40, H, 1024, p.in[41]));
    }
    phase_row(p, false, DBG_MIXER_UPD, l, 2, 1, true, l, 2, 3);
    grid.sync();
    CHK(0, chk_h(p, l == 0 ? 4 : (l == 1 ? 11 : (l == 2 ? 28 : 41)), l, 2, 3));
    phase_gemm_bf16<1>(H, 1024, (const bf16_t*)(ws + OFF_W1T) + (size_t)l * 4096 * 1024, 1024, 1024, 48, 32, HID, 4096, lds); grid.sync();
    CHK(2, chk_hid(p, l == 0 ? 5 : (l == 1 ? 12 : (l == 2 ? 29 : 42)), l));
    phase_gemm_f32(HID, 4096, (const bf16_t*)(ws + OFF_W2T) + (size_t)l * 4096 * 1024, 4096, 4096, 48, 8, O, 1024, 1024, lds); grid.sync();
    CHK(2, chk_o(p, l == 0 ? 6 : (l == 1 ? 13 : (l == 2 ? 30 : 43)), HID, 4096, p.in[11] + (size_t)l * 4096 * 1024));
    phase_row(p, false, true, l, 5, 3, l < 3 && l != 1, l + 1, 0, 0);
    if (l < 3) grid.sync();
    if (l == 0 || l == 2) CHK(0, chk_h(p, l == 0 ? 7 : 31, l + 1, 0, 0));
  }
#ifdef SELFCHECK
  grid.sync();
  for (size_t i = (size_t)blockIdx.x * 256 + threadIdx.x; i < 9699328; i += (size_t)gridDim.x * 256) { const float v = p.out[i]; if (!(fabsf(v) < 1e30f)) p.out[i] = 0.f; }
  grid.sync();
  if (blockIdx.x == 0 && threadIdx.x == 0) {
    const unsigned* errs = (const unsigned*)(ws + OFF_CTR) + 8;
    if (__uint_as_float(errs[45]) > SC_TOL) p.out[0] = 46000.f; else if (__uint_as_float(errs[46]) > SC_TOL) p.out[0] = 47000.f; else if (__uint_as_float(errs[47]) > SC_TOL) p.out[0] = 48000.f; else if (__uint_as_float(errs[44]) > SC_TOL) p.out[0] = 45000.f; else
    for (int id = 0; id < 48; ++id) if (!((SKIPMASK >> id) & 1ull) && __uint_as_float(errs[id]) > SC_TOL) { p.out[0] = 1000.f * (id + 1); break; }
  }
#endif
}

extern "C" void kernel_launch(void* const* d_in, const int* in_sizes, int n_in, void* d_out, int out_size, void* d_ws, size_t ws_size, hipStream_t stream) {
  static int grid_blocks = 0;
  if (!grid_blocks) {
    int dev = 0, cus = 0, per_cu = 0;
    (void)hipGetDevice(&dev);
    (void)hipDeviceGetAttribute(&cus, hipDeviceAttributeMultiprocessorCount, dev);
    (void)hipOccupancyMaxActiveBlocksPerMultiprocessor(&per_cu, mega, 256, 0);
    if (per_cu > 2) per_cu = 2;
    if (per_cu < 1) per_cu = 1;
    grid_blocks = cus * per_cu;
  }
  if (ws_size < WS_TOTAL) { fprintf(stderr, "workspace too small: %zu < %zu\n", ws_size, (size_t)WS_TOTAL); return; }
  Params p{};
  for (int i = 0; i < 42; ++i) p.in[i] = (const float*)d_in[i];
  p.out = (float*)d_out; p.ws = (char*)d_ws;
  void* args[] = {&p};
  hipError_t e = hipLaunchCooperativeKernel((void*)mega, dim3(grid_blocks), dim3(256), args, 0, stream);
  if (e != hipSuccess) fprintf(stderr, "cooperative launch failed: %s (grid %d)\n", hipGetErrorString(e), grid_blocks);
}
```

```cpp
#include <hip/hip_runtime.h>
#include <hip/hip_cooperative_groups.h>
#include <cstdio>
#include <cstdint>
namespace cg = cooperative_groups;

typedef unsigned short bf16_t;
typedef short bf16x8 __attribute__((ext_vector_type(8)));
typedef float f32x4 __attribute__((ext_vector_type(4)));
typedef float f32x2 __attribute__((ext_vector_type(2)));

struct Params { const float* in[42]; float* out; char* ws; };

constexpr size_t SZ_ACT = 6144ull * 1024ull;
constexpr size_t OFF_MOD = 0;
constexpr size_t OFF_CTR = OFF_MOD + 4 * 3 * 6144 * 4;
constexpr size_t OFF_BAR = OFF_CTR + 256;
constexpr size_t OFF_W1T = OFF_BAR + 3456 * 4 + 256;
constexpr size_t OFF_W2T = OFF_W1T + 4ull * 4096 * 1024 * 2;
constexpr size_t OFF_FFTWT = OFF_W2T + 4ull * 4096 * 1024 * 2;
constexpr size_t OFF_CINT = OFF_FFTWT + 1024 * 1024 * 2;
constexpr size_t OFF_COUTT = OFF_CINT + 3072 * 1024 * 2;
constexpr size_t OFF_RW1T = OFF_COUTT + 1024 * 1024 * 2;
constexpr size_t OFF_RWW2T = OFF_RW1T + 3456 * 1024 * 2;
constexpr size_t OFF_RWA2T = OFF_RWW2T + 2 * 1024 * 64 * 2;
constexpr size_t OFF_RWG2T = OFF_RWA2T + 2 * 1024 * 64 * 2;
constexpr size_t OFF_RWOT = OFF_RWG2T + 1024 * 128 * 2;
constexpr size_t OFF_MDQKVT = OFF_RWOT + 1024 * 1024 * 2;
constexpr size_t OFF_MUQT = OFF_MDQKVT + 768 * 1024 * 2;
constexpr size_t OFF_MUKT = OFF_MUQT + 1536 * 384 * 2;
constexpr size_t OFF_MUVT = OFF_MUKT + 1024 * 256 * 2;
constexpr size_t OFF_MOT = OFF_MUVT + 1024 * 256 * 2;
constexpr size_t OFF_DFTC = OFF_MOT + 1024 * 1024 * 2;
constexpr size_t OFF_DFTP256 = OFF_DFTC + 256 * 128 * 2;
constexpr size_t OFF_DFTP1024 = OFF_DFTP256 + 256 * 512 * 2;
constexpr size_t OFF_CKVALL = OFF_DFTP1024 + 1024 * 2048 * 2;
constexpr size_t OFF_KRALL = OFF_CKVALL + 6656 * 256 * 2;
constexpr size_t OFF_H = OFF_KRALL + 6656 * 64 * 2;
constexpr size_t OFF_O = OFF_H + SZ_ACT * 2;
constexpr size_t OFF_HID = OFF_O + SZ_ACT * 4;
constexpr size_t OFF_RA = OFF_HID + SZ_ACT * 8;
constexpr size_t OFF_RB = OFF_RA + SZ_ACT * 12;
constexpr size_t OFF_LB = OFF_RB + SZ_ACT * 16;
constexpr size_t WS_TOTAL = OFF_LB + 6144ull * 384 * 2;
constexpr size_t OFF_YT = OFF_RA;
constexpr size_t OFF_F = OFF_RA + SZ_ACT * 4;
constexpr size_t OFF_BCU = OFF_RA;
constexpr size_t OFF_A2 = OFF_RA + SZ_ACT * 6;
constexpr size_t OFF_XM = OFF_RA;
constexpr size_t OFF_KEFF = OFF_RA;
constexpr size_t OFF_NB = OFF_RA + SZ_ACT * 4;
constexpr size_t OFF_G = OFF_RA + SZ_ACT * 8;
constexpr size_t OFF_QC = OFF_RA;
constexpr size_t OFF_QN = OFF_QC + 6144ull * 704 * 4;
constexpr size_t OFF_Q = OFF_QN + 6144ull * 384 * 2;
constexpr size_t OFF_KN = OFF_Q + 6144ull * 1536 * 2;
constexpr size_t OFF_VT = OFF_KN + 6656ull * 1024 * 2;
constexpr size_t OFF_R = OFF_RB;
constexpr size_t OFF_V = OFF_RB + SZ_ACT * 4;
constexpr size_t OFF_K = OFF_RB + SZ_ACT * 8;
constexpr size_t OFF_KK = OFF_RB + SZ_ACT * 12;
constexpr size_t OFF_Y0 = OFF_K;
constexpr size_t OFF_Y1 = OFF_O;
constexpr size_t OFF_WDEC = OFF_HID;
constexpr size_t OUT_STATE = 6291456, OUT_CKV = 8388608, OUT_KROPE = 9437184;

__device__ __forceinline__ unsigned short f2bf(float f) { unsigned u = __float_as_uint(f); u += 0x7fffu + ((u >> 16) & 1u); return (unsigned short)(u >> 16); }
typedef __bf16 bf16x2_t __attribute__((ext_vector_type(2)));
__device__ __forceinline__ unsigned pack2(float a, float b) { const f32x2 v = {a, b}; const bf16x2_t r = __builtin_convertvector(v, bf16x2_t); return __builtin_bit_cast(unsigned, r); }
__device__ __forceinline__ float bflo(unsigned u) { return __uint_as_float(u << 16); }
__device__ __forceinline__ float bfhi(unsigned u) { return __uint_as_float(u & 0xffff0000u); }
__device__ __forceinline__ float wave_sum(float v) {
#pragma unroll
  for (int o = 32; o > 0; o >>= 1) v += __shfl_xor(v, o);
  return v;
}
__device__ __forceinline__ float quad_sum(float v) {
  v += __int_as_float(__builtin_amdgcn_update_dpp(0, __float_as_int(v), 0xB1, 0xF, 0xF, true));
  v += __int_as_float(__builtin_amdgcn_update_dpp(0, __float_as_int(v), 0x4E, 0xF, 0xF, true));
  return v;
}
__device__ __forceinline__ float sigmoidf_(float x) { return 1.f / (1.f + __expf(-x)); }
__device__ __forceinline__ int row_group(int row) { return row < 4096 ? 0 : 1 + ((row - 4096) >> 10); }

template <bool SWAP, class Epi>
__device__ __forceinline__ void gemm_tile(const bf16_t* __restrict__ A, int lda, const bf16_t* __restrict__ Bt, int ldb, int K, char* lds, Epi&& epi) {
  int tid = threadIdx.x; asm volatile("" : "+v"(tid));
  const int lane = tid & 63, wid = tid >> 6, wr = wid >> 1, wc = wid & 1;
  const int lrow = tid >> 3, lch = tid & 7;
  const bf16_t* ap = A + (size_t)lrow * lda + lch * 8;
  const bf16_t* bp = Bt + (size_t)lrow * ldb + lch * 8;
  const int soff = lrow * 128 + ((lch ^ ((lrow >> 1) & 7)) << 4);
  const int quad = lane >> 4, l15 = lane & 15, sw = l15 >> 1;
  const int aoff = (wr * 64 + l15) * 128, boff = 16384 + (wc * 64 + l15) * 128;
  f32x4 acc[4][4];
#pragma unroll
  for (int i = 0; i < 4; ++i)
#pragma unroll
    for (int j = 0; j < 4; ++j) acc[i][j] = (f32x4){0.f, 0.f, 0.f, 0.f};
  uint4 ra0, ra1, ra2, ra3, rb0, rb1, rb2, rb3;
#define GT_LOAD() do { ra0 = *(const uint4*)(ap); ra1 = *(const uint4*)(ap + (size_t)32 * lda); ra2 = *(const uint4*)(ap + (size_t)64 * lda); ra3 = *(const uint4*)(ap + (size_t)96 * lda); \
                       rb0 = *(const uint4*)(bp); rb1 = *(const uint4*)(bp + (size_t)32 * ldb); rb2 = *(const uint4*)(bp + (size_t)64 * ldb); rb3 = *(const uint4*)(bp + (size_t)96 * ldb); } while (0)
#define GT_STORE(base) do { char* _b = (base) + soff; *(uint4*)(_b) = ra0; *(uint4*)(_b + 4096) = ra1; *(uint4*)(_b + 8192) = ra2; *(uint4*)(_b + 12288) = ra3; \
                            *(uint4*)(_b + 16384) = rb0; *(uint4*)(_b + 20480) = rb1; *(uint4*)(_b + 24576) = rb2; *(uint4*)(_b + 28672) = rb3; } while (0)
  GT_LOAD();
  GT_STORE(lds);
  __syncthreads();
  const int nk = K >> 6;
  for (int kt = 0; kt < nk; ++kt) {
    char* cur = lds + (kt & 1) * 32768;
    const bool more = kt + 1 < nk;
    if (more) { ap += 64; bp += 64; GT_LOAD(); }
#pragma unroll
    for (int ks = 0; ks < 2; ++ks) {
      const int ch = ((ks * 4 + quad) ^ sw) << 4;
      bf16x8 af[4], bfr[4];
#pragma unroll
      for (int mi = 0; mi < 4; ++mi) af[mi] = *(const bf16x8*)(cur + aoff + mi * 2048 + ch);
#pragma unroll
      for (int ni = 0; ni < 4; ++ni) bfr[ni] = *(const bf16x8*)(cur + boff + ni * 2048 + ch);
#pragma unroll
      for (int mi = 0; mi < 4; ++mi)
#pragma unroll
        for (int ni = 0; ni < 4; ++ni)
          acc[mi][ni] = SWAP ? __builtin_amdgcn_mfma_f32_16x16x32_bf16(bfr[ni], af[mi], acc[mi][ni], 0, 0, 0)
                             : __builtin_amdgcn_mfma_f32_16x16x32_bf16(af[mi], bfr[ni], acc[mi][ni], 0, 0, 0);
    }
    if (more) GT_STORE(lds + ((kt + 1) & 1) * 32768);
    __syncthreads();
  }
  epi(acc, wr * 64, wc * 64);
}

#define PH_BEGIN_NOWS int tid_ = threadIdx.x; int bid_ = blockIdx.x; asm volatile("" : "+v"(tid_), "+s"(bid_));
#define PH_BEGIN PH_BEGIN_NOWS char* ws_ = p.ws; asm volatile("" : "+s"(ws_));
__device__ __forceinline__ void conv_T(const float* __restrict__ src, int K, int N, bf16_t* __restrict__ dst, int ldd, int& base, char* lds) {
  PH_BEGIN_NOWS
  const int tn = N >> 6, nt = (K >> 6) * tn, G = gridDim.x, tid = tid_;
  float (*tile)[65] = (float (*)[65])lds;
  int first = ((int)bid_ - base) % G; if (first < 0) first += G;
  for (int t = first; t < nt; t += G) {
    const int kt = t / tn, nti = t - kt * tn;
    const float* s = src + (size_t)(kt * 64) * N + nti * 64;
    const int c = tid & 63, r0 = tid >> 6;
#pragma unroll
    for (int i = 0; i < 16; ++i) tile[r0 + 4 * i][c] = s[(size_t)(r0 + 4 * i) * N + c];
    __syncthreads();
    const int n = tid >> 2, kc = (tid & 3) * 16;
    unsigned w[8];
#pragma unroll
    for (int j = 0; j < 8; ++j) w[j] = pack2(tile[kc + 2 * j][n], tile[kc + 2 * j + 1][n]);
    bf16_t* d = dst + (size_t)(nti * 64 + n) * ldd + kt * 64 + kc;
    *(uint4*)d = make_uint4(w[0], w[1], w[2], w[3]);
    *(uint4*)(d + 8) = make_uint4(w[4], w[5], w[6], w[7]);
    __syncthreads();
  }
  base = (base + nt) % G;
}

__device__ __forceinline__ void phase_prep(const Params& p, char* lds) {
  PH_BEGIN
  char* ws = ws_;
  const int tid = tid_, gt = bid_ * 256 + tid, nthr = gridDim.x * 256;
  if (bid_ == 0 && tid < 64) ((unsigned*)(ws + OFF_CTR))[tid] = 0u;
  {
    float* sl = (float*)lds;
    float* red = (float*)(lds + 12288);
    bool have = false;
    for (int item = bid_; item < 384; item += gridDim.x) {
      if (!have) {
        for (int i = tid; i < 3072; i += 256) {
          const int g = i >> 10, k = i & 1023;
          const float cv = g == 0 ? p.in[6][k] : p.in[5][(g - 1) * 1024 + k];
          sl[i] = cv / (1.f + __expf(-cv));
        }
        have = true;
        __syncthreads();
      }
      const int l = item / 96, n0 = (item % 96) * 64, lane = tid & 63, w = tid >> 6;
      const float* mw = p.in[7] + (size_t)l * 1024 * 6144 + n0 + lane;
      float a0 = 0.f, a1 = 0.f, a2 = 0.f;
#pragma unroll 16
      for (int k = w * 256; k < w * 256 + 256; ++k) {
        const float wv = mw[(size_t)k * 6144];
        a0 += sl[k] * wv; a1 += sl[1024 + k] * wv; a2 += sl[2048 + k] * wv;
      }
      red[(w * 3 + 0) * 64 + lane] = a0; red[(w * 3 + 1) * 64 + lane] = a1; red[(w * 3 + 2) * 64 + lane] = a2;
      __syncthreads();
      if (tid < 192) {
        const int g = tid >> 6;
        const float s = red[(0 * 3 + g) * 64 + lane] + red[(1 * 3 + g) * 64 + lane] + red[(2 * 3 + g) * 64 + lane] + red[(3 * 3 + g) * 64 + lane];
        ((float*)(ws + OFF_MOD))[(l * 3 + g) * 6144 + n0 + lane] = s + p.in[8][l * 6144 + n0 + lane];
      }
      __syncthreads();
    }
    __syncthreads();
  }
  {
    bf16_t* dc = (bf16_t*)(ws + OFF_DFTC);
    for (int i = gt; i < 256 * 128; i += nthr) {
      const int np = i >> 7, c = i & 127, half = np >> 7, cp = np & 127, m = (c * cp) & 127;
      const float x = (float)m * (1.f / 128.f);
      const float v = half ? __builtin_amdgcn_sinf(x) : __builtin_amdgcn_cosf(x);
      dc[i] = f2bf(v * 0.08838834764831845f);
    }
    bf16_t* d256 = (bf16_t*)(ws + OFF_DFTP256);
    for (int i = gt; i < 256 * 512; i += nthr) {
      const int np = i >> 9, c = i & 511, half = c >> 8, pos = c & 255, m = (pos * np) & 255;
      const float x = (float)m * (1.f / 256.f);
      const float v = half ? -__builtin_amdgcn_sinf(x) : __builtin_amdgcn_cosf(x);
      d256[i] = f2bf(v * 0.0625f);
    }
    bf16_t* d1024 = (bf16_t*)(ws + OFF_DFTP1024);
    for (int i = gt; i < 1024 * 2048; i += nthr) {
      const int np = i >> 11, c = i & 2047, half = c >> 10, pos = c & 1023, m = (pos * np) & 1023;
      const float x = (float)m * (1.f / 1024.f);
      const float v = half ? -__builtin_amdgcn_sinf(x) : __builtin_amdgcn_cosf(x);
      d1024[i] = f2bf(v * 0.03125f);
    }
  }
  {
    bf16_t* ck = (bf16_t*)(ws + OFF_CKVALL);
    for (int i = gt; i < 2 * 256 * 256; i += nthr) {
      const int b = i >> 16, r = i & 65535;
      ck[(size_t)(4096 + b * 1280) * 256 + r] = f2bf(p.in[3][i]);
    }
    bf16_t* kr = (bf16_t*)(ws + OFF_KRALL);
    for (int i = gt; i < 2 * 256 * 64; i += nthr) {
      const int b = i >> 14, r = i & 16383;
      kr[(size_t)(4096 + b * 1280) * 64 + r] = f2bf(p.in[4][i]);
    }
    bf16_t* pad = (bf16_t*)(ws + OFF_MDQKVT) + 704 * 1024;
    for (int i = gt; i < 64 * 1024; i += nthr) pad[i] = 0;
  }
  int base = 0;
  for (int l = 0; l < 4; ++l) {
    conv_T(p.in[10] + (size_t)l * 1024 * 4096, 1024, 4096, (bf16_t*)(ws + OFF_W1T) + (size_t)l * 4096 * 1024, 1024, base, lds);
    conv_T(p.in[11] + (size_t)l * 4096 * 1024, 4096, 1024, (bf16_t*)(ws + OFF_W2T) + (size_t)l * 4096 * 1024, 4096, base, lds);
  }
  conv_T(p.in[12], 1024, 1024, (bf16_t*)(ws + OFF_FFTWT), 1024, base, lds);
  conv_T(p.in[13], 1024, 3072, (bf16_t*)(ws + OFF_CINT), 1024, base, lds);
  conv_T(p.in[15], 1024, 1024, (bf16_t*)(ws + OFF_COUTT), 1024, base, lds);
  {
    bf16_t* r1 = (bf16_t*)(ws + OFF_RW1T);
    conv_T(p.in[17], 1024, 1024, r1, 1024, base, lds);
    conv_T(p.in[18], 1024, 1024, r1 + 1024 * 1024, 1024, base, lds);
    conv_T(p.in[19], 1024, 1024, r1 + 2048 * 1024, 1024, base, lds);
    conv_T(p.in[22], 1024, 64, r1 + 3072 * 1024, 1024, base, lds);
    conv_T(p.in[22] + 1024 * 64, 1024, 64, r1 + (3072 + 64) * 1024, 1024, base, lds);
    conv_T(p.in[25], 1024, 64, r1 + (3072 + 128) * 1024, 1024, base, lds);
    conv_T(p.in[25] + 1024 * 64, 1024, 64, r1 + (3072 + 192) * 1024, 1024, base, lds);
    conv_T(p.in[27], 1024, 128, r1 + (3072 + 256) * 1024, 1024, base, lds);
    conv_T(p.in[23], 64, 1024, (bf16_t*)(ws + OFF_RWW2T), 64, base, lds);
    conv_T(p.in[23] + 64 * 1024, 64, 1024, (bf16_t*)(ws + OFF_RWW2T) + 1024 * 64, 64, base, lds);
    conv_T(p.in[26], 64, 1024, (bf16_t*)(ws + OFF_RWA2T), 64, base, lds);
    conv_T(p.in[26] + 64 * 1024, 64, 1024, (bf16_t*)(ws + OFF_RWA2T) + 1024 * 64, 64, base, lds);
    conv_T(p.in[28], 128, 1024, (bf16_t*)(ws + OFF_RWG2T), 128, base, lds);
    conv_T(p.in[20], 1024, 1024, (bf16_t*)(ws + OFF_RWOT), 1024, base, lds);
  }
  conv_T(p.in[34], 1024, 384, (bf16_t*)(ws + OFF_MDQKVT), 1024, base, lds);
  conv_T(p.in[37], 1024, 320, (bf16_t*)(ws + OFF_MDQKVT) + 384 * 1024, 1024, base, lds);
  conv_T(p.in[36], 384, 1536, (bf16_t*)(ws + OFF_MUQT), 384, base, lds);
  conv_T(p.in[39], 256, 1024, (bf16_t*)(ws + OFF_MUKT), 256, base, lds);
  conv_T(p.in[40], 256, 1024, (bf16_t*)(ws + OFF_MUVT), 256, base, lds);
  conv_T(p.in[41], 1024, 1024, (bf16_t*)(ws + OFF_MOT), 1024, base, lds);
}

__device__ __forceinline__ void phase_row(const Params& p, bool from_input, bool upd, int ul, int ugate, int ugn, bool wh, int hl, int hgn, int hshift) {
  PH_BEGIN
  const int lane = tid_ & 63, gw = bid_ * 4 + (tid_ >> 6), nw = gridDim.x * 4;
  float* X = p.out;
  const float* O = (const float*)(ws_ + OFF_O);
  bf16_t* H = (bf16_t*)(ws_ + OFF_H);
  const float* modv = (const float*)(ws_ + OFF_MOD);
  const float* ng = p.in[9];
  for (int row = gw; row < 6144; row += nw) {
    const int g = row_group(row);
    const float* xr = from_input ? (row < 4096 ? p.in[0] + (size_t)row * 1024 : p.in[1] + (size_t)(row - 4096) * 1024) : X + (size_t)row * 1024;
    f32x4 x[4];
#pragma unroll
    for (int i = 0; i < 4; ++i) x[i] = *(const f32x4*)(xr + lane * 4 + 256 * i);
    if (upd) {
      f32x4 ov[4]; float ss = 0.f;
#pragma unroll
      for (int i = 0; i < 4; ++i) { ov[i] = *(const f32x4*)(O + (size_t)row * 1024 + lane * 4 + 256 * i); ss += ov[i][0] * ov[i][0] + ov[i][1] * ov[i][1] + ov[i][2] * ov[i][2] + ov[i][3] * ov[i][3]; }
      ss = wave_sum(ss);
      const float rs = rsqrtf(ss * (1.f / 1024.f) + 1e-6f);
      const float* gn = ng + (ul * 4 + ugn) * 1024;
      const float* gate = modv + ((ul * 3 + g) * 6 + ugate) * 1024;
#pragma unroll
      for (int i = 0; i < 4; ++i) {
        const f32x4 gv = *(const f32x4*)(gn + lane * 4 + 256 * i), gt = *(const f32x4*)(gate + lane * 4 + 256 * i);
        x[i] += gt * (ov[i] * rs * gv);
      }
    }
    if (upd || from_input) {
#pragma unroll
      for (int i = 0; i < 4; ++i) *(f32x4*)(X + (size_t)row * 1024 + lane * 4 + 256 * i) = x[i];
    }
    if (wh) {
      float ss = 0.f;
#pragma unroll
      for (int i = 0; i < 4; ++i) ss += x[i][0] * x[i][0] + x[i][1] * x[i][1] + x[i][2] * x[i][2] + x[i][3] * x[i][3];
      ss = wave_sum(ss);
      const float rs = rsqrtf(ss * (1.f / 1024.f) + 1e-6f);
      const float* gn = ng + (hl * 4 + hgn) * 1024;
      const float* sh = modv + ((hl * 3 + g) * 6 + hshift) * 1024;
#pragma unroll
      for (int i = 0; i < 4; ++i) {
        const int c = lane * 4 + 256 * i;
        const f32x4 gv = *(const f32x4*)(gn + c), shv = *(const f32x4*)(sh + c), scv = *(const f32x4*)(sh + 1024 + c);
        const f32x4 h = x[i] * rs * gv * (1.f + scv) + shv;
        *(uint2*)(H + (size_t)row * 1024 + c) = make_uint2(pack2(h[0], h[1]), pack2(h[2], h[3]));
      }
    }
  }
}

__device__ __forceinline__ void phase_rwkv_mix(const Params& p) {
  PH_BEGIN
  const int lane = tid_ & 63, gw = bid_ * 4 + (tid_ >> 6), nw = gridDim.x * 4;
  const float* X = p.out;
  bf16_t* XM = (bf16_t*)(ws_ + OFF_XM);
  const float* modv = (const float*)(ws_ + OFF_MOD);
  const float* gn = p.in[9] + (2 * 4 + 0) * 1024;
  const float* mu = p.in[16];
  for (int row = gw; row < 6144; row += nw) {
    const int g = row_group(row);
    const int pos = row < 4096 ? (row & 255) : ((row - 4096) & 1023), n = row < 4096 ? 256 : 1024;
    const bool hasp = pos > 0, hasn = pos < n - 1;
    const float* sh = modv + ((2 * 3 + g) * 6 + 0) * 1024;
    f32x4 xc[4], xp[4], xn[4];
    float sc_ = 0.f, sp_ = 0.f, sn_ = 0.f;
#pragma unroll
    for (int i = 0; i < 4; ++i) {
      const int c = lane * 4 + 256 * i;
      xc[i] = *(const f32x4*)(X + (size_t)row * 1024 + c);
      xp[i] = hasp ? *(const f32x4*)(X + (size_t)(row - 1) * 1024 + c) : (f32x4){0.f, 0.f, 0.f, 0.f};
      xn[i] = hasn ? *(const f32x4*)(X + (size_t)(row + 1) * 1024 + c) : (f32x4){0.f, 0.f, 0.f, 0.f};
#pragma unroll
      for (int j = 0; j < 4; ++j) { sc_ += xc[i][j] * xc[i][j]; sp_ += xp[i][j] * xp[i][j]; sn_ += xn[i][j] * xn[i][j]; }
    }
    sc_ = wave_sum(sc_); sp_ = wave_sum(sp_); sn_ = wave_sum(sn_);
    const float rc = rsqrtf(sc_ * (1.f / 1024.f) + 1e-6f), rp = rsqrtf(sp_ * (1.f / 1024.f) + 1e-6f), rn = rsqrtf(sn_ * (1.f / 1024.f) + 1e-6f);
#pragma unroll
    for (int i = 0; i < 4; ++i) {
      const int c = lane * 4 + 256 * i;
      const f32x4 gv = *(const f32x4*)(gn + c), shv = *(const f32x4*)(sh + c), scv = *(const f32x4*)(sh + 1024 + c);
      const f32x4 gm = gv * (1.f + scv);
      const f32x4 hc = xc[i] * rc * gm + shv;
      f32x4 hp = xp[i] * rp * gm + shv, hn = xn[i] * rn * gm + shv;
      if (!hasp) hp = (f32x4){0.f, 0.f, 0.f, 0.f};
      if (!hasn) hn = (f32x4){0.f, 0.f, 0.f, 0.f};
      const f32x4 dx = 0.5f * (hp + hn) - hc;
#pragma unroll
      for (int m = 0; m < 6; ++m) {
        const f32x4 muv = *(const f32x4*)(mu + m * 1024 + c);
        const f32x4 o = hc + dx * muv;
        *(uint2*)(XM + (size_t)m * SZ_ACT + (size_t)row * 1024 + c) = make_uint2(pack2(o[0], o[1]), pack2(o[2], o[3]));
      }
    }
  }
}

__device__ __forceinline__ void phase_conv_elt(const Params& p) {
  PH_BEGIN
  const int lane = tid_ & 63, gw = bid_ * 4 + (tid_ >> 6), nw = gridDim.x * 4;
  const bf16_t* BCU = (const bf16_t*)(ws_ + OFF_BCU);
  bf16_t* A2 = (bf16_t*)(ws_ + OFF_A2);
  const float* cw = p.in[14];
  for (int row = gw; row < 6144; row += nw) {
    const int pos = row < 4096 ? (row & 255) : ((row - 4096) & 1023), n = row < 4096 ? 256 : 1024;
    const bool hasp = pos > 0, hasn = pos < n - 1;
#pragma unroll
    for (int i = 0; i < 2; ++i) {
      const int c = lane * 8 + 512 * i;
      const bf16_t* rb = BCU + (size_t)row * 3072 + c;
      const uint4 bg = *(const uint4*)rb, cg = *(const uint4*)(rb + 1024), u = *(const uint4*)(rb + 2048);
      uint4 cgp = make_uint4(0, 0, 0, 0), up = cgp, cgn = cgp, un = cgp;
      if (hasp) { cgp = *(const uint4*)(rb - 3072 + 1024); up = *(const uint4*)(rb - 3072 + 2048); }
      if (hasn) { cgn = *(const uint4*)(rb + 3072 + 1024); un = *(const uint4*)(rb + 3072 + 2048); }
      const unsigned bgw[4] = {bg.x, bg.y, bg.z, bg.w}, cgw[4] = {cg.x, cg.y, cg.z, cg.w}, uw[4] = {u.x, u.y, u.z, u.w};
      const unsigned cgpw[4] = {cgp.x, cgp.y, cgp.z, cgp.w}, upw[4] = {up.x, up.y, up.z, up.w}, cgnw[4] = {cgn.x, cgn.y, cgn.z, cgn.w}, unw[4] = {un.x, un.y, un.z, un.w};
      unsigned ow[4];
#pragma unroll
      for (int j = 0; j < 4; ++j) {
        const int cc = c + 2 * j;
        const float w00 = cw[cc], w01 = cw[cc + 1], w10 = cw[1024 + cc], w11 = cw[1024 + cc + 1], w20 = cw[2048 + cc], w21 = cw[2048 + cc + 1];
        const float z0 = bflo(cgw[j]) * bflo(uw[j]), z1 = bfhi(cgw[j]) * bfhi(uw[j]);
        const float zp0 = bflo(cgpw[j]) * bflo(upw[j]), zp1 = bfhi(cgpw[j]) * bfhi(upw[j]);
        const float zn0 = bflo(cgnw[j]) * bflo(unw[j]), zn1 = bfhi(cgnw[j]) * bfhi(unw[j]);
        const float o0 = bflo(bgw[j]) * (zp0 * w00 + z0 * w10 + zn0 * w20);
        const float o1 = bfhi(bgw[j]) * (zp1 * w01 + z1 * w11 + zn1 * w21);
        ow[j] = pack2(o0, o1);
      }
      *(uint4*)(A2 + (size_t)row * 1024 + c) = make_uint4(ow[0], ow[1], ow[2], ow[3]);
    }
  }
}

__device__ __forceinline__ void phase_postscan(const Params& p) {
  PH_BEGIN
  const int lane = tid_ & 63, gw = bid_ * 4 + (tid_ >> 6), nw = gridDim.x * 4;
  const float* Y0 = (const float*)(ws_ + OFF_Y0);
  const float* Y1 = (const float*)(ws_ + OFF_Y1);
  const float* R = (const float*)(ws_ + OFF_R);
  const float* V = (const float*)(ws_ + OFF_V);
  const float* G = (const float*)(ws_ + OFF_G);
  const bf16_t* KE = (const bf16_t*)(ws_ + OFF_KEFF);
  bf16_t* Z = (bf16_t*)(ws_ + OFF_H);
  const float* rk = p.in[31]; const float* lng = p.in[32]; const float* lnb = p.in[33];
  for (int row = gw; row < 6144; row += nw) {
    const size_t b = (size_t)row * 1024 + lane * 16;
    float y[16], bon = 0.f, s = 0.f;
#pragma unroll
    for (int i = 0; i < 4; ++i) {
      const f32x4 a = *(const f32x4*)(Y0 + b + 4 * i), c = *(const f32x4*)(Y1 + b + 4 * i), r = *(const f32x4*)(R + b + 4 * i);
      const uint2 k0 = *(const uint2*)(KE + b + 4 * i), k1 = *(const uint2*)(KE + SZ_ACT + b + 4 * i);
      const f32x4 rkv = *(const f32x4*)(rk + lane * 16 + 4 * i);
      const float ke[4] = {bflo(k0.x) + bflo(k1.x), bfhi(k0.x) + bfhi(k1.x), bflo(k0.y) + bflo(k1.y), bfhi(k0.y) + bfhi(k1.y)};
#pragma unroll
      for (int j = 0; j < 4; ++j) { y[4 * i + j] = a[j] + c[j]; s += y[4 * i + j]; bon += r[j] * ke[j] * rkv[j]; }
    }
    s = quad_sum(s); bon = quad_sum(bon);
    const float mean = s * (1.f / 64.f);
    float vs = 0.f;
#pragma unroll
    for (int j = 0; j < 16; ++j) { const float d = y[j] - mean; vs += d * d; }
    vs = quad_sum(vs);
    const float rstd = rsqrtf(vs * (1.f / 64.f) + 64e-5f);
    unsigned ow[8];
#pragma unroll
    for (int i = 0; i < 4; ++i) {
      const f32x4 v = *(const f32x4*)(V + b + 4 * i), gg = *(const f32x4*)(G + b + 4 * i);
      const f32x4 lg = *(const f32x4*)(lng + lane * 16 + 4 * i), lb = *(const f32x4*)(lnb + lane * 16 + 4 * i);
      float o[4];
#pragma unroll
      for (int j = 0; j < 4; ++j) o[j] = ((y[4 * i + j] - mean) * rstd * lg[j] + lb[j] + bon * v[j]) * gg[j];
      ow[2 * i] = pack2(o[0], o[1]); ow[2 * i + 1] = pack2(o[2], o[3]);
    }
    *(uint4*)(Z + b) = make_uint4(ow[0], ow[1], ow[2], ow[3]);
    *(uint4*)(Z + b + 8) = make_uint4(ow[4], ow[5], ow[6], ow[7]);
  }
}

__device__ __forceinline__ void phase_mla_rows(const Params& p) {
  PH_BEGIN
  const int lane = tid_ & 63, gw = bid_ * 4 + (tid_ >> 6), nw = gridDim.x * 4;
  const float* QC = (const float*)(ws_ + OFF_QC);
  bf16_t* QN = (bf16_t*)(ws_ + OFF_QN);
  bf16_t* CK = (bf16_t*)(ws_ + OFF_CKVALL);
  bf16_t* KR = (bf16_t*)(ws_ + OFF_KRALL);
  const float* gq = p.in[35]; const float* gkv = p.in[38];
  for (int row = gw; row < 6144; row += nw) {
    const float* q = QC + (size_t)row * 704;
    int keyrow = row;
    if (row >= 4096) { const int r = row - 4096; keyrow = 4096 + (r >> 10) * 1280 + 256 + (r & 1023); }
    float qv[6], ss = 0.f;
#pragma unroll
    for (int i = 0; i < 6; ++i) { qv[i] = q[lane + 64 * i]; ss += qv[i] * qv[i]; }
    ss = wave_sum(ss);
    float rs = rsqrtf(ss * (1.f / 384.f) + 1e-6f);
#pragma unroll
    for (int i = 0; i < 6; ++i) QN[(size_t)row * 384 + lane + 64 * i] = f2bf(qv[i] * rs * gq[lane + 64 * i]);
    float cv[4]; ss = 0.f;
#pragma unroll
    for (int i = 0; i < 4; ++i) { cv[i] = q[384 + lane + 64 * i]; ss += cv[i] * cv[i]; }
    ss = wave_sum(ss);
    rs = rsqrtf(ss * (1.f / 256.f) + 1e-6f);
#pragma unroll
    for (int i = 0; i < 4; ++i) {
      const float o = cv[i] * rs * gkv[lane + 64 * i];
      CK[(size_t)keyrow * 256 + lane + 64 * i] = f2bf(o);
      if (row < 4096) p.out[OUT_CKV + (size_t)row * 256 + lane + 64 * i] = o;
    }
    float kv = q[640 + lane];
    if (row < 4096) {
      p.out[OUT_KROPE + (size_t)row * 64 + lane] = kv;
    } else {
      const int pp = (row - 4096) & 1023;
      const float posv = (lane >> 5) ? (float)(pp & 63) : (float)(pp >> 6);
      const float inv = exp2f(-(float)(lane & 15) * 0.8304820237218406f);
      const float rev = posv * inv * 0.15915494309189535f;
      const float sn = __builtin_amdgcn_sinf(rev), cs = __builtin_amdgcn_cosf(rev);
      const float other = __shfl_xor(kv, 16);
      kv = (lane & 16) ? (other * sn + kv * cs) : (kv * cs - other * sn);
    }
    KR[(size_t)keyrow * 64 + lane] = f2bf(kv);
  }
}

#define ACC_T f32x4 (&acc)[4][4]
#define LANE_VARS const int lane = tid_ & 63, l15 = lane & 15, quad = lane >> 4; (void)l15; (void)quad;

__device__ __forceinline__ void phase_gemm_f32(const bf16_t* A, int lda, const bf16_t* Bt, int ldb, int K, int ntm, int ntn, float* Out, int ldo, int nvalid, char* lds) {
  PH_BEGIN_NOWS
  asm volatile("" : "+s"(A), "+s"(Bt), "+s"(Out));
  LANE_VARS
  for (int t = bid_; t < ntm * ntn; t += gridDim.x) {
    const int tm = t % ntm, tn = t / ntm;
    gemm_tile<true>(A + (size_t)tm * 128 * lda, lda, Bt + (size_t)tn * 128 * ldb, ldb, K, lds, [&](ACC_T, int r0, int c0) __attribute__((always_inline)) {
#pragma unroll
      for (int mi = 0; mi < 4; ++mi)
#pragma unroll
        for (int ni = 0; ni < 4; ++ni) {
          const int row = tm * 128 + r0 + mi * 16 + l15, col = tn * 128 + c0 + ni * 16 + quad * 4;
          if (col < nvalid) *(f32x4*)(Out + (size_t)row * ldo + col) = acc[mi][ni];
        }
    });
  }
}

template <int ACT>
__device__ __forceinline__ void phase_gemm_bf16(const bf16_t* A, int lda, const bf16_t* Bt, int ldb, int K, int ntm, int ntn, bf16_t* Out, int ldo, char* lds) {
  PH_BEGIN_NOWS
  asm volatile("" : "+s"(A), "+s"(Bt), "+s"(Out));
  LANE_VARS
  for (int t = bid_; t < ntm * ntn; t += gridDim.x) {
    const int tm = t % ntm, tn = t / ntm;
    gemm_tile<true>(A + (size_t)tm * 128 * lda, lda, Bt + (size_t)tn * 128 * ldb, ldb, K, lds, [&](ACC_T, int r0, int c0) __attribute__((always_inline)) {
#pragma unroll
      for (int mi = 0; mi < 4; ++mi)
#pragma unroll
        for (int ni = 0; ni < 4; ++ni) {
          const int row = tm * 128 + r0 + mi * 16 + l15, col = tn * 128 + c0 + ni * 16 + quad * 4;
          f32x4 v = acc[mi][ni];
          if (ACT == 1) {
#pragma unroll
            for (int j = 0; j < 4; ++j) { const float r = fmaxf(v[j], 0.f); v[j] = r * r; }
          }
          *(uint2*)(Out + (size_t)row * ldo + col) = make_uint2(pack2(v[0], v[1]), pack2(v[2], v[3]));
        }
    });
  }
}

__device__ __forceinline__ void phase_chan_dft(const Params& p, char* lds) {
  PH_BEGIN
  LANE_VARS
  const bf16_t* H = (const bf16_t*)(ws_ + OFF_H);
  const bf16_t* TB = (const bf16_t*)(ws_ + OFF_DFTC);
  bf16_t* YT = (bf16_t*)(ws_ + OFF_YT);
  for (int t = bid_; t < 48 * 16; t += gridDim.x) {
    const int tm = t % 48, tn = t / 48, g = tn >> 1, half = tn & 1;
    const int trow = tm * 128;
    bf16_t* base; int n, pos0;
    if (trow < 4096) { n = 256; pos0 = trow & 255; base = YT + (size_t)(trow >> 8) * (1024 * 512); }
    else { n = 1024; pos0 = (trow - 4096) & 1023; base = YT + (size_t)16 * 1024 * 512 + (size_t)((trow - 4096) >> 10) * (1024 * 2048); }
    gemm_tile<false>(H + (size_t)trow * 1024 + g * 128, 1024, TB + (size_t)half * 128 * 128, 128, 128, lds, [&](ACC_T, int r0, int c0) __attribute__((always_inline)) {
#pragma unroll
      for (int mi = 0; mi < 4; ++mi)
#pragma unroll
        for (int ni = 0; ni < 4; ++ni) {
          const int pos = pos0 + r0 + mi * 16 + quad * 4, cp = c0 + ni * 16 + l15;
          const f32x4 v = acc[mi][ni];
          *(uint2*)(base + (size_t)(g * 128 + cp) * (2 * n) + half * n + pos) = make_uint2(pack2(v[0], v[1]), pack2(v[2], v[3]));
        }
    });
  }
}

__device__ __forceinline__ void phase_pos_dft(const Params& p, char* lds) {
  PH_BEGIN
  LANE_VARS
  const bf16_t* YT = (const bf16_t*)(ws_ + OFF_YT);
  bf16_t* F = (bf16_t*)(ws_ + OFF_F);
  for (int u = bid_; u < 384; u += gridDim.x) {
    const bf16_t *A, *Bt; int ld, K, orow, tn;
    if (u < 128) {
      const int s2 = u >> 6, tm = (u >> 3) & 7; tn = u & 7;
      A = (const bf16_t*)(ws_ + OFF_DFTP1024) + (size_t)tm * 128 * 2048; ld = 2048; K = 2048;
      Bt = YT + (size_t)16 * 1024 * 512 + (size_t)s2 * 1024 * 2048 + (size_t)tn * 128 * 2048;
      orow = 4096 + s2 * 1024 + tm * 128;
    } else {
      const int v = u - 128, s = v >> 4, tm = (v >> 3) & 1; tn = v & 7;
      A = (const bf16_t*)(ws_ + OFF_DFTP256) + (size_t)tm * 128 * 512; ld = 512; K = 512;
      Bt = YT + (size_t)s * 1024 * 512 + (size_t)tn * 128 * 512;
      orow = s * 256 + tm * 128;
    }
    gemm_tile<true>(A, ld, Bt, ld, K, lds, [&](ACC_T, int r0, int c0) __attribute__((always_inline)) {
#pragma unroll
      for (int mi = 0; mi < 4; ++mi)
#pragma unroll
        for (int ni = 0; ni < 4; ++ni) {
          const int row = orow + r0 + mi * 16 + l15, col = tn * 128 + c0 + ni * 16 + quad * 4;
          const f32x4 v = acc[mi][ni];
          *(uint2*)(F + (size_t)row * 1024 + col) = make_uint2(pack2(v[0], v[1]), pack2(v[2], v[3]));
        }
    });
  }
}

__device__ __forceinline__ void phase_rwkv_gemm1(const Params& p, char* lds) {
  PH_BEGIN
  LANE_VARS
  const bf16_t* XM = (const bf16_t*)(ws_ + OFF_XM);
  const bf16_t* Bt = (const bf16_t*)(ws_ + OFF_RW1T);
  float* R = (float*)(ws_ + OFF_R); float* V = (float*)(ws_ + OFF_V); float* Kb = (float*)(ws_ + OFF_K); float* KK = (float*)(ws_ + OFF_KK);
  bf16_t* LB = (bf16_t*)(ws_ + OFF_LB);
  const float* k_k = p.in[29];
  for (int t = bid_; t < 48 * 27; t += gridDim.x) {
    const int tm = t % 48, tn = t / 48;
    int sel, kind;
    if (tn < 8) { sel = 0; kind = 0; } else if (tn < 16) { sel = 2; kind = 1; } else if (tn < 24) { sel = 3; kind = 2; }
    else { kind = 3; sel = tn == 24 ? 1 : (tn == 25 ? 4 : 5); }
    gemm_tile<true>(XM + (size_t)sel * SZ_ACT + (size_t)tm * 128 * 1024, 1024, Bt + (size_t)tn * 128 * 1024, 1024, 1024, lds, [&](ACC_T, int r0, int c0) __attribute__((always_inline)) {
      if (kind == 1) {
        const int cb = (tn - 8) * 128 + c0;
#pragma unroll
        for (int mi = 0; mi < 4; ++mi) {
          const int row = tm * 128 + r0 + mi * 16 + l15;
          f32x4 kk[4]; float ss = 0.f;
#pragma unroll
          for (int ni = 0; ni < 4; ++ni) {
            const int col = cb + ni * 16 + quad * 4;
            const f32x4 kkw = *(const f32x4*)(k_k + col);
            kk[ni] = acc[mi][ni] * kkw;
            ss += kk[ni][0] * kk[ni][0] + kk[ni][1] * kk[ni][1] + kk[ni][2] * kk[ni][2] + kk[ni][3] * kk[ni][3];
            *(f32x4*)(Kb + (size_t)row * 1024 + col) = acc[mi][ni];
          }
          ss += __shfl_xor(ss, 16); ss += __shfl_xor(ss, 32);
          const float rn = rsqrtf(ss + 1e-12f);
#pragma unroll
          for (int ni = 0; ni < 4; ++ni) *(f32x4*)(KK + (size_t)row * 1024 + cb + ni * 16 + quad * 4) = kk[ni] * rn;
          __builtin_amdgcn_sched_barrier(0);
        }
      } else if (kind == 3) {
        const int cb = (tn - 24) * 128 + c0;
#pragma unroll
        for (int mi = 0; mi < 4; ++mi)
#pragma unroll
          for (int ni = 0; ni < 4; ++ni) {
            const int row = tm * 128 + r0 + mi * 16 + l15, col = cb + ni * 16 + quad * 4;
            f32x4 v = acc[mi][ni];
            if (tn == 24) { v[0] = tanhf(v[0]); v[1] = tanhf(v[1]); v[2] = tanhf(v[2]); v[3] = tanhf(v[3]); }
            else if (tn == 26) { v[0] = sigmoidf_(v[0]); v[1] = sigmoidf_(v[1]); v[2] = sigmoidf_(v[2]); v[3] = sigmoidf_(v[3]); }
            *(uint2*)(LB + (size_t)row * 384 + col) = make_uint2(pack2(v[0], v[1]), pack2(v[2], v[3]));
            __builtin_amdgcn_sched_barrier(0);
          }
      } else {
        float* dst = kind == 0 ? R : V;
        const int cb = (kind == 0 ? tn : tn - 16) * 128 + c0;
#pragma unroll
        for (int mi = 0; mi < 4; ++mi)
#pragma unroll
          for (int ni = 0; ni < 4; ++ni)
            *(f32x4*)(dst + (size_t)(tm * 128 + r0 + mi * 16 + l15) * 1024 + cb + ni * 16 + quad * 4) = acc[mi][ni];
      }
    });
  }
}

__device__ __forceinline__ void phase_rwkv_gemm2(const Params& p, char* lds) {
  PH_BEGIN
  LANE_VARS
  const bf16_t* LB = (const bf16_t*)(ws_ + OFF_LB);
  const float* Kb = (const float*)(ws_ + OFF_K); const float* KK = (const float*)(ws_ + OFF_KK);
  float* WD = (float*)(ws_ + OFF_WDEC); float* G = (float*)(ws_ + OFF_G);
  bf16_t* KE = (bf16_t*)(ws_ + OFF_KEFF); bf16_t* NB = (bf16_t*)(ws_ + OFF_NB);
  const float* k_a = p.in[30];
  for (int t = bid_; t < 48 * 40; t += gridDim.x) {
    const int tm = t % 48, tq = t / 48, grp = tq >> 3, tn = tq & 7;
    const bf16_t* Bt; int K;
    if (grp < 2) { Bt = (const bf16_t*)(ws_ + OFF_RWW2T) + (size_t)grp * 1024 * 64; K = 64; }
    else if (grp < 4) { Bt = (const bf16_t*)(ws_ + OFF_RWA2T) + (size_t)(grp - 2) * 1024 * 64; K = 64; }
    else { Bt = (const bf16_t*)(ws_ + OFF_RWG2T); K = 128; }
    gemm_tile<true>(LB + (size_t)tm * 128 * 384 + grp * 64, 384, Bt + (size_t)tn * 128 * K, K, K, lds, [&](ACC_T, int r0, int c0) __attribute__((always_inline)) {
#pragma unroll
      for (int mi = 0; mi < 4; ++mi)
#pragma unroll
        for (int ni = 0; ni < 4; ++ni) {
          const int row = tm * 128 + r0 + mi * 16 + l15, col = tn * 128 + c0 + ni * 16 + quad * 4;
          const size_t idx = (size_t)row * 1024 + col;
          f32x4 v = acc[mi][ni];
          if (grp < 2) {
            const f32x4 w0 = *(const f32x4*)(p.in[21] + grp * 1024 + col);
            auto dec = [](float w0v, float vv) {
              const float z = -(w0v + vv);
              const float sp = fmaxf(z, 0.f) + __logf(1.f + __expf(-fabsf(z)));
              return __expf(-__expf(-sp - 0.5f));
            };
            *(f32x4*)(WD + (size_t)grp * SZ_ACT + idx) = (f32x4){dec(w0[0], v[0]), dec(w0[1], v[1]), dec(w0[2], v[2]), dec(w0[3], v[3])};
          } else if (grp < 4) {
            const int d = grp - 2;
            const f32x4 a0 = *(const f32x4*)(p.in[24] + d * 1024 + col), ka = *(const f32x4*)(k_a + col);
            const f32x4 kv = *(const f32x4*)(Kb + idx), kkv = *(const f32x4*)(KK + idx);
            const f32x4 a = (f32x4){sigmoidf_(a0[0] + v[0]), sigmoidf_(a0[1] + v[1]), sigmoidf_(a0[2] + v[2]), sigmoidf_(a0[3] + v[3])};
            const f32x4 ke = kv * (1.f + (a - 1.f) * ka);
            const f32x4 nb = -kkv * a;
            *(uint2*)(KE + (size_t)d * SZ_ACT + idx) = make_uint2(pack2(ke[0], ke[1]), pack2(ke[2], ke[3]));
            *(uint2*)(NB + (size_t)d * SZ_ACT + idx) = make_uint2(pack2(nb[0], nb[1]), pack2(nb[2], nb[3]));
          } else {
            *(f32x4*)(G + idx) = v;
          }
          __builtin_amdgcn_sched_barrier(0);
        }
    });
  }
}

__device__ __forceinline__ void phase_mla_up(const Params& p, char* lds) {
  PH_BEGIN
  LANE_VARS
  const bf16_t* QN = (const bf16_t*)(ws_ + OFF_QN);
  const bf16_t* CK = (const bf16_t*)(ws_ + OFF_CKVALL);
  bf16_t* Q = (bf16_t*)(ws_ + OFF_Q); bf16_t* KN = (bf16_t*)(ws_ + OFF_KN); bf16_t* VT = (bf16_t*)(ws_ + OFF_VT);
  const float qs = 0.07216878364870323f * 1.4426950408889634f;
  for (int t = bid_; t < 576 + 416 + 416; t += gridDim.x) {
    if (t < 576) {
      const int tm = t % 48, tn = t / 48;
      gemm_tile<true>(QN + (size_t)tm * 128 * 384, 384, (const bf16_t*)(ws_ + OFF_MUQT) + (size_t)tn * 128 * 384, 384, 384, lds, [&](ACC_T, int r0, int c0) __attribute__((always_inline)) {
        const int cb = tn * 128 + c0;
        const bool ropeblk = (cb % 192) == 128;
#pragma unroll
        for (int mi = 0; mi < 4; ++mi) {
          const int row = tm * 128 + r0 + mi * 16 + l15;
          f32x4 v[4];
#pragma unroll
          for (int ni = 0; ni < 4; ++ni) v[ni] = acc[mi][ni] * qs;
          if (ropeblk && row >= 4096) {
            const int pp = (row - 4096) & 1023;
#pragma unroll
            for (int ax = 0; ax < 2; ++ax) {
              const float posv = ax ? (float)(pp & 63) : (float)(pp >> 6);
#pragma unroll
              for (int j = 0; j < 4; ++j) {
                const float inv = exp2f(-(float)(quad * 4 + j) * 0.8304820237218406f);
                const float rev = posv * inv * 0.15915494309189535f;
                const float sn = __builtin_amdgcn_sinf(rev), cs = __builtin_amdgcn_cosf(rev);
                const float x1 = v[2 * ax][j], x2 = v[2 * ax + 1][j];
                v[2 * ax][j] = x1 * cs - x2 * sn; v[2 * ax + 1][j] = x1 * sn + x2 * cs;
              }
            }
          }
#pragma unroll
          for (int ni = 0; ni < 4; ++ni)
            *(uint2*)(Q + (size_t)row * 1536 + cb + ni * 16 + quad * 4) = make_uint2(pack2(v[ni][0], v[ni][1]), pack2(v[ni][2], v[ni][3]));
        }
      });
    } else if (t < 576 + 416) {
      const int u = t - 576, tm = u % 52, tn = u / 52;
      gemm_tile<true>(CK + (size_t)tm * 128 * 256, 256, (const bf16_t*)(ws_ + OFF_MUKT) + (size_t)tn * 128 * 256, 256, 256, lds, [&](ACC_T, int r0, int c0) __attribute__((always_inline)) {
#pragma unroll
        for (int mi = 0; mi < 4; ++mi)
#pragma unroll
          for (int ni = 0; ni < 4; ++ni) {
            const f32x4 v = acc[mi][ni];
            *(uint2*)(KN + (size_t)(tm * 128 + r0 + mi * 16 + l15) * 1024 + tn * 128 + c0 + ni * 16 + quad * 4) = make_uint2(pack2(v[0], v[1]), pack2(v[2], v[3]));
          }
      });
    } else {
      const int u = t - 576 - 416, tm = u % 52, tn = u / 52;
      const int krow = tm * 128;
      bf16_t* base; int ldv, kp0;
      if (krow < 4096) { base = VT + (size_t)(krow >> 8) * 262144; ldv = 256; kp0 = krow & 255; }
      else { const int r = krow - 4096, s2 = r / 1280; base = VT + 4194304 + (size_t)s2 * 1310720; ldv = 1280; kp0 = r - s2 * 1280; }
      gemm_tile<false>(CK + (size_t)tm * 128 * 256, 256, (const bf16_t*)(ws_ + OFF_MUVT) + (size_t)tn * 128 * 256, 256, 256, lds, [&](ACC_T, int r0, int c0) __attribute__((always_inline)) {
#pragma unroll
        for (int mi = 0; mi < 4; ++mi)
#pragma unroll
          for (int ni = 0; ni < 4; ++ni) {
            const f32x4 v = acc[mi][ni];
            const int n = tn * 128 + c0 + ni * 16 + l15, kp = kp0 + r0 + mi * 16 + quad * 4;
            *(uint2*)(base + (size_t)n * ldv + kp) = make_uint2(pack2(v[0], v[1]), pack2(v[2], v[3]));
          }
      });
    }
  }
}

__device__ __forceinline__ void phase_scan(const Params& p, char* lds, int cidx = 0) {
  PH_BEGIN
  const int tid = tid_, lane = tid & 63, wid = tid >> 6;
  unsigned* ctr = (unsigned*)(ws_ + OFF_CTR) + cidx;
  const float* R = (const float*)(ws_ + OFF_R); const float* V = (const float*)(ws_ + OFF_V); const float* KK = (const float*)(ws_ + OFF_KK);
  volatile int& s_item = *(volatile int*)(lds + 57344);
  float* vb = (float*)lds;
  float* yb = (float*)(lds + 49152);
  const int vrow = wid * 16 + (lane >> 2), kq = lane & 3;
  const int lsi = tid >> 4, lc4 = (tid & 15) * 4;
  for (;;) {
    if (tid == 0) s_item = (int)atomicAdd(ctr, 1u);
    __syncthreads();
    const int item = s_item;
    __syncthreads();
    if (item >= 576) break;
    int n, tok0, h, dir; const float* sinit = nullptr; float* sfin = nullptr;
    if (item < 64) { const int s2 = item >> 5; h = (item >> 1) & 15; dir = item & 1; n = 1024; tok0 = 4096 + s2 * 1024; sinit = p.in[2] + (size_t)((s2 * 2 + dir) * 16 + h) * 4096; }
    else { const int j = item - 64, s = j >> 5; h = (j >> 1) & 15; dir = j & 1; n = 256; tok0 = s * 256; sfin = p.out + OUT_STATE + (size_t)((s * 2 + dir) * 16 + h) * 4096; }
    const float* WD = (const float*)(ws_ + OFF_WDEC) + (size_t)dir * SZ_ACT;
    const bf16_t* KE = (const bf16_t*)(ws_ + OFF_KEFF) + (size_t)dir * SZ_ACT;
    const bf16_t* NB = (const bf16_t*)(ws_ + OFF_NB) + (size_t)dir * SZ_ACT;
    float* Y = (float*)(ws_ + (dir ? OFF_Y1 : OFF_Y0));
    f32x2 S[8];
#pragma unroll
    for (int i = 0; i < 8; ++i) S[i] = sinit ? *(const f32x2*)(sinit + vrow * 64 + kq * 16 + 2 * i) : (f32x2){0.f, 0.f};
    const int nch = n >> 4;
    f32x4 lr, lw, lke, lkk, lnb, lv;
    auto gload = [&](int c) {
      const int tt = c * 16 + lsi, tm = dir ? (n - 1 - tt) : tt;
      const size_t idx = (size_t)(tok0 + tm) * 1024 + h * 64 + lc4;
      lr = *(const f32x4*)(R + idx); lw = *(const f32x4*)(WD + idx); lkk = *(const f32x4*)(KK + idx); lv = *(const f32x4*)(V + idx);
      const uint2 a = *(const uint2*)(KE + idx), b = *(const uint2*)(NB + idx);
      lke = (f32x4){bflo(a.x), bfhi(a.x), bflo(a.y), bfhi(a.y)};
      lnb = (f32x4){bflo(b.x), bfhi(b.x), bflo(b.y), bfhi(b.y)};
    };
    auto lstore = [&](int buf) {
      float* d = vb + buf * 6144 + lsi * 384 + lc4;
      *(f32x4*)(d) = lr; *(f32x4*)(d + 64) = lw; *(f32x4*)(d + 128) = lke; *(f32x4*)(d + 192) = lkk; *(f32x4*)(d + 256) = lnb; *(f32x4*)(d + 320) = lv;
    };
    gload(0); lstore(0);
    __syncthreads();
    for (int c = 0; c < nch; ++c) {
      const int buf = c & 1;
      if (c + 1 < nch) gload(c + 1);
      const float* cb = vb + buf * 6144;
      float* ycb = yb + buf * 1024;
#pragma unroll 4
      for (int s = 0; s < 16; ++s) {
        const float* sv = cb + s * 384 + kq * 16;
        f32x2 a2 = {0.f, 0.f};
#pragma unroll
        for (int i = 0; i < 4; ++i) {
          const f32x4 k4 = *(const f32x4*)(sv + 192 + 4 * i);
          a2 += S[2 * i] * (f32x2){k4[0], k4[1]};
          a2 += S[2 * i + 1] * (f32x2){k4[2], k4[3]};
        }
        const float sa = quad_sum(a2[0] + a2[1]);
        const float vv = cb[s * 384 + 320 + vrow];
        const f32x2 sa2 = {sa, sa}, vv2 = {vv, vv};
        f32x2 y2 = {0.f, 0.f};
#pragma unroll
        for (int i = 0; i < 4; ++i) {
          const f32x4 w4 = *(const f32x4*)(sv + 64 + 4 * i), b4 = *(const f32x4*)(sv + 256 + 4 * i), e4 = *(const f32x4*)(sv + 128 + 4 * i), r4 = *(const f32x4*)(sv + 4 * i);
          S[2 * i] = S[2 * i] * (f32x2){w4[0], w4[1]} + sa2 * (f32x2){b4[0], b4[1]} + vv2 * (f32x2){e4[0], e4[1]};
          S[2 * i + 1] = S[2 * i + 1] * (f32x2){w4[2], w4[3]} + sa2 * (f32x2){b4[2], b4[3]} + vv2 * (f32x2){e4[2], e4[3]};
          y2 += S[2 * i] * (f32x2){r4[0], r4[1]};
          y2 += S[2 * i + 1] * (f32x2){r4[2], r4[3]};
        }
        const float y = quad_sum(y2[0] + y2[1]);
        if (kq == 0) ycb[s * 64 + vrow] = y;
      }
      if (c + 1 < nch) lstore(buf ^ 1);
      __syncthreads();
      {
        const int tt = c * 16 + lsi, tm = dir ? (n - 1 - tt) : tt;
        *(f32x4*)(Y + (size_t)(tok0 + tm) * 1024 + h * 64 + lc4) = *(const f32x4*)(ycb + lsi * 64 + lc4);
      }
    }
    if (sfin) {
#pragma unroll
      for (int i = 0; i < 8; ++i) *(f32x2*)(sfin + vrow * 64 + kq * 16 + 2 * i) = S[i];
    }
    __syncthreads();
  }
}

__device__ __forceinline__ void phase_attn(const Params& p, int cidx = 1) {
  PH_BEGIN
  const int lane = tid_ & 63, l15 = lane & 15, quad = lane >> 4;
  unsigned* ctr = (unsigned*)(ws_ + OFF_CTR) + cidx;
  const bf16_t* Q = (const bf16_t*)(ws_ + OFF_Q); const bf16_t* KN = (const bf16_t*)(ws_ + OFF_KN);
  const bf16_t* KR = (const bf16_t*)(ws_ + OFF_KRALL); const bf16_t* VT = (const bf16_t*)(ws_ + OFF_VT);
  bf16_t* OA = (bf16_t*)(ws_ + OFF_H);
  for (;;) {
    int item = 0;
    if (lane == 0) item = (int)atomicAdd(ctr, 1u);
    item = __builtin_amdgcn_readfirstlane(item);
    if (item >= 3072) break;
    int h, qrow0, nkeys, keybase; const bf16_t* vt;
    if (item < 1024) { const int s2 = item >> 9; h = (item >> 6) & 7; qrow0 = 4096 + s2 * 1024 + (item & 63) * 16; nkeys = 1280; keybase = 4096 + s2 * 1280; vt = VT + 4194304 + (size_t)s2 * 1310720; }
    else { const int j = item - 1024, s = j >> 7; h = (j >> 4) & 7; qrow0 = s * 256 + (j & 15) * 16; nkeys = 256; keybase = s * 256; vt = VT + (size_t)s * 262144; }
    vt += (size_t)(h * 128) * nkeys;
    bf16x8 qf[6];
#pragma unroll
    for (int ks = 0; ks < 6; ++ks) qf[ks] = *(const bf16x8*)(Q + (size_t)(qrow0 + l15) * 1536 + h * 192 + ks * 32 + quad * 8);
    f32x4 oacc[8];
#pragma unroll
    for (int i = 0; i < 8; ++i) oacc[i] = (f32x4){0.f, 0.f, 0.f, 0.f};
    float m = -1e30f, lsum = 0.f;
    for (int c = 0; c < nkeys; c += 32) {
      f32x4 st[2];
#pragma unroll
      for (int kt = 0; kt < 2; ++kt) {
        const size_t kr = (size_t)(keybase + c + kt * 16 + l15);
        st[kt] = (f32x4){0.f, 0.f, 0.f, 0.f};
#pragma unroll
        for (int ks = 0; ks < 4; ++ks) {
          const bf16x8 kf = *(const bf16x8*)(KN + kr * 1024 + h * 128 + ks * 32 + quad * 8);
          st[kt] = __builtin_amdgcn_mfma_f32_16x16x32_bf16(kf, qf[ks], st[kt], 0, 0, 0);
        }
#pragma unroll
        for (int ks = 0; ks < 2; ++ks) {
          const bf16x8 kf = *(const bf16x8*)(KR + kr * 64 + ks * 32 + quad * 8);
          st[kt] = __builtin_amdgcn_mfma_f32_16x16x32_bf16(kf, qf[4 + ks], st[kt], 0, 0, 0);
        }
      }
      float cm = fmaxf(fmaxf(fmaxf(st[0][0], st[0][1]), fmaxf(st[0][2], st[0][3])), fmaxf(fmaxf(st[1][0], st[1][1]), fmaxf(st[1][2], st[1][3])));
      cm = fmaxf(cm, __shfl_xor(cm, 16)); cm = fmaxf(cm, __shfl_xor(cm, 32));
      const float mn = fmaxf(m, cm), alpha = exp2f(m - mn);
      m = mn;
      float ps = 0.f; float pv[8];
#pragma unroll
      for (int e = 0; e < 8; ++e) { pv[e] = exp2f(st[e >> 2][e & 3] - mn); ps += pv[e]; }
      lsum = lsum * alpha + ps;
      union { bf16x8 v; unsigned u[4]; } pb;
      pb.u[0] = pack2(pv[0], pv[1]); pb.u[1] = pack2(pv[2], pv[3]); pb.u[2] = pack2(pv[4], pv[5]); pb.u[3] = pack2(pv[6], pv[7]);
#pragma unroll
      for (int dvt = 0; dvt < 8; ++dvt) {
        const bf16_t* vp = vt + (size_t)(dvt * 16 + l15) * nkeys + c + quad * 4;
        union { bf16x8 v; uint2 u[2]; } vf;
        vf.u[0] = *(const uint2*)vp; vf.u[1] = *(const uint2*)(vp + 16);
        oacc[dvt] = __builtin_amdgcn_mfma_f32_16x16x32_bf16(vf.v, pb.v, oacc[dvt] * alpha, 0, 0, 0);
      }
    }
    lsum += __shfl_xor(lsum, 16); lsum += __shfl_xor(lsum, 32);
    const float il = 1.f / lsum;
#pragma unroll
    for (int dvt = 0; dvt < 8; ++dvt) {
      const f32x4 o = oacc[dvt] * il;
      *(uint2*)(OA + (size_t)(qrow0 + l15) * 1024 + h * 128 + dvt * 16 + quad * 4) = make_uint2(pack2(o[0], o[1]), pack2(o[2], o[3]));
    }
  }
}

#define SC_TOL 0.2f
#define DBG_MIXER_UPD true
#define SKIPMASK 0x0ull
#ifdef SELFCHECK
__device__ __forceinline__ unsigned hsh(unsigned x) { x ^= x >> 16; x *= 0x7feb352dU; x ^= x >> 15; x *= 0x846ca68bU; x ^= x >> 16; return x; }
__device__ __forceinline__ float b2f(bf16_t h) { return __uint_as_float(((unsigned)h) << 16); }
__device__ __forceinline__ void rep(const Params& p, int id, float got, float ref, float atol) {
  float e = fabsf(got - ref) / (fabsf(ref) + atol);
  if (!(e == e) || e > 1e9f) e = 1e9f;
  atomicMax((unsigned*)(p.ws + OFF_CTR) + 8 + id, __float_as_uint(e));
}
__device__ __forceinline__ float dotA(const bf16_t* a, const float* w, int ldw, int K) { float s = 0.f; for (int k = 0; k < K; ++k) s += b2f(a[k]) * w[(size_t)k * ldw]; return s; }
#define GID (bid_ * 256 + tid_)
#define NTHR (gridDim.x * 256)
__device__ __forceinline__ int seq_start(int row) { return row < 4096 ? (row & ~255) : 4096 + ((row - 4096) & ~1023); }
__device__ __forceinline__ int seq_len(int row) { return row < 4096 ? 256 : 1024; }
__device__ __forceinline__ int key_row(int row) { if (row < 4096) return row; const int r = row - 4096; return 4096 + (r >> 10) * 1280 + 256 + (r & 1023); }

__device__ __forceinline__ void chk_modv(const Params& p) {
  PH_BEGIN
  for (int i = GID; i < 4 * 3 * 6144; i += NTHR) {
    const int l = i / 18432, g = (i / 6144) % 3, n = i % 6144;
    float s = 0.f;
    for (int k = 0; k < 1024; ++k) { const float c = g == 0 ? p.in[6][k] : p.in[5][(g - 1) * 1024 + k]; s += c / (1.f + expf(-c)) * p.in[7][((size_t)l * 1024 + k) * 6144 + n]; }
    rep(p, 0, ((const float*)(ws_ + OFF_MOD))[i], s + p.in[8][l * 6144 + n], 0.2f);
  }
}
__device__ __forceinline__ void chk_h(const Params& p, int id, int l, int gi, int shi) {
  PH_BEGIN
  const int s = GID; if (s >= 512) return;
  const int row = hsh(s * 2 + id * 7919) % 6144, col = hsh(s * 2 + 1 + id * 7919) & 1023, g = row_group(row);
  const float* x = p.out + (size_t)row * 1024;
  float ss = 0.f; for (int k = 0; k < 1024; ++k) ss += x[k] * x[k];
  const float rs = 1.f / sqrtf(ss / 1024.f + 1e-6f);
  const float* mv = (const float*)(ws_ + OFF_MOD) + ((l * 3 + g) * 6 + shi) * 1024;
  const float ref = x[col] * rs * p.in[9][(l * 4 + gi) * 1024 + col] * (1.f + mv[1024 + col]) + mv[col];
  rep(p, id, b2f(((const bf16_t*)(ws_ + OFF_H))[(size_t)row * 1024 + col]), ref, 0.3f);
}
__device__ __forceinline__ void chk_o(const Params& p, int id, const bf16_t* A, int K, const float* W) {
  PH_BEGIN
  const int s = GID; if (s >= 512) return;
  const int row = hsh(s * 2 + id * 7919) % 6144, col = hsh(s * 2 + 1 + id * 7919) & 1023;
  rep(p, id, ((const float*)(ws_ + OFF_O))[(size_t)row * 1024 + col], dotA(A + (size_t)row * K, W + col, 1024, K), 0.3f);
}
__device__ __forceinline__ void chk_hid(const Params& p, int id, int l) {
  PH_BEGIN
  const int s = GID; if (s >= 512) return;
  const int row = hsh(s * 2 + id * 7919) % 6144, col = hsh(s * 2 + 1 + id * 7919) & 4095;
  float d = dotA((const bf16_t*)(ws_ + OFF_H) + (size_t)row * 1024, p.in[10] + (size_t)l * 1024 * 4096 + col, 4096, 1024);
  d = fmaxf(d, 0.f); d *= d;
  rep(p, id, b2f(((const bf16_t*)(ws_ + OFF_HID))[(size_t)row * 4096 + col]), d, 0.5f);
}
__device__ __forceinline__ void chk_fft(const Params& p, int id) {
  PH_BEGIN
  const int s = GID; if (s >= 128) return;
  const int row = hsh(s * 2 + id * 7919) % 6144, col = hsh(s * 2 + 1 + id * 7919) & 1023;
  const int s0 = seq_start(row), n = seq_len(row), tp = row - s0, g = col >> 7, cp = col & 127;
  const bf16_t* H = (const bf16_t*)(ws_ + OFF_H);
  float acc = 0.f;
  for (int t = 0; t < n; ++t) {
    const float a = (float)((t * tp) % n) / (float)n;
    for (int c = 0; c < 128; ++c) {
      const float b = (float)((c * cp) & 127) / 128.f;
      acc += b2f(H[(size_t)(s0 + t) * 1024 + g * 128 + c]) * cosf(6.283185307179586f * (a + b));
    }
  }
  rep(p, id, b2f(((const bf16_t*)(ws_ + OFF_F))[(size_t)row * 1024 + col]), acc / sqrtf(128.f * n), 0.3f);
}
__device__ __forceinline__ void chk_bcu(const Params& p, int id) {
  PH_BEGIN
  const int s = GID; if (s >= 512) return;
  const int row = hsh(s * 2 + id * 7919) % 6144, col = hsh(s * 2 + 1 + id * 7919) % 3072;
  rep(p, id, b2f(((const bf16_t*)(ws_ + OFF_BCU))[(size_t)row * 3072 + col]), dotA((const bf16_t*)(ws_ + OFF_H) + (size_t)row * 1024, p.in[13] + col, 3072, 1024), 0.3f);
}
__device__ __forceinline__ void chk_a2(const Params& p, int id) {
  PH_BEGIN
  const int s = GID; if (s >= 512) return;
  const int row = hsh(s * 2 + id * 7919) % 6144, col = hsh(s * 2 + 1 + id * 7919) & 1023;
  const bf16_t* B = (const bf16_t*)(ws_ + OFF_BCU);
  const int pos = row - seq_start(row), n = seq_len(row);
  auto z = [&](int r) { return b2f(B[(size_t)r * 3072 + 1024 + col]) * b2f(B[(size_t)r * 3072 + 2048 + col]); };
  float cv = z(row) * p.in[14][1024 + col];
  if (pos > 0) cv += z(row - 1) * p.in[14][col];
  if (pos < n - 1) cv += z(row + 1) * p.in[14][2048 + col];
  rep(p, id, b2f(((const bf16_t*)(ws_ + OFF_A2))[(size_t)row * 1024 + col]), b2f(B[(size_t)row * 3072 + col]) * cv, 0.3f);
}
__device__ __forceinline__ void chk_xm(const Params& p, int id) {
  PH_BEGIN
  const int s = GID; if (s >= 512) return;
  const int row = hsh(s * 2 + id * 7919) % 6144, col = hsh(s * 2 + 1 + id * 7919) & 1023, m = s % 6, g = row_group(row);
  const int pos = row - seq_start(row), n = seq_len(row);
  const float* mv = (const float*)(ws_ + OFF_MOD) + ((2 * 3 + g) * 6 + 0) * 1024;
  auto hval = [&](int r) {
    const float* x = p.out + (size_t)r * 1024; float ss = 0.f; for (int k = 0; k < 1024; ++k) ss += x[k] * x[k];
    return x[col] / sqrtf(ss / 1024.f + 1e-6f) * p.in[9][(2 * 4 + 0) * 1024 + col] * (1.f + mv[1024 + col]) + mv[col]; };
  const float hc = hval(row), hp = pos > 0 ? hval(row - 1) : 0.f, hn = pos < n - 1 ? hval(row + 1) : 0.f;
  const float ref = hc + (0.5f * (hp + hn) - hc) * p.in[16][m * 1024 + col];
  rep(p, id, b2f(((const bf16_t*)(ws_ + OFF_XM))[(size_t)m * SZ_ACT + (size_t)row * 1024 + col]), ref, 0.3f);
}
__device__ __forceinline__ void chk_rw1(const Params& p, int id0) {
  PH_BEGIN
  const int s = GID; if (s >= 512) return;
  const int row = hsh(s * 2 + id0 * 7919) % 6144, col = hsh(s * 2 + 1 + id0 * 7919) & 1023;
  const bf16_t* XM = (const bf16_t*)(ws_ + OFF_XM);
  rep(p, id0 + 0, ((const float*)(ws_ + OFF_R))[(size_t)row * 1024 + col], dotA(XM + 0 * SZ_ACT + (size_t)row * 1024, p.in[17] + col, 1024, 1024), 0.3f);
  rep(p, id0 + 1, ((const float*)(ws_ + OFF_K))[(size_t)row * 1024 + col], dotA(XM + 2 * SZ_ACT + (size_t)row * 1024, p.in[18] + col, 1024, 1024), 0.3f);
  rep(p, id0 + 2, ((const float*)(ws_ + OFF_V))[(size_t)row * 1024 + col], dotA(XM + 3 * SZ_ACT + (size_t)row * 1024, p.in[19] + col, 1024, 1024), 0.3f);
  const int lc = col % 384; float lr;
  if (lc < 128) lr = tanhf(dotA(XM + 1 * SZ_ACT + (size_t)row * 1024, p.in[22] + (size_t)(lc >> 6) * 1024 * 64 + (lc & 63), 64, 1024));
  else if (lc < 256) lr = dotA(XM + 4 * SZ_ACT + (size_t)row * 1024, p.in[25] + (size_t)((lc - 128) >> 6) * 1024 * 64 + (lc & 63), 64, 1024);
  else { lr = dotA(XM + 5 * SZ_ACT + (size_t)row * 1024, p.in[27] + (lc - 256), 128, 1024); lr = 1.f / (1.f + expf(-lr)); }
  rep(p, id0 + 3, b2f(((const bf16_t*)(ws_ + OFF_LB))[(size_t)row * 384 + lc]), lr, 0.2f);
  const float* Kb = (const float*)(ws_ + OFF_K) + (size_t)row * 1024 + (col & ~63);
  float ss = 0.f; for (int c = 0; c < 64; ++c) { const float v = Kb[c] * p.in[29][(col & ~63) + c]; ss += v * v; }
  rep(p, id0 + 4, ((const float*)(ws_ + OFF_KK))[(size_t)row * 1024 + col], Kb[col & 63] * p.in[29][col] / sqrtf(ss + 1e-12f), 0.03f);
}
__device__ __forceinline__ void chk_rw2(const Params& p, int id0) {
  PH_BEGIN
  const int s = GID; if (s >= 512) return;
  const int row = hsh(s * 2 + id0 * 7919) % 6144, col = hsh(s * 2 + 1 + id0 * 7919) & 1023, d = s & 1;
  const bf16_t* LB = (const bf16_t*)(ws_ + OFF_LB) + (size_t)row * 384;
  const size_t idx = (size_t)row * 1024 + col;
  const float z = p.in[21][d * 1024 + col] + dotA(LB + d * 64, p.in[23] + (size_t)d * 64 * 1024 + col, 1024, 64);
  const float logw = -log1pf(expf(-z)) - 0.5f;
  rep(p, id0 + 0, ((const float*)(ws_ + OFF_WDEC))[(size_t)d * SZ_ACT + idx], expf(-expf(logw)), 0.2f);
  const float a = 1.f / (1.f + expf(-(p.in[24][d * 1024 + col] + dotA(LB + 128 + d * 64, p.in[26] + (size_t)d * 64 * 1024 + col, 1024, 64))));
  const float kv = ((const float*)(ws_ + OFF_K))[idx], kkv = ((const float*)(ws_ + OFF_KK))[idx];
  rep(p, id0 + 1, b2f(((const bf16_t*)(ws_ + OFF_KEFF))[(size_t)d * SZ_ACT + idx]), kv * (1.f + (a - 1.f) * p.in[30][col]), 0.3f);
  rep(p, id0 + 2, b2f(((const bf16_t*)(ws_ + OFF_NB))[(size_t)d * SZ_ACT + idx]), -kkv * a, 0.02f);
  rep(p, id0 + 3, ((const float*)(ws_ + OFF_G))[idx], dotA(LB + 256, p.in[28] + col, 1024, 128), 0.2f);
}
__device__ __forceinline__ void chk_scan(const Params& p, int id0) {
  PH_BEGIN
  const int s = GID; if (s >= 64) return;
  const int item = s < 8 ? s * 7 : 64 + (hsh(s) % 512), v = hsh(s + 77) & 63;
  int n, tok0, h, dir; const float* sinit = nullptr; const float* sfin = nullptr;
  if (item < 64) { const int s2 = item >> 5; h = (item >> 1) & 15; dir = item & 1; n = 1024; tok0 = 4096 + s2 * 1024; sinit = p.in[2] + (size_t)((s2 * 2 + dir) * 16 + h) * 4096; }
  else { const int j = item - 64, sq = j >> 5; h = (j >> 1) & 15; dir = j & 1; n = 256; tok0 = sq * 256; sfin = p.out + OUT_STATE + (size_t)((sq * 2 + dir) * 16 + h) * 4096; }
  const float* R = (const float*)(ws_ + OFF_R); const float* V = (const float*)(ws_ + OFF_V); const float* KK = (const float*)(ws_ + OFF_KK);
  const float* WD = (const float*)(ws_ + OFF_WDEC) + (size_t)dir * SZ_ACT;
  const bf16_t* KE = (const bf16_t*)(ws_ + OFF_KEFF) + (size_t)dir * SZ_ACT; const bf16_t* NB = (const bf16_t*)(ws_ + OFF_NB) + (size_t)dir * SZ_ACT;
  const float* Y = (const float*)(ws_ + (dir ? OFF_Y1 : OFF_Y0));
  float S[64];
#pragma unroll
  for (int k = 0; k < 64; ++k) S[k] = sinit ? sinit[v * 64 + k] : 0.f;
  for (int tt = 0; tt < n; ++tt) {
    const int t = dir ? n - 1 - tt : tt; const size_t b = (size_t)(tok0 + t) * 1024 + h * 64;
    float sa = 0.f;
#pragma unroll
    for (int k = 0; k < 64; ++k) sa += S[k] * KK[b + k];
    const float vv = V[b + v]; float y = 0.f;
#pragma unroll
    for (int k = 0; k < 64; ++k) { S[k] = S[k] * WD[b + k] + sa * b2f(NB[b + k]) + vv * b2f(KE[b + k]); y += S[k] * R[b + k]; }
    rep(p, id0, Y[b + v], y, 0.05f);
  }
  if (sfin) {
#pragma unroll
    for (int k = 0; k < 64; ++k) rep(p, id0 + 1, sfin[v * 64 + k], S[k], 0.05f);
  }
}
__device__ __forceinline__ void chk_z(const Params& p, int id) {
  PH_BEGIN
  const int s = GID; if (s >= 512) return;
  const int row = hsh(s * 2 + id * 7919) % 6144, col = hsh(s * 2 + 1 + id * 7919) & 1023, hb = col & ~63;
  const size_t b = (size_t)row * 1024 + hb;
  const float* Y0 = (const float*)(ws_ + OFF_Y0); const float* Y1 = (const float*)(ws_ + OFF_Y1); const float* R = (const float*)(ws_ + OFF_R);
  const bf16_t* KE = (const bf16_t*)(ws_ + OFF_KEFF);
  float mean = 0.f, bon = 0.f;
  for (int c = 0; c < 64; ++c) { mean += Y0[b + c] + Y1[b + c]; bon += R[b + c] * (b2f(KE[b + c]) + b2f(KE[SZ_ACT + b + c])) * p.in[31][hb + c]; }
  mean /= 64.f; float var = 0.f;
  for (int c = 0; c < 64; ++c) { const float d = Y0[b + c] + Y1[b + c] - mean; var += d * d; }
  var /= 64.f;
  const size_t i = (size_t)row * 1024 + col;
  const float ref = ((Y0[i] + Y1[i] - mean) / sqrtf(var + 64e-5f) * p.in[32][col] + p.in[33][col] + bon * ((const float*)(ws_ + OFF_V))[i]) * ((const float*)(ws_ + OFF_G))[i];
  rep(p, id, b2f(((const bf16_t*)(ws_ + OFF_H))[i]), ref, 0.2f);
}
__device__ __forceinline__ void chk_qc(const Params& p, int id) {
  PH_BEGIN
  const int s = GID; if (s >= 512) return;
  const int row = hsh(s * 2 + id * 7919) % 6144, col = hsh(s * 2 + 1 + id * 7919) % 704;
  const bf16_t* a = (const bf16_t*)(ws_ + OFF_H) + (size_t)row * 1024;
  const float ref = col < 384 ? dotA(a, p.in[34] + col, 384, 1024) : dotA(a, p.in[37] + (col - 384), 320, 1024);
  rep(p, id, ((const float*)(ws_ + OFF_QC))[(size_t)row * 704 + col], ref, 0.3f);
}
__device__ __forceinline__ float rope_ref(float x, float partner, int r  , int pp) {
  const int ax = r >> 5, part = (r >> 4) & 1, i = r & 15;
  const float ang = (ax ? (float)(pp & 63) : (float)(pp >> 6)) * powf(10000.f, -(float)i / 16.f);
  return part == 0 ? x * cosf(ang) - partner * sinf(ang) : partner * sinf(ang) + x * cosf(ang);
}
__device__ __forceinline__ void chk_mlarows(const Params& p, int id0) {
  PH_BEGIN
  const int s = GID; if (s >= 512) return;
  const int row = hsh(s * 2 + id0 * 7919) % 6144, c0 = hsh(s * 2 + 1 + id0 * 7919);
  const float* q = (const float*)(ws_ + OFF_QC) + (size_t)row * 704;
  float ss = 0.f; for (int k = 0; k < 384; ++k) ss += q[k] * q[k];
  int col = c0 % 384;
  rep(p, id0, b2f(((const bf16_t*)(ws_ + OFF_QN))[(size_t)row * 384 + col]), q[col] / sqrtf(ss / 384.f + 1e-6f) * p.in[35][col], 0.3f);
  ss = 0.f; for (int k = 0; k < 256; ++k) ss += q[384 + k] * q[384 + k];
  col = c0 & 255;
  const float cr = q[384 + col] / sqrtf(ss / 256.f + 1e-6f) * p.in[38][col];
  rep(p, id0 + 1, b2f(((const bf16_t*)(ws_ + OFF_CKVALL))[(size_t)key_row(row) * 256 + col]), cr, 0.3f);
  if (row < 4096) rep(p, id0 + 1, p.out[OUT_CKV + (size_t)row * 256 + col], cr, 0.3f);
  col = c0 & 63;
  float kr = q[640 + col];
  if (row >= 4096) kr = rope_ref(kr, q[640 + (col ^ 16)], col, (row - 4096) & 1023);
  else rep(p, id0 + 2, p.out[OUT_KROPE + (size_t)row * 64 + col], kr, 0.3f);
  rep(p, id0 + 2, b2f(((const bf16_t*)(ws_ + OFF_KRALL))[(size_t)key_row(row) * 64 + col]), kr, 0.3f);
}
__device__ __forceinline__ void chk_up(const Params& p, int id0) {
  PH_BEGIN
  const int s = GID; if (s >= 512) return;
  const int row = hsh(s * 2 + id0 * 7919) % 6144, c0 = hsh(s * 2 + 1 + id0 * 7919);
  const float qs = 0.07216878364870323f * 1.4426950408889634f;
  int col = c0 % 1536;
  const bf16_t* qn = (const bf16_t*)(ws_ + OFF_QN) + (size_t)row * 384;
  float d = dotA(qn, p.in[36] + col, 1536, 384) * qs;
  const int r = col % 192 - 128;
  if (r >= 0 && row >= 4096) d = rope_ref(d, dotA(qn, p.in[36] + (col ^ 16), 1536, 384) * qs, r, (row - 4096) & 1023);
  rep(p, id0, b2f(((const bf16_t*)(ws_ + OFF_Q))[(size_t)row * 1536 + col]), d, 0.03f);
  const int kr = hsh(s + 1234567) % 6656; col = c0 & 1023;
  const bf16_t* ck = (const bf16_t*)(ws_ + OFF_CKVALL) + (size_t)kr * 256;
  rep(p, id0 + 1, b2f(((const bf16_t*)(ws_ + OFF_KN))[(size_t)kr * 1024 + col]), dotA(ck, p.in[39] + col, 1024, 256), 0.3f);
  const bf16_t* VT = (const bf16_t*)(ws_ + OFF_VT);
  size_t vi;
  if (kr < 4096) vi = (size_t)(kr >> 8) * 262144 + (size_t)col * 256 + (kr & 255);
  else { const int rr = kr - 4096, s2 = rr / 1280; vi = 4194304 + (size_t)s2 * 1310720 + (size_t)col * 1280 + (rr - s2 * 1280); }
  rep(p, id0 + 2, b2f(VT[vi]), dotA(ck, p.in[40] + col, 1024, 256), 0.3f);
}
__device__ __forceinline__ void chk_attn(const Params& p, int id) {
  PH_BEGIN
  const int s = GID; if (s >= 128) return;
  const int row = hsh(s * 2 + id * 7919) % 6144, c0 = hsh(s * 2 + 1 + id * 7919), h = c0 & 7, dv = (c0 >> 3) & 127;
  int kb, nk; const bf16_t* vt;
  const bf16_t* VT = (const bf16_t*)(ws_ + OFF_VT);
  if (row < 4096) { kb = row & ~255; nk = 256; vt = VT + (size_t)(row >> 8) * 262144 + (size_t)(h * 128 + dv) * 256; }
  else { const int s2 = (row - 4096) >> 10; kb = 4096 + s2 * 1280; nk = 1280; vt = VT + 4194304 + (size_t)s2 * 1310720 + (size_t)(h * 128 + dv) * 1280; }
  const bf16_t* q = (const bf16_t*)(ws_ + OFF_Q) + (size_t)row * 1536 + h * 192;
  const bf16_t* KN = (const bf16_t*)(ws_ + OFF_KN); const bf16_t* KR = (const bf16_t*)(ws_ + OFF_KRALL);
  float m = -1e30f, l = 0.f, o = 0.f;
  for (int j = 0; j < nk; ++j) {
    float sc = 0.f;
    for (int d = 0; d < 128; ++d) sc += b2f(q[d]) * b2f(KN[(size_t)(kb + j) * 1024 + h * 128 + d]);
    for (int d = 0; d < 64; ++d) sc += b2f(q[128 + d]) * b2f(KR[(size_t)(kb + j) * 64 + d]);
    const float mn = fmaxf(m, sc), al = exp2f(m - mn), pj = exp2f(sc - mn);
    l = l * al + pj; o = o * al + pj * b2f(vt[j]); m = mn;
  }
  rep(p, id, b2f(((const bf16_t*)(ws_ + OFF_H))[(size_t)row * 1024 + h * 128 + dv]), o / l, 0.03f);
}
__device__ __forceinline__ void chk_yt(const Params& p, int id) {
  PH_BEGIN
  const int s = GID; if (s >= 512) return;
  const int row = hsh(s * 2 + id * 7919) % 6144, col = hsh(s * 2 + 1 + id * 7919) & 1023, half = s & 1;
  const int s0 = seq_start(row), n = seq_len(row), pos = row - s0, g = col >> 7, cp = col & 127;
  const bf16_t* H = (const bf16_t*)(ws_ + OFF_H);
  float acc = 0.f;
  for (int c = 0; c < 128; ++c) { const float b = (float)((c * cp) & 127) / 128.f; acc += b2f(H[(size_t)row * 1024 + g * 128 + c]) * (half ? sinf(6.283185307179586f * b) : cosf(6.283185307179586f * b)); }
  const bf16_t* YT = (const bf16_t*)(ws_ + OFF_YT);
  const bf16_t* base = row < 4096 ? YT + (size_t)(row >> 8) * (1024 * 512) : YT + (size_t)16 * 1024 * 512 + (size_t)((row - 4096) >> 10) * (1024 * 2048);
  rep(p, id, b2f(base[(size_t)col * (2 * n) + half * n + pos]), acc / sqrtf(128.f), 0.3f);
}
__device__ __forceinline__ void chk_tab(const Params& p) {
  PH_BEGIN
  const int s = GID; if (s >= 2048) return;
  const unsigned hh = hsh(s * 3 + 11);
  { const int np = hh & 255, c = (hh >> 8) & 127, half = np >> 7, cp = np & 127; const float b = (float)((c * cp) & 127) / 128.f * 6.283185307179586f;
    rep(p, 45, b2f(((const bf16_t*)(ws_ + OFF_DFTC))[np * 128 + c]), (half ? sinf(b) : cosf(b)) / sqrtf(128.f), 0.02f); }
  { const int np = hh & 255, c = (hh >> 8) & 511, half = c >> 8, pos = c & 255; const float b = (float)((pos * np) & 255) / 256.f * 6.283185307179586f;
    rep(p, 46, b2f(((const bf16_t*)(ws_ + OFF_DFTP256))[np * 512 + c]), (half ? -sinf(b) : cosf(b)) / 16.f, 0.01f); }
  { const int np = hh & 1023, c = (hh >> 10) & 2047, half = c >> 10, pos = c & 1023; const float b = (float)((pos * np) & 1023) / 1024.f * 6.283185307179586f;
    rep(p, 47, b2f(((const bf16_t*)(ws_ + OFF_DFTP1024))[np * 2048 + c]), (half ? -sinf(b) : cosf(b)) / 32.f, 0.005f); }
}
#ifndef CHKMASK
#define CHKMASK 0x7F
#endif
#define CHK(grp, call) do { if (CHKMASK & (1 << (grp))) { call; GSYNC(); } } while (0)
#else
#define CHK(grp, call) do { } while (0)
#endif

#define XB_TMO      128
#define XB_XCNT(j)  (256  + 64 * (j))
#define XB_XSUB(j)  (1280 + 64 * (j))
#define XB_XGEN(j)  (2304 + 64 * (j))
#define XB_TOP      3328
#define XB_TOPGEN   3392
#define XCD_BAR_WORDS 3456
#define XB_SPIN_CAP (1u << 20)
#define LAS __attribute__((address_space(3)))
__device__ __forceinline__ unsigned xb_ld(unsigned* p)              { return __hip_atomic_load(p, __ATOMIC_RELAXED, __HIP_MEMORY_SCOPE_AGENT); }
__device__ __forceinline__ unsigned xb_add(unsigned* p, unsigned v) { return __hip_atomic_fetch_add(p, v, __ATOMIC_RELAXED, __HIP_MEMORY_SCOPE_AGENT); }
__device__ __forceinline__ unsigned xb_xcc_id() { return (unsigned)__builtin_amdgcn_s_getreg((3 << 11) | 20) & 0xFu; }
#define XB_SPIN(cond, bar) do { unsigned _sp = 0; while (cond) { __builtin_amdgcn_s_sleep(1); \
    if ((++_sp & 255u) == 0u) { if (xb_ld(&(bar)[XB_TMO])) break; if (_sp > XB_SPIN_CAP) { atomicAdd(&(bar)[XB_TMO], 1u); break; } } } } while (0)
struct XcdBarrier { unsigned* bar; unsigned x; volatile LAS unsigned* st; };
__device__ __forceinline__ XcdBarrier xcd_barrier_post(unsigned* bar, volatile LAS unsigned* st) {
    XcdBarrier b; b.bar = bar; b.x = xb_xcc_id(); b.st = st;
    if (threadIdx.x == 0) (void)xb_add(&bar[XB_XCNT(b.x)], 1u);
    return b;
}
__device__ __forceinline__ void xcd_barrier_complete(unsigned* bar, unsigned x, unsigned& nloc, unsigned& nx) {
    const unsigned G = gridDim.x * gridDim.y * gridDim.z;
    unsigned sum, cnt, mine, sp = 0u;
    for (;;) {
        sum = 0u; cnt = 0u; mine = 0u;
#pragma unroll
        for (unsigned j = 0; j < 16; ++j) { const unsigned c = xb_ld(&bar[XB_XCNT(j)]); sum += c; cnt += (c > 0u) ? 1u : 0u; mine = (j == x) ? c : mine; }
        if (sum == G) break;
        __builtin_amdgcn_s_sleep(1);
        if ((++sp & 255u) == 0u) { if (xb_ld(&bar[XB_TMO])) break; if (sp > XB_SPIN_CAP) { atomicAdd(&bar[XB_TMO], 1u); break; } }
    }
    nloc = mine > 0u ? mine : 1u; nx = cnt > 0u ? cnt : 1u;
}
__device__ __forceinline__ void xcd_barrier(const XcdBarrier& b) {
    asm volatile("s_waitcnt vmcnt(0)" ::: "memory");
    __syncthreads();
    if (threadIdx.x == 0) {
        unsigned* bar = b.bar;
        __builtin_amdgcn_s_waitcnt(0);
        unsigned nloc = b.st[0], nx = b.st[1];
        if (nloc == 0u) { xcd_barrier_complete(bar, b.x, nloc, nx); b.st[0] = nloc; b.st[1] = nx; }
        const unsigned old = xb_add(&bar[XB_XSUB(b.x)], 1u);
        const unsigned gen = old / nloc;
        if (old + 1u == (gen + 1u) * nloc) {
            __builtin_amdgcn_fence(__ATOMIC_RELEASE, "agent");
            asm volatile("s_waitcnt vmcnt(0)" ::: "memory");
            const unsigned og = xb_add(&bar[XB_TOP], 1u);
            const unsigned tg = og / nx;
            if (og + 1u == (tg + 1u) * nx) xb_add(&bar[XB_TOPGEN], 1u);
            else XB_SPIN(xb_ld(&bar[XB_TOPGEN]) == tg, bar);
            __builtin_amdgcn_fence(__ATOMIC_ACQUIRE, "agent");
            xb_add(&bar[XB_XGEN(b.x)], 1u);
            asm volatile("s_waitcnt vmcnt(0)" ::: "memory");
        } else {
            XB_SPIN(xb_ld(&bar[XB_XGEN(b.x)]) == gen, bar);
            __builtin_amdgcn_fence(__ATOMIC_ACQUIRE, "agent");
            asm volatile("s_waitcnt vmcnt(0)" ::: "memory");
        }
    }
    __syncthreads();
}

#ifndef PH_LO
#define PH_LO 0
#endif
#ifndef PH_HI
#define PH_HI 1000
#endif
__global__ void __launch_bounds__(256, 2) mega(Params p) {
  __shared__ __attribute__((aligned(16))) char lds[65536];
  cg::grid_group grid = cg::this_grid();
  __shared__ uint4 xb_words;
  if (threadIdx.x == 0) xb_words = make_uint4(0u, 0u, 0u, 0u);
  __syncthreads();
  const XcdBarrier xb = xcd_barrier_post((unsigned*)(p.ws + OFF_BAR), (volatile LAS unsigned*)&xb_words);
  if (p.out == nullptr) grid.sync();
#define GSYNC() xcd_barrier(xb)
  char* ws = p.ws;
  bf16_t* H = (bf16_t*)(ws + OFF_H);
  float* O = (float*)(ws + OFF_O);
  bf16_t* HID = (bf16_t*)(ws + OFF_HID);
#define DUPMASK 0
#define REP(bit, call) do { call; GSYNC(); if (DUPMASK & (bit)) { call; GSYNC(); } } while (0)
#define REP2(bit, call, call2) do { call; GSYNC(); if (DUPMASK & (bit)) { call2; GSYNC(); } } while (0)
  REP(1, phase_prep(p, lds));
  CHK(0, chk_modv(p));
  CHK(0, chk_tab(p));
  REP(32, phase_row(p, true, false, 0, 0, 0, true, 0, 0, 0));
  CHK(0, chk_h(p, 1, 0, 0, 0));
  if (DUPMASK & 64) { for (int i = 0; i < 35; ++i) GSYNC(); }
#pragma unroll
  for (int l = 0; l < 4; ++l) {
    if (l == 0) {
      REP(4, phase_chan_dft(p, lds));
      CHK(1, chk_yt(p, 44));
      REP(4, phase_pos_dft(p, lds));
      CHK(1, chk_fft(p, 2));
      REP(4, phase_gemm_f32((const bf16_t*)(ws + OFF_F), 1024, (const bf16_t*)(ws + OFF_FFTWT), 1024, 1024, 48, 8, O, 1024, 1024, lds));
      CHK(2, chk_o(p, 3, (const bf16_t*)(ws + OFF_F), 1024, p.in[12]));
    } else if (l == 1) {
      REP(4, phase_gemm_bf16<0>(H, 1024, (const bf16_t*)(ws + OFF_CINT), 1024, 1024, 48, 24, (bf16_t*)(ws + OFF_BCU), 3072, lds));
      CHK(3, chk_bcu(p, 8));
      REP(32, phase_conv_elt(p));
      CHK(3, chk_a2(p, 9));
      REP(4, phase_gemm_f32((const bf16_t*)(ws + OFF_A2), 1024, (const bf16_t*)(ws + OFF_COUTT), 1024, 1024, 48, 8, O, 1024, 1024, lds));
      CHK(2, chk_o(p, 10, (const bf16_t*)(ws + OFF_A2), 1024, p.in[15]));
    } else if (l == 2) {
      REP(32, phase_rwkv_mix(p));
      CHK(4, chk_xm(p, 14));
      REP(4, phase_rwkv_gemm1(p, lds));
      CHK(4, chk_rw1(p, 15));
      REP(4, phase_rwkv_gemm2(p, lds));
      CHK(4, chk_rw2(p, 20));
      REP2(8, phase_scan(p, lds, 0), phase_scan(p, lds, 2));
      CHK(5, chk_scan(p, 24));
      REP(32, phase_postscan(p));
      CHK(6, chk_z(p, 26));
      REP(4, phase_gemm_f32(H, 1024, (const bf16_t*)(ws + OFF_RWOT), 1024, 1024, 48, 8, O, 1024, 1024, lds));
      CHK(2, chk_o(p, 27, H, 1024, p.in[20]));
    } else {
      REP(4, phase_gemm_f32(H, 1024, (const bf16_t*)(ws + OFF_MDQKVT), 1024, 1024, 48, 6, (float*)(ws + OFF_QC), 704, 704, lds));
      CHK(7, chk_qc(p, 32));
      REP(32, phase_mla_rows(p));
      CHK(7, chk_mlarows(p, 33));
      REP(4, phase_mla_up(p, lds));
      CHK(7, chk_up(p, 36));
      REP2(16, phase_attn(p, 1), phase_attn(p, 3));
      CHK(8, chk_attn(p, 39));
      REP(4, phase_gemm_f32(H, 1024, (const bf16_t*)(ws + OFF_MOT), 1024, 1024, 48, 8, O, 1024, 1024, lds));
      CHK(2, chk_o(p, 40, H, 1024, p.in[41]));
    }
    REP2(32, phase_row(p, false, DBG_MIXER_UPD, l, 2, 1, true, l, 2, 3), phase_row(p, false, false, l, 2, 1, true, l, 2, 3));
    CHK(0, chk_h(p, l == 0 ? 4 : (l == 1 ? 11 : (l == 2 ? 28 : 41)), l, 2, 3));
    REP(2, phase_gemm_bf16<1>(H, 1024, (const bf16_t*)(ws + OFF_W1T) + (size_t)l * 4096 * 1024, 1024, 1024, 48, 32, HID, 4096, lds));
    CHK(2, chk_hid(p, l == 0 ? 5 : (l == 1 ? 12 : (l == 2 ? 29 : 42)), l));
    REP(2, phase_gemm_f32(HID, 4096, (const bf16_t*)(ws + OFF_W2T) + (size_t)l * 4096 * 1024, 4096, 4096, 48, 8, O, 1024, 1024, lds));
    CHK(2, chk_o(p, l == 0 ? 6 : (l == 1 ? 13 : (l == 2 ? 30 : 43)), HID, 4096, p.in[11] + (size_t)l * 4096 * 1024));
    phase_row(p, false, true, l, 5, 3, l < 3 && l != 1, l + 1, 0, 0);
    if (l < 3) GSYNC();
    if (l == 0 || l == 2) CHK(0, chk_h(p, l == 0 ? 7 : 31, l + 1, 0, 0));
  }
#ifdef SELFCHECK
  GSYNC();
  for (size_t i = (size_t)blockIdx.x * 256 + threadIdx.x; i < 9699328; i += (size_t)gridDim.x * 256) { const float v = p.out[i]; if (!(fabsf(v) < 1e30f)) p.out[i] = 0.f; }
  GSYNC();
  if (blockIdx.x == 0 && threadIdx.x == 0) {
    const unsigned* errs = (const unsigned*)(ws + OFF_CTR) + 8;
    if (__uint_as_float(errs[45]) > SC_TOL) p.out[0] = 46000.f; else if (__uint_as_float(errs[46]) > SC_TOL) p.out[0] = 47000.f; else if (__uint_as_float(errs[47]) > SC_TOL) p.out[0] = 48000.f; else if (__uint_as_float(errs[44]) > SC_TOL) p.out[0] = 45000.f; else
    for (int id = 0; id < 48; ++id) if (!((SKIPMASK >> id) & 1ull) && __uint_as_float(errs[id]) > SC_TOL) { p.out[0] = 1000.f * (id + 1); break; }
  }
#endif
}

extern "C" void kernel_launch(void* const* d_in, const int* in_sizes, int n_in, void* d_out, int out_size, void* d_ws, size_t ws_size, hipStream_t stream) {
  static int grid_blocks = 0;
  if (!grid_blocks) {
    int dev = 0, cus = 0, per_cu = 0;
    (void)hipGetDevice(&dev);
    (void)hipDeviceGetAttribute(&cus, hipDeviceAttributeMultiprocessorCount, dev);
    (void)hipOccupancyMaxActiveBlocksPerMultiprocessor(&per_cu, mega, 256, 0);
    if (per_cu > 2) per_cu = 2;
    if (per_cu < 1) per_cu = 1;
    grid_blocks = cus * per_cu;
  }
  if (ws_size < WS_TOTAL) { fprintf(stderr, "workspace too small: %zu < %zu\n", ws_size, (size_t)WS_TOTAL); return; }
  Params p{};
  for (int i = 0; i < 42; ++i) p.in[i] = (const float*)d_in[i];
  p.out = (float*)d_out; p.ws = (char*)d_ws;
  (void)hipMemsetAsync((char*)d_ws + OFF_CTR, 0, 256 + 3456 * 4 + 256, stream);
  void* args[] = {&p};
  hipError_t e = hipLaunchCooperativeKernel((void*)mega, dim3(grid_blocks), dim3(256), args, 0, stream);
  if (e != hipSuccess) fprintf(stderr, "cooperative launch failed: %s (grid %d)\n", hipGetErrorString(e), grid_blocks);
}
```

```cpp
#include <hip/hip_runtime.h>
#include <hip/hip_cooperative_groups.h>
#include <cstdio>
#include <cstdint>
namespace cg = cooperative_groups;

typedef unsigned short bf16_t;
typedef short bf16x8 __attribute__((ext_vector_type(8)));
typedef float f32x4 __attribute__((ext_vector_type(4)));
typedef float f32x2 __attribute__((ext_vector_type(2)));

struct Params { const float* in[42]; float* out; char* ws; };

constexpr size_t SZ_ACT = 6144ull * 1024ull;
constexpr size_t OFF_MOD = 0;
constexpr size_t OFF_CTR = OFF_MOD + 4 * 3 * 6144 * 4;
constexpr size_t OFF_BAR = OFF_CTR + 256;
constexpr size_t OFF_W1T = OFF_BAR + 3456 * 4 + 256;
constexpr size_t OFF_W2T = OFF_W1T + 4ull * 4096 * 1024 * 2;
constexpr size_t OFF_FFTWT = OFF_W2T + 4ull * 4096 * 1024 * 2;
constexpr size_t OFF_CINT = OFF_FFTWT + 1024 * 1024 * 2;
constexpr size_t OFF_COUTT = OFF_CINT + 3072 * 1024 * 2;
constexpr size_t OFF_RW1T = OFF_COUTT + 1024 * 1024 * 2;
constexpr size_t OFF_RWW2T = OFF_RW1T + 3456 * 1024 * 2;
constexpr size_t OFF_RWA2T = OFF_RWW2T + 2 * 1024 * 64 * 2;
constexpr size_t OFF_RWG2T = OFF_RWA2T + 2 * 1024 * 64 * 2;
constexpr size_t OFF_RWOT = OFF_RWG2T + 1024 * 128 * 2;
constexpr size_t OFF_MDQKVT = OFF_RWOT + 1024 * 1024 * 2;
constexpr size_t OFF_MUQT = OFF_MDQKVT + 768 * 1024 * 2;
constexpr size_t OFF_MUKT = OFF_MUQT + 1536 * 384 * 2;
constexpr size_t OFF_MUVT = OFF_MUKT + 1024 * 256 * 2;
constexpr size_t OFF_MOT = OFF_MUVT + 1024 * 256 * 2;
constexpr size_t OFF_DFTC = OFF_MOT + 1024 * 1024 * 2;
constexpr size_t OFF_DFTP256 = OFF_DFTC + 256 * 128 * 2;
constexpr size_t OFF_DFTP1024 = OFF_DFTP256 + 256 * 512 * 2;
constexpr size_t OFF_CKVALL = OFF_DFTP1024 + 1024 * 2048 * 2;
constexpr size_t OFF_KRALL = OFF_CKVALL + 6656 * 256 * 2;
constexpr size_t OFF_H = OFF_KRALL + 6656 * 64 * 2;
constexpr size_t OFF_O = OFF_H + SZ_ACT * 2;
constexpr size_t OFF_HID = OFF_O + SZ_ACT * 4;
constexpr size_t OFF_RA = OFF_HID + SZ_ACT * 8;
constexpr size_t OFF_RB = OFF_RA + SZ_ACT * 12;
constexpr size_t OFF_LB = OFF_RB + SZ_ACT * 16;
constexpr size_t OFF_MODP = OFF_LB + 6144ull * 384 * 2;
constexpr size_t WS_TOTAL = OFF_MODP + 4ull * 73728 * 4;
constexpr size_t OFF_YT = OFF_RA;
constexpr size_t OFF_F = OFF_RA + SZ_ACT * 4;
constexpr size_t OFF_BCU = OFF_RA;
constexpr size_t OFF_A2 = OFF_RA + SZ_ACT * 6;
constexpr size_t OFF_XM = OFF_RA;
constexpr size_t OFF_KEFF = OFF_RA;
constexpr size_t OFF_NB = OFF_RA + SZ_ACT * 4;
constexpr size_t OFF_G = OFF_RA + SZ_ACT * 8;
constexpr size_t OFF_QC = OFF_RA;
constexpr size_t OFF_QN = OFF_QC + 6144ull * 704 * 4;
constexpr size_t OFF_Q = OFF_QN + 6144ull * 384 * 2;
constexpr size_t OFF_KN = OFF_Q + 6144ull * 1536 * 2;
constexpr size_t OFF_VT = OFF_KN + 6656ull * 1024 * 2;
constexpr size_t OFF_R = OFF_RB;
constexpr size_t OFF_V = OFF_RB + SZ_ACT * 4;
constexpr size_t OFF_K = OFF_RB + SZ_ACT * 8;
constexpr size_t OFF_KK = OFF_RB + SZ_ACT * 12;
constexpr size_t OFF_Y0 = OFF_K;
constexpr size_t OFF_Y1 = OFF_O;
constexpr size_t OFF_WDEC = OFF_HID;
constexpr size_t OUT_STATE = 6291456, OUT_CKV = 8388608, OUT_KROPE = 9437184;

__device__ __forceinline__ unsigned short f2bf(float f) { unsigned u = __float_as_uint(f); u += 0x7fffu + ((u >> 16) & 1u); return (unsigned short)(u >> 16); }
typedef __bf16 bf16x2_t __attribute__((ext_vector_type(2)));
__device__ __forceinline__ unsigned pack2(float a, float b) { const f32x2 v = {a, b}; const bf16x2_t r = __builtin_convertvector(v, bf16x2_t); return __builtin_bit_cast(unsigned, r); }
__device__ __forceinline__ float bflo(unsigned u) { return __uint_as_float(u << 16); }
__device__ __forceinline__ float bfhi(unsigned u) { return __uint_as_float(u & 0xffff0000u); }
__device__ __forceinline__ float wave_sum(float v) {
#pragma unroll
  for (int o = 32; o > 0; o >>= 1) v += __shfl_xor(v, o);
  return v;
}
__device__ __forceinline__ float quad_sum(float v) {
  v += __int_as_float(__builtin_amdgcn_update_dpp(0, __float_as_int(v), 0xB1, 0xF, 0xF, true));
  v += __int_as_float(__builtin_amdgcn_update_dpp(0, __float_as_int(v), 0x4E, 0xF, 0xF, true));
  return v;
}
__device__ __forceinline__ float sigmoidf_(float x) { return 1.f / (1.f + __expf(-x)); }
__device__ __forceinline__ f32x4 ldmod(const float* mp, int off) { return (*(const f32x4*)(mp + off) + *(const f32x4*)(mp + 73728 + off)) + (*(const f32x4*)(mp + 2 * 73728 + off) + *(const f32x4*)(mp + 3 * 73728 + off)); }
__device__ __forceinline__ size_t krf_idx(int key, int d) { return ((size_t)((key >> 4) * 2 + (d >> 5)) * 64 + ((d & 31) >> 3) * 16 + (key & 15)) * 8 + (d & 7); }
__device__ __forceinline__ size_t knf_idx(int key, int col) { const int h = col >> 7, dd = col & 127; return ((size_t)(((key >> 4) * 8 + h) * 4 + (dd >> 5)) * 64 + ((dd & 31) >> 3) * 16 + (key & 15)) * 8 + (dd & 7); }
__device__ __forceinline__ size_t vf_idx(int key, int n) { const int h = n >> 7, dvt = (n >> 4) & 7, kk = key & 31; return ((size_t)(((key >> 5) * 8 + h) * 8 + dvt) * 64 + ((kk & 15) >> 2) * 16 + (n & 15)) * 8 + (kk >> 4) * 4 + (kk & 3); }
__device__ __forceinline__ int row_group(int row) { return row < 4096 ? 0 : 1 + ((row - 4096) >> 10); }

template <bool SWAP, int MI, bool PIPE2 = true, class Epi>
__device__ __forceinline__ void gemm_tile_mi(const bf16_t* __restrict__ A, int lda, const bf16_t* __restrict__ Bt, int ldb, int K, char* lds, Epi&& epi) {
  int tid = threadIdx.x; asm volatile("" : "+v"(tid));
  const int lane = tid & 63, wid = tid >> 6, wr = wid >> 1, wc = wid & 1;
  const int lrow = tid >> 3, lch = tid & 7;
  const bf16_t* ap = A + (size_t)lrow * lda + lch * 8;
  const bf16_t* bp = Bt + (size_t)lrow * ldb + lch * 8;
  const int soff = lrow * 128 + ((lch ^ ((lrow >> 1) & 7)) << 4);
  const int quad = lane >> 4, l15 = lane & 15, sw = l15 >> 1;
  const int aoff = (wr * (MI * 16) + l15) * 128, boff = 16384 + (wc * 64 + l15) * 128;
  f32x4 acc[MI][4];
#pragma unroll
  for (int i = 0; i < MI; ++i)
#pragma unroll
    for (int j = 0; j < 4; ++j) acc[i][j] = (f32x4){0.f, 0.f, 0.f, 0.f};
  uint4 xa0, xa1, xa2, xa3, xb0, xb1, xb2, xb3;
  uint4 ya0, ya1, ya2, ya3, yb0, yb1, yb2, yb3;
#define GT_LOAD(P, kt_) do { const bf16_t* _a = ap + (size_t)(kt_) * 64; const bf16_t* _b = bp + (size_t)(kt_) * 64; \
    P##a0 = *(const uint4*)(_a); P##a1 = *(const uint4*)(_a + (size_t)32 * lda); P##a2 = *(const uint4*)(_a + (size_t)64 * lda); if (MI == 4) P##a3 = *(const uint4*)(_a + (size_t)96 * lda); \
    P##b0 = *(const uint4*)(_b); P##b1 = *(const uint4*)(_b + (size_t)32 * ldb); P##b2 = *(const uint4*)(_b + (size_t)64 * ldb); P##b3 = *(const uint4*)(_b + (size_t)96 * ldb); } while (0)
#define GT_STORE(P, base) do { char* _s = (base) + soff; *(uint4*)(_s) = P##a0; *(uint4*)(_s + 4096) = P##a1; *(uint4*)(_s + 8192) = P##a2; if (MI == 4) *(uint4*)(_s + 12288) = P##a3; \
    *(uint4*)(_s + 16384) = P##b0; *(uint4*)(_s + 20480) = P##b1; *(uint4*)(_s + 24576) = P##b2; *(uint4*)(_s + 28672) = P##b3; } while (0)
#define GT_COMPUTE(cur) do { __builtin_amdgcn_s_setprio(1); _Pragma("unroll") for (int ks = 0; ks < 2; ++ks) { \
      const int ch = ((ks * 4 + quad) ^ sw) << 4; \
      bf16x8 af[MI], bfr[4]; \
      _Pragma("unroll") for (int mi = 0; mi < MI; ++mi) af[mi] = *(const bf16x8*)((cur) + aoff + mi * 2048 + ch); \
      _Pragma("unroll") for (int ni = 0; ni < 4; ++ni) bfr[ni] = *(const bf16x8*)((cur) + boff + ni * 2048 + ch); \
      _Pragma("unroll") for (int mi = 0; mi < MI; ++mi) \
        _Pragma("unroll") for (int ni = 0; ni < 4; ++ni) \
          acc[mi][ni] = SWAP ? __builtin_amdgcn_mfma_f32_16x16x32_bf16(bfr[ni], af[mi], acc[mi][ni], 0, 0, 0) \
                             : __builtin_amdgcn_mfma_f32_16x16x32_bf16(af[mi], bfr[ni], acc[mi][ni], 0, 0, 0); } __builtin_amdgcn_s_setprio(0); } while (0)
  const int nk = K >> 6;
  GT_LOAD(x, 0);
  if (!PIPE2) {
    GT_STORE(x, lds);
    __syncthreads();
    for (int kt = 0; kt < nk; ++kt) {
      const bool more = kt + 1 < nk;
      if (more) GT_LOAD(x, kt + 1);
      GT_COMPUTE(lds + (kt & 1) * 32768);
      if (more) GT_STORE(x, lds + ((kt + 1) & 1) * 32768);
      __syncthreads();
    }
  } else if (nk == 1) {
    GT_STORE(x, lds);
    __syncthreads();
    GT_COMPUTE(lds);
    __syncthreads();
  } else {
    GT_LOAD(y, 1);
    GT_STORE(x, lds);
    if (nk > 2) GT_LOAD(x, 2);
    __syncthreads();
    int kt = 0;
#pragma nounroll
    for (; kt + 4 < nk; kt += 2) {
      GT_COMPUTE(lds);
      GT_STORE(y, lds + 32768);
      GT_LOAD(y, kt + 3);
      __syncthreads();
      GT_COMPUTE(lds + 32768);
      GT_STORE(x, lds);
      GT_LOAD(x, kt + 4);
      __syncthreads();
    }
    if (nk >= 4) {
      GT_COMPUTE(lds);
      GT_STORE(y, lds + 32768);
      GT_LOAD(y, kt + 3);
      __syncthreads();
      GT_COMPUTE(lds + 32768);
      GT_STORE(x, lds);
      __syncthreads();
      kt += 2;
    }
    GT_COMPUTE(lds);
    GT_STORE(y, lds + 32768);
    __syncthreads();
    GT_COMPUTE(lds + 32768);
    __syncthreads();
  }
  epi(acc, wr * (MI * 16), wc * 64);
}
template <bool SWAP, class Epi>
__device__ __forceinline__ void gemm_tile(const bf16_t* __restrict__ A, int lda, const bf16_t* __restrict__ Bt, int ldb, int K, char* lds, Epi&& epi) {
  gemm_tile_mi<SWAP, 4>(A, lda, Bt, ldb, K, lds, epi);
}
template <bool SWAP, class Epi>
__device__ __forceinline__ void gemm_tile_1set(const bf16_t* __restrict__ A, int lda, const bf16_t* __restrict__ Bt, int ldb, int K, char* lds, Epi&& epi) {
  gemm_tile_mi<SWAP, 4, false>(A, lda, Bt, ldb, K, lds, epi);
}

#define PH_BEGIN_NOWS int tid_ = threadIdx.x; int bid_ = blockIdx.x; asm volatile("" : "+v"(tid_), "+s"(bid_));
#define PH_BEGIN PH_BEGIN_NOWS size_t wz_ = 0; asm volatile("" : "+s"(wz_)); char* ws_ = p.ws + wz_;
__device__ __forceinline__ void conv_T(const float* __restrict__ src, int K, int N, bf16_t* __restrict__ dst, int ldd, int& base, char* lds) {
  PH_BEGIN_NOWS
  const int tn = N >> 6, nt = (K >> 6) * tn, G = gridDim.x, tid = tid_;
  float (*tile)[65] = (float (*)[65])lds;
  int first = ((int)bid_ - base) % G; if (first < 0) first += G;
  for (int t = first; t < nt; t += G) {
    const int kt = t / tn, nti = t - kt * tn;
    const float* s = src + (size_t)(kt * 64) * N + nti * 64;
    const int c = tid & 63, r0 = tid >> 6;
#pragma unroll
    for (int i = 0; i < 16; ++i) tile[r0 + 4 * i][c] = s[(size_t)(r0 + 4 * i) * N + c];
    __syncthreads();
    const int n = tid >> 2, kc = (tid & 3) * 16;
    unsigned w[8];
#pragma unroll
    for (int j = 0; j < 8; ++j) w[j] = pack2(tile[kc + 2 * j][n], tile[kc + 2 * j + 1][n]);
    bf16_t* d = dst + (size_t)(nti * 64 + n) * ldd + kt * 64 + kc;
    *(uint4*)d = make_uint4(w[0], w[1], w[2], w[3]);
    *(uint4*)(d + 8) = make_uint4(w[4], w[5], w[6], w[7]);
    __syncthreads();
  }
  base = (base + nt) % G;
}

__device__ __forceinline__ void conv_tile128(const float* __restrict__ src, int K, int N, bf16_t* __restrict__ dst, int ldd, int t, char* lds, int tid) {
  const int tn = N >> 7;
  bf16_t* tile = (bf16_t*)lds;
  const int kt = t / tn, nti = t - kt * tn;
  const float* s = src + (size_t)(kt * 128) * N + nti * 128;
  const int c4 = (tid & 31) * 4, r0 = tid >> 5;
  f32x4 v[16];
#pragma unroll
  for (int i = 0; i < 16; ++i) v[i] = __builtin_nontemporal_load((const f32x4*)(s + (size_t)(r0 + 8 * i) * N + c4));
#pragma unroll
  for (int i = 0; i < 16; ++i) *(uint2*)(tile + (r0 + 8 * i) * 132 + c4) = make_uint2(pack2(v[i][0], v[i][1]), pack2(v[i][2], v[i][3]));
  __syncthreads();
  const int n = tid >> 1, k0 = (tid & 1) * 64;
  bf16_t* d = dst + (size_t)(nti * 128 + n) * ldd + kt * 128 + k0;
#pragma unroll
  for (int j = 0; j < 8; ++j) {
    unsigned w[4];
#pragma unroll
    for (int q = 0; q < 4; ++q) w[q] = (unsigned)tile[(k0 + j * 8 + 2 * q) * 132 + n] | ((unsigned)tile[(k0 + j * 8 + 2 * q + 1) * 132 + n] << 16);
    *(uint4*)(d + j * 8) = make_uint4(w[0], w[1], w[2], w[3]);
  }
  __syncthreads();
}
__device__ __forceinline__ void conv_T128(const float* __restrict__ src, int K, int N, bf16_t* __restrict__ dst, int ldd, int& base, char* lds) {
  PH_BEGIN_NOWS
  const int nt = (K >> 7) * (N >> 7), G = gridDim.x;
  int first = ((int)bid_ - base) % G; if (first < 0) first += G;
  for (int t = first; t < nt; t += G) conv_tile128(src, K, N, dst, ldd, t, lds, tid_);
  base = (base + nt) % G;
}
__device__ __forceinline__ void conv_deferred(const Params& p, char* ws, int d, char* lds, int tid) {
  const float* src; bf16_t* dst; int K, N, ldd, t;
  if (d < 1024) {
    const int m = d >> 8, l = 2 + (m >> 1); t = d & 255;
    if ((m & 1) == 0) { src = p.in[10] + (size_t)l * 1024 * 4096; K = 1024; N = 4096; dst = (bf16_t*)(ws + OFF_W1T) + (size_t)l * 4096 * 1024; ldd = 1024; }
    else { src = p.in[11] + (size_t)l * 4096 * 1024; K = 4096; N = 1024; dst = (bf16_t*)(ws + OFF_W2T) + (size_t)l * 4096 * 1024; ldd = 4096; }
  } else {
    d -= 1024;
    if (d < 64) { src = p.in[20]; K = 1024; N = 1024; dst = (bf16_t*)(ws + OFF_RWOT); ldd = 1024; t = d; }
    else if (d < 88) { src = p.in[34]; K = 1024; N = 384; dst = (bf16_t*)(ws + OFF_MDQKVT); ldd = 1024; t = d - 64; }
    else if (d < 124) { src = p.in[36]; K = 384; N = 1536; dst = (bf16_t*)(ws + OFF_MUQT); ldd = 384; t = d - 88; }
    else if (d < 140) { src = p.in[39]; K = 256; N = 1024; dst = (bf16_t*)(ws + OFF_MUKT); ldd = 256; t = d - 124; }
    else if (d < 156) { src = p.in[40]; K = 256; N = 1024; dst = (bf16_t*)(ws + OFF_MUVT); ldd = 256; t = d - 140; }
    else { src = p.in[41]; K = 1024; N = 1024; dst = (bf16_t*)(ws + OFF_MOT); ldd = 1024; t = d - 156; }
  }
  conv_tile128(src, K, N, dst, ldd, t, lds, tid);
}
__device__ __forceinline__ void conv_deferred_l1(const Params& p, char* ws, int d, char* lds, int tid) {
  const float* src; bf16_t* dst; int K, N, ldd, t;
  bf16_t* r1 = (bf16_t*)(ws + OFF_RW1T);
  if (d < 256) { src = p.in[10] + (size_t)1024 * 4096; K = 1024; N = 4096; dst = (bf16_t*)(ws + OFF_W1T) + (size_t)4096 * 1024; ldd = 1024; t = d; }
  else if (d < 512) { src = p.in[11] + (size_t)4096 * 1024; K = 4096; N = 1024; dst = (bf16_t*)(ws + OFF_W2T) + (size_t)4096 * 1024; ldd = 4096; t = d - 256; }
  else if (d < 704) { src = p.in[13]; K = 1024; N = 3072; dst = (bf16_t*)(ws + OFF_CINT); ldd = 1024; t = d - 512; }
  else if (d < 768) { src = p.in[15]; K = 1024; N = 1024; dst = (bf16_t*)(ws + OFF_COUTT); ldd = 1024; t = d - 704; }
  else if (d < 832) { src = p.in[17]; K = 1024; N = 1024; dst = r1; ldd = 1024; t = d - 768; }
  else if (d < 896) { src = p.in[18]; K = 1024; N = 1024; dst = r1 + 1024 * 1024; ldd = 1024; t = d - 832; }
  else if (d < 960) { src = p.in[19]; K = 1024; N = 1024; dst = r1 + 2048 * 1024; ldd = 1024; t = d - 896; }
  else if (d < 968) { src = p.in[27]; K = 1024; N = 128; dst = r1 + (3072 + 256) * 1024; ldd = 1024; t = d - 960; }
  else { src = p.in[28]; K = 128; N = 1024; dst = (bf16_t*)(ws + OFF_RWG2T); ldd = 128; t = d - 968; }
  conv_tile128(src, K, N, dst, ldd, t, lds, tid);
}
constexpr int N_DEFERRED_L1 = 976;
constexpr int N_DEFERRED = 1024 + 64 + 24 + 36 + 16 + 16 + 64;

__device__ __forceinline__ void phase_prep_a(const Params& p, char* lds) {
  PH_BEGIN
  char* ws = ws_;
  const int tid = tid_, gt = bid_ * 256 + tid, nthr = gridDim.x * 256;
  if (bid_ == 0 && tid < 64) ((unsigned*)(ws + OFF_CTR))[tid] = 0u;
  {
    float* sl = (float*)lds;
    f32x4* red = (f32x4*)(lds + 12288);
    bool have = false;
    for (int item = bid_; item < 384; item += gridDim.x) {
      if (!have) {
        for (int i = tid; i < 3072; i += 256) {
          const int g = i >> 10, k = i & 1023;
          const float cv = g == 0 ? p.in[6][k] : p.in[5][(g - 1) * 1024 + k];
          sl[i] = cv / (1.f + __expf(-cv));
        }
        have = true;
        __syncthreads();
      }
      const int l = item / 96, r = item % 96, chunk = r >> 2, kq = r & 3, lane = tid & 63, w = tid >> 6;
      const int n0 = chunk * 256 + lane * 4, k0 = kq * 256 + w * 64;
      const float* mw = p.in[7] + (size_t)l * 1024 * 6144 + (size_t)k0 * 6144 + n0;
      f32x4 a0 = {0.f, 0.f, 0.f, 0.f}, a1 = a0, a2 = a0;
#pragma unroll 16
      for (int k = 0; k < 64; ++k) {
        const f32x4 wv = __builtin_nontemporal_load((const f32x4*)(mw + (size_t)k * 6144));
        a0 += sl[k0 + k] * wv; a1 += sl[1024 + k0 + k] * wv; a2 += sl[2048 + k0 + k] * wv;
      }
      red[(w * 3 + 0) * 64 + lane] = a0; red[(w * 3 + 1) * 64 + lane] = a1; red[(w * 3 + 2) * 64 + lane] = a2;
      __syncthreads();
      if (tid < 192) {
        const int g = tid >> 6;
        f32x4 sm = (red[(0 * 3 + g) * 64 + lane] + red[(1 * 3 + g) * 64 + lane]) + (red[(2 * 3 + g) * 64 + lane] + red[(3 * 3 + g) * 64 + lane]);
        if (kq == 0) sm += *(const f32x4*)(p.in[8] + l * 6144 + n0);
        *(f32x4*)((float*)(ws + OFF_MODP) + (size_t)kq * 73728 + (l * 3 + g) * 6144 + n0) = sm;
      }
      __syncthreads();
    }
    __syncthreads();
  }
  {
    bf16_t* dc = (bf16_t*)(ws + OFF_DFTC);
    for (int i = gt; i < 256 * 128; i += nthr) {
      const int np = i >> 7, c = i & 127, half = np >> 7, cp = np & 127, m = (c * cp) & 127;
      const float x = (float)m * (1.f / 128.f);
      const float v = half ? __builtin_amdgcn_sinf(x) : __builtin_amdgcn_cosf(x);
      dc[i] = f2bf(v * 0.08838834764831845f);
    }
    bf16_t* d256 = (bf16_t*)(ws + OFF_DFTP256);
    for (int i = gt; i < 256 * 512; i += nthr) {
      const int np = i >> 9, c = i & 511, half = c >> 8, pos = c & 255, m = (pos * np) & 255;
      const float x = (float)m * (1.f / 256.f);
      const float v = half ? -__builtin_amdgcn_sinf(x) : __builtin_amdgcn_cosf(x);
      d256[i] = f2bf(v * 0.0625f);
    }
    bf16_t* d1024 = (bf16_t*)(ws + OFF_DFTP1024);
    for (int i = gt; i < 1024 * 2048; i += nthr) {
      const int np = i >> 11, c = i & 2047, half = c >> 10, pos = c & 1023, m = (pos * np) & 1023;
      const float x = (float)m * (1.f / 1024.f);
      const float v = half ? -__builtin_amdgcn_sinf(x) : __builtin_amdgcn_cosf(x);
      d1024[i] = f2bf(v * 0.03125f);
    }
  }
  {
    bf16_t* ck = (bf16_t*)(ws + OFF_CKVALL);
    for (int i = gt; i < 2 * 256 * 256; i += nthr) {
      const int b = i >> 16, r = i & 65535;
      ck[(size_t)(4096 + b * 1280) * 256 + r] = f2bf(p.in[3][i]);
    }
    bf16_t* kr = (bf16_t*)(ws + OFF_KRALL);
    for (int i = gt; i < 2 * 256 * 64; i += nthr) {
      const int b = i >> 14, r = i & 16383;
      kr[krf_idx(4096 + b * 1280 + (r >> 6), r & 63)] = f2bf(p.in[4][i]);
    }
    bf16_t* pad = (bf16_t*)(ws + OFF_MDQKVT) + 704 * 1024;
    for (int i = gt; i < 64 * 1024; i += nthr) pad[i] = 0;
  }
}
__device__ __forceinline__ void phase_prep_b(const Params& p, char* lds) {
  PH_BEGIN
  char* ws = ws_;
  int base = 0;
  for (int l = 0; l < 1; ++l) {
    conv_T128(p.in[10] + (size_t)l * 1024 * 4096, 1024, 4096, (bf16_t*)(ws + OFF_W1T) + (size_t)l * 4096 * 1024, 1024, base, lds);
    conv_T128(p.in[11] + (size_t)l * 4096 * 1024, 4096, 1024, (bf16_t*)(ws + OFF_W2T) + (size_t)l * 4096 * 1024, 4096, base, lds);
  }
  conv_T128(p.in[12], 1024, 1024, (bf16_t*)(ws + OFF_FFTWT), 1024, base, lds);
  {
    bf16_t* r1 = (bf16_t*)(ws + OFF_RW1T);
    conv_T(p.in[22], 1024, 64, r1 + 3072 * 1024, 1024, base, lds);
    conv_T(p.in[22] + 1024 * 64, 1024, 64, r1 + (3072 + 64) * 1024, 1024, base, lds);
    conv_T(p.in[25], 1024, 64, r1 + (3072 + 128) * 1024, 1024, base, lds);
    conv_T(p.in[25] + 1024 * 64, 1024, 64, r1 + (3072 + 192) * 1024, 1024, base, lds);
    conv_T(p.in[23], 64, 1024, (bf16_t*)(ws + OFF_RWW2T), 64, base, lds);
    conv_T(p.in[23] + 64 * 1024, 64, 1024, (bf16_t*)(ws + OFF_RWW2T) + 1024 * 64, 64, base, lds);
    conv_T(p.in[26], 64, 1024, (bf16_t*)(ws + OFF_RWA2T), 64, base, lds);
    conv_T(p.in[26] + 64 * 1024, 64, 1024, (bf16_t*)(ws + OFF_RWA2T) + 1024 * 64, 64, base, lds);
  }
  conv_T(p.in[37], 1024, 320, (bf16_t*)(ws + OFF_MDQKVT) + 384 * 1024, 1024, base, lds);
}

__device__ __forceinline__ void phase_row(const Params& p, bool from_input, bool upd, int ul, int ugate, int ugn, bool wh, int hl, int hgn, int hshift, bool part = false) {
  PH_BEGIN
  const int lane = tid_ & 63, gw = bid_ * 4 + (tid_ >> 6), nw = gridDim.x * 4;
  float* X = p.out;
  const bf16_t* O = (const bf16_t*)(ws_ + OFF_O);
  bf16_t* H = (bf16_t*)(ws_ + OFF_H);
  const float* modv = (const float*)(ws_ + (part ? OFF_MODP : OFF_MOD));
  const float* ng = p.in[9];
  if (part) {
    const float* mp = (const float*)(ws_ + OFF_MODP); float* mf = (float*)(ws_ + OFF_MOD);
    for (int i = (bid_ * 256 + tid_) * 4; i < 73728; i += gridDim.x * 1024) *(f32x4*)(mf + i) = ldmod(mp, i);
  }
  auto xptr = [&](int row) { return from_input ? (row < 4096 ? p.in[0] + (size_t)row * 1024 : p.in[1] + (size_t)(row - 4096) * 1024) : (const float*)X + (size_t)row * 1024; };
  f32x4 xn[4], on[4];
  if (gw < 6144) {
    const float* xr = xptr(gw);
#pragma unroll
    for (int i = 0; i < 4; ++i) { xn[i] = *(const f32x4*)(xr + lane * 4 + 256 * i); if (upd) { const uint2 u_ = *(const uint2*)(O + (size_t)gw * 1024 + lane * 4 + 256 * i); on[i] = (f32x4){bflo(u_.x), bfhi(u_.x), bflo(u_.y), bfhi(u_.y)}; } }
  }
  for (int row = gw; row < 6144; row += nw) {
    const int g = row_group(row);
    f32x4 x[4], ov[4], gvu[4], gt[4], gvh[4], shv[4], scv[4];
#pragma unroll
    for (int i = 0; i < 4; ++i) { x[i] = xn[i]; if (upd) ov[i] = on[i]; }
    const float* gnu = ng + (ul * 4 + ugn) * 1024;
    const float* gate = modv + ((ul * 3 + g) * 6 + ugate) * 1024;
    const float* gnh = ng + (hl * 4 + hgn) * 1024;
    const float* sh = modv + ((hl * 3 + g) * 6 + hshift) * 1024;
#pragma unroll
    for (int i = 0; i < 4; ++i) {
      const int c = lane * 4 + 256 * i;
      if (upd) { gvu[i] = *(const f32x4*)(gnu + c); gt[i] = *(const f32x4*)(gate + c); }
      if (wh) { gvh[i] = *(const f32x4*)(gnh + c); shv[i] = part ? ldmod(sh, c) : *(const f32x4*)(sh + c); scv[i] = part ? ldmod(sh, 1024 + c) : *(const f32x4*)(sh + 1024 + c); }
    }
    if (row + nw < 6144) {
      const float* xr = xptr(row + nw);
#pragma unroll
      for (int i = 0; i < 4; ++i) { xn[i] = *(const f32x4*)(xr + lane * 4 + 256 * i); if (upd) { const uint2 u_ = *(const uint2*)(O + (size_t)(row + nw) * 1024 + lane * 4 + 256 * i); on[i] = (f32x4){bflo(u_.x), bfhi(u_.x), bflo(u_.y), bfhi(u_.y)}; } }
    }
    if (upd) {
      float ss = 0.f;
#pragma unroll
      for (int i = 0; i < 4; ++i) ss += ov[i][0] * ov[i][0] + ov[i][1] * ov[i][1] + ov[i][2] * ov[i][2] + ov[i][3] * ov[i][3];
      ss = wave_sum(ss);
      const float rs = rsqrtf(ss * (1.f / 1024.f) + 1e-6f);
#pragma unroll
      for (int i = 0; i < 4; ++i) x[i] += gt[i] * (ov[i] * rs * gvu[i]);
    }
    if (upd) {
#pragma unroll
      for (int i = 0; i < 4; ++i) *(f32x4*)(X + (size_t)row * 1024 + lane * 4 + 256 * i) = x[i];
    }
    if (wh) {
      float ss = 0.f;
#pragma unroll
      for (int i = 0; i < 4; ++i) ss += x[i][0] * x[i][0] + x[i][1] * x[i][1] + x[i][2] * x[i][2] + x[i][3] * x[i][3];
      ss = wave_sum(ss);
      const float rs = rsqrtf(ss * (1.f / 1024.f) + 1e-6f);
#pragma unroll
      for (int i = 0; i < 4; ++i) {
        const int c = lane * 4 + 256 * i;
        const f32x4 h = x[i] * rs * gvh[i] * (1.f + scv[i]) + shv[i];
        *(uint2*)(H + (size_t)row * 1024 + c) = make_uint2(pack2(h[0], h[1]), pack2(h[2], h[3]));
      }
    }
  }
}

__device__ __forceinline__ void phase_rwkv_mix(const Params& p) {
  PH_BEGIN
  const int lane = tid_ & 63, gw = bid_ * 4 + (tid_ >> 6), nw = gridDim.x * 4;
  const float* X = p.out;
  bf16_t* XM = (bf16_t*)(ws_ + OFF_XM);
  const float* modv = (const float*)(ws_ + OFF_MOD);
  const float* gn = p.in[9] + (2 * 4 + 0) * 1024;
  const float* mu = p.in[16];
  for (int row = gw; row < 6144; row += nw) {
    const int g = row_group(row);
    const int pos = row < 4096 ? (row & 255) : ((row - 4096) & 1023), n = row < 4096 ? 256 : 1024;
    const bool hasp = pos > 0, hasn = pos < n - 1;
    const float* sh = modv + ((2 * 3 + g) * 6 + 0) * 1024;
    f32x4 xc[4], xp[4], xn[4];
    float sc_ = 0.f, sp_ = 0.f, sn_ = 0.f;
#pragma unroll
    for (int i = 0; i < 4; ++i) {
      const int c = lane * 4 + 256 * i;
      xc[i] = *(const f32x4*)(X + (size_t)row * 1024 + c);
      xp[i] = hasp ? *(const f32x4*)(X + (size_t)(row - 1) * 1024 + c) : (f32x4){0.f, 0.f, 0.f, 0.f};
      xn[i] = hasn ? *(const f32x4*)(X + (size_t)(row + 1) * 1024 + c) : (f32x4){0.f, 0.f, 0.f, 0.f};
#pragma unroll
      for (int j = 0; j < 4; ++j) { sc_ += xc[i][j] * xc[i][j]; sp_ += xp[i][j] * xp[i][j]; sn_ += xn[i][j] * xn[i][j]; }
    }
    sc_ = wave_sum(sc_); sp_ = wave_sum(sp_); sn_ = wave_sum(sn_);
    const float rc = rsqrtf(sc_ * (1.f / 1024.f) + 1e-6f), rp = rsqrtf(sp_ * (1.f / 1024.f) + 1e-6f), rn = rsqrtf(sn_ * (1.f / 1024.f) + 1e-6f);
#pragma unroll
    for (int i = 0; i < 4; ++i) {
      const int c = lane * 4 + 256 * i;
      const f32x4 gv = *(const f32x4*)(gn + c), shv = *(const f32x4*)(sh + c), scv = *(const f32x4*)(sh + 1024 + c);
      const f32x4 gm = gv * (1.f + scv);
      const f32x4 hc = xc[i] * rc * gm + shv;
      f32x4 hp = xp[i] * rp * gm + shv, hn = xn[i] * rn * gm + shv;
      if (!hasp) hp = (f32x4){0.f, 0.f, 0.f, 0.f};
      if (!hasn) hn = (f32x4){0.f, 0.f, 0.f, 0.f};
      const f32x4 dx = 0.5f * (hp + hn) - hc;
#pragma unroll
      for (int m = 0; m < 6; ++m) {
        const f32x4 muv = *(const f32x4*)(mu + m * 1024 + c);
        const f32x4 o = hc + dx * muv;
        *(uint2*)(XM + (size_t)m * SZ_ACT + (size_t)row * 1024 + c) = make_uint2(pack2(o[0], o[1]), pack2(o[2], o[3]));
      }
    }
  }
}

__device__ __forceinline__ void phase_conv_elt(const Params& p) {
  PH_BEGIN
  const int lane = tid_ & 63, gw = bid_ * 4 + (tid_ >> 6), nw = gridDim.x * 4;
  const bf16_t* BCU = (const bf16_t*)(ws_ + OFF_BCU);
  bf16_t* A2 = (bf16_t*)(ws_ + OFF_A2);
  const float* cw = p.in[14];
  for (int row = gw; row < 6144; row += nw) {
    const int pos = row < 4096 ? (row & 255) : ((row - 4096) & 1023), n = row < 4096 ? 256 : 1024;
    const bool hasp = pos > 0, hasn = pos < n - 1;
#pragma unroll
    for (int i = 0; i < 2; ++i) {
      const int c = lane * 8 + 512 * i;
      const bf16_t* rb = BCU + (size_t)row * 3072 + c;
      const uint4 bg = *(const uint4*)rb, cg = *(const uint4*)(rb + 1024), u = *(const uint4*)(rb + 2048);
      uint4 cgp = make_uint4(0, 0, 0, 0), up = cgp, cgn = cgp, un = cgp;
      if (hasp) { cgp = *(const uint4*)(rb - 3072 + 1024); up = *(const uint4*)(rb - 3072 + 2048); }
      if (hasn) { cgn = *(const uint4*)(rb + 3072 + 1024); un = *(const uint4*)(rb + 3072 + 2048); }
      const unsigned bgw[4] = {bg.x, bg.y, bg.z, bg.w}, cgw[4] = {cg.x, cg.y, cg.z, cg.w}, uw[4] = {u.x, u.y, u.z, u.w};
      const unsigned cgpw[4] = {cgp.x, cgp.y, cgp.z, cgp.w}, upw[4] = {up.x, up.y, up.z, up.w}, cgnw[4] = {cgn.x, cgn.y, cgn.z, cgn.w}, unw[4] = {un.x, un.y, un.z, un.w};
      unsigned ow[4];
#pragma unroll
      for (int j = 0; j < 4; ++j) {
        const int cc = c + 2 * j;
        const float w00 = cw[cc], w01 = cw[cc + 1], w10 = cw[1024 + cc], w11 = cw[1024 + cc + 1], w20 = cw[2048 + cc], w21 = cw[2048 + cc + 1];
        const float z0 = bflo(cgw[j]) * bflo(uw[j]), z1 = bfhi(cgw[j]) * bfhi(uw[j]);
        const float zp0 = bflo(cgpw[j]) * bflo(upw[j]), zp1 = bfhi(cgpw[j]) * bfhi(upw[j]);
        const float zn0 = bflo(cgnw[j]) * bflo(unw[j]), zn1 = bfhi(cgnw[j]) * bfhi(unw[j]);
        const float o0 = bflo(bgw[j]) * (zp0 * w00 + z0 * w10 + zn0 * w20);
        const float o1 = bfhi(bgw[j]) * (zp1 * w01 + z1 * w11 + zn1 * w21);
        ow[j] = pack2(o0, o1);
      }
      *(uint4*)(A2 + (size_t)row * 1024 + c) = make_uint4(ow[0], ow[1], ow[2], ow[3]);
    }
  }
}

__device__ __forceinline__ void phase_postscan(const Params& p) {
  PH_BEGIN
  const int lane = tid_ & 63, gw = bid_ * 4 + (tid_ >> 6), nw = gridDim.x * 4;
  const float* Y0 = (const float*)(ws_ + OFF_Y0);
  const float* Y1 = (const float*)(ws_ + OFF_Y1);
  const float* R = (const float*)(ws_ + OFF_R);
  const float* V = (const float*)(ws_ + OFF_V);
  const float* G = (const float*)(ws_ + OFF_G);
  const bf16_t* KE = (const bf16_t*)(ws_ + OFF_KEFF);
  bf16_t* Z = (bf16_t*)(ws_ + OFF_H);
  const float* rk = p.in[31]; const float* lng = p.in[32]; const float* lnb = p.in[33];
  for (int row = gw; row < 6144; row += nw) {
    const size_t b = (size_t)row * 1024 + lane * 16;
    float y[16], bon = 0.f, s = 0.f;
    f32x4 vv4[4], gg4[4], lg4[4], lb4[4];
#pragma unroll
    for (int i = 0; i < 4; ++i) {
      vv4[i] = *(const f32x4*)(V + b + 4 * i); gg4[i] = *(const f32x4*)(G + b + 4 * i);
      lg4[i] = *(const f32x4*)(lng + lane * 16 + 4 * i); lb4[i] = *(const f32x4*)(lnb + lane * 16 + 4 * i);
    }
#pragma unroll
    for (int i = 0; i < 4; ++i) {
      const f32x4 a = *(const f32x4*)(Y0 + b + 4 * i), c = *(const f32x4*)(Y1 + b + 4 * i), r = *(const f32x4*)(R + b + 4 * i);
      const uint2 k0 = *(const uint2*)(KE + b + 4 * i), k1 = *(const uint2*)(KE + SZ_ACT + b + 4 * i);
      const f32x4 rkv = *(const f32x4*)(rk + lane * 16 + 4 * i);
      const float ke[4] = {bflo(k0.x) + bflo(k1.x), bfhi(k0.x) + bfhi(k1.x), bflo(k0.y) + bflo(k1.y), bfhi(k0.y) + bfhi(k1.y)};
#pragma unroll
      for (int j = 0; j < 4; ++j) { y[4 * i + j] = a[j] + c[j]; s += y[4 * i + j]; bon += r[j] * ke[j] * rkv[j]; }
    }
    s = quad_sum(s); bon = quad_sum(bon);
    const float mean = s * (1.f / 64.f);
    float vs = 0.f;
#pragma unroll
    for (int j = 0; j < 16; ++j) { const float d = y[j] - mean; vs += d * d; }
    vs = quad_sum(vs);
    const float rstd = rsqrtf(vs * (1.f / 64.f) + 64e-5f);
    unsigned ow[8];
#pragma unroll
    for (int i = 0; i < 4; ++i) {
      float o[4];
#pragma unroll
      for (int j = 0; j < 4; ++j) o[j] = ((y[4 * i + j] - mean) * rstd * lg4[i][j] + lb4[i][j] + bon * vv4[i][j]) * gg4[i][j];
      ow[2 * i] = pack2(o[0], o[1]); ow[2 * i + 1] = pack2(o[2], o[3]);
    }
    *(uint4*)(Z + b) = make_uint4(ow[0], ow[1], ow[2], ow[3]);
    *(uint4*)(Z + b + 8) = make_uint4(ow[4], ow[5], ow[6], ow[7]);
  }
}

__device__ __forceinline__ void phase_mla_rows(const Params& p) {
  PH_BEGIN
  const int lane = tid_ & 63, gw = bid_ * 4 + (tid_ >> 6), nw = gridDim.x * 4;
  const float* QC = (const float*)(ws_ + OFF_QC);
  bf16_t* QN = (bf16_t*)(ws_ + OFF_QN);
  bf16_t* CK = (bf16_t*)(ws_ + OFF_CKVALL);
  bf16_t* KR = (bf16_t*)(ws_ + OFF_KRALL);
  const float* gq = p.in[35]; const float* gkv = p.in[38];
  for (int row = gw; row < 6144; row += nw) {
    const float* q = QC + (size_t)row * 704;
    int keyrow = row;
    if (row >= 4096) { const int r = row - 4096; keyrow = 4096 + (r >> 10) * 1280 + 256 + (r & 1023); }
    float qv[6], ss = 0.f;
#pragma unroll
    for (int i = 0; i < 6; ++i) { qv[i] = q[lane + 64 * i]; ss += qv[i] * qv[i]; }
    ss = wave_sum(ss);
    float rs = rsqrtf(ss * (1.f / 384.f) + 1e-6f);
#pragma unroll
    for (int i = 0; i < 6; ++i) QN[(size_t)row * 384 + lane + 64 * i] = f2bf(qv[i] * rs * gq[lane + 64 * i]);
    float cv[4]; ss = 0.f;
#pragma unroll
    for (int i = 0; i < 4; ++i) { cv[i] = q[384 + lane + 64 * i]; ss += cv[i] * cv[i]; }
    ss = wave_sum(ss);
    rs = rsqrtf(ss * (1.f / 256.f) + 1e-6f);
#pragma unroll
    for (int i = 0; i < 4; ++i) {
      const float o = cv[i] * rs * gkv[lane + 64 * i];
      CK[(size_t)keyrow * 256 + lane + 64 * i] = f2bf(o);
      if (row < 4096) p.out[OUT_CKV + (size_t)row * 256 + lane + 64 * i] = o;
    }
    float kv = q[640 + lane];
    if (row < 4096) {
      p.out[OUT_KROPE + (size_t)row * 64 + lane] = kv;
    } else {
      const int pp = (row - 4096) & 1023;
      const float posv = (lane >> 5) ? (float)(pp & 63) : (float)(pp >> 6);
      const float inv = exp2f(-(float)(lane & 15) * 0.8304820237218406f);
      const float rev = posv * inv * 0.15915494309189535f;
      const float sn = __builtin_amdgcn_sinf(rev), cs = __builtin_amdgcn_cosf(rev);
      const float other = __shfl_xor(kv, 16);
      kv = (lane & 16) ? (other * sn + kv * cs) : (kv * cs - other * sn);
    }
    KR[krf_idx(keyrow, lane)] = f2bf(kv);
  }
}

#define ACC_T f32x4 (&acc)[4][4]
#define LANE_VARS const int lane = tid_ & 63, l15 = lane & 15, quad = lane >> 4; (void)l15; (void)quad;

__device__ __forceinline__ void phase_gemm_f32(const bf16_t* A, int lda, const bf16_t* Bt, int ldb, int K, int ntm, int ntn, float* Out, int ldo, int nvalid, char* lds) {
  PH_BEGIN_NOWS
  { size_t z_ = 0; asm volatile("" : "+s"(z_)); A += z_; Bt += z_; Out += z_; }
  LANE_VARS
  for (int t = bid_; t < ntm * ntn; t += gridDim.x) {
    const int tm = t % ntm, tn = t / ntm;
    gemm_tile<true>(A + (size_t)tm * 128 * lda, lda, Bt + (size_t)tn * 128 * ldb, ldb, K, lds, [&](ACC_T, int r0, int c0) __attribute__((always_inline)) {
#pragma unroll
      for (int mi = 0; mi < 4; ++mi)
#pragma unroll
        for (int ni = 0; ni < 4; ++ni) {
          const int row = tm * 128 + r0 + mi * 16 + l15, col = tn * 128 + c0 + ni * 16 + quad * 4;
          if (col < nvalid) *(f32x4*)(Out + (size_t)row * ldo + col) = acc[mi][ni];
        }
    });
  }
}

__device__ __forceinline__ void phase_gemm_f32_m96(const bf16_t* A, int lda, const bf16_t* Bt, int ldb, int K, float* Out, char* lds) {
  PH_BEGIN_NOWS
  { size_t z_ = 0; asm volatile("" : "+s"(z_)); A += z_; Bt += z_; Out += z_; }
  LANE_VARS
  char* stg = lds + 32768 + (tid_ >> 6) * 8192;
  bf16_t* Ob = (bf16_t*)Out;
  for (int t = bid_; t < 64 * 8; t += gridDim.x) {
    const int tm = t % 64, tn = t / 64;
    gemm_tile_mi<true, 3>(A + (size_t)tm * 96 * lda, lda, Bt + (size_t)tn * 128 * ldb, ldb, K, lds, [&](f32x4 (&acc)[3][4], int r0, int c0) __attribute__((always_inline)) {
#pragma unroll
      for (int mi = 0; mi < 3; ++mi) {
#pragma unroll
        for (int ni = 0; ni < 4; ++ni) {
          const f32x4 v = acc[mi][ni];
          *(uint2*)(stg + l15 * 144 + (ni * 16 + quad * 4) * 2) = make_uint2(pack2(v[0], v[1]), pack2(v[2], v[3]));
        }
#pragma unroll
        for (int j = 0; j < 2; ++j) {
          const int rr = (lane >> 3) + 8 * j;
          const uint4 w = *(const uint4*)(stg + rr * 144 + (lane & 7) * 16);
          *(uint4*)(Ob + (size_t)(tm * 96 + r0 + mi * 16 + rr) * 1024 + tn * 128 + c0 + (lane & 7) * 8) = w;
        }
      }
    });
  }
}

template <int ACT>
__device__ __forceinline__ void phase_gemm_bf16(const bf16_t* A, int lda, const bf16_t* Bt, int ldb, int K, int ntm, int ntn, bf16_t* Out, int ldo, char* lds) {
  PH_BEGIN_NOWS
  { size_t z_ = 0; asm volatile("" : "+s"(z_)); A += z_; Bt += z_; Out += z_; }
  LANE_VARS
  char* stg = lds + 32768 + (tid_ >> 6) * 8192;
  for (int t = bid_; t < ntm * ntn; t += gridDim.x) {
    const int tm = t % ntm, tn = t / ntm;
    gemm_tile<true>(A + (size_t)tm * 128 * lda, lda, Bt + (size_t)tn * 128 * ldb, ldb, K, lds, [&](ACC_T, int r0, int c0) __attribute__((always_inline)) {
#pragma unroll
      for (int ps = 0; ps < 2; ++ps) {
#pragma unroll
        for (int mi2 = 0; mi2 < 2; ++mi2)
#pragma unroll
          for (int ni = 0; ni < 4; ++ni) {
            f32x4 v = acc[ps * 2 + mi2][ni];
            if (ACT == 1) {
#pragma unroll
              for (int j = 0; j < 4; ++j) { const float r = fmaxf(v[j], 0.f); v[j] = r * r; }
            }
            *(uint2*)(stg + (mi2 * 16 + l15) * 144 + (ni * 16 + quad * 4) * 2) = make_uint2(pack2(v[0], v[1]), pack2(v[2], v[3]));
          }
#pragma unroll
        for (int j = 0; j < 4; ++j) {
          const int rr = (lane >> 3) + 8 * j;
          const uint4 w = *(const uint4*)(stg + rr * 144 + (lane & 7) * 16);
          *(uint4*)(Out + (size_t)(tm * 128 + r0 + ps * 32 + rr) * ldo + tn * 128 + c0 + (lane & 7) * 8) = w;
        }
      }
    });
  }
}

__device__ __forceinline__ void phase_gemm_bf16_m96(const bf16_t* A, int lda, const bf16_t* Bt, int ldb, int K, int ntn, bf16_t* Out, int ldo, char* lds) {
  PH_BEGIN_NOWS
  { size_t z_ = 0; asm volatile("" : "+s"(z_)); A += z_; Bt += z_; Out += z_; }
  LANE_VARS
  char* stg = lds + 32768 + (tid_ >> 6) * 8192;
  for (int t = bid_; t < 64 * ntn; t += gridDim.x) {
    const int tm = t % 64, tn = t / 64;
    gemm_tile_mi<true, 3>(A + (size_t)tm * 96 * lda, lda, Bt + (size_t)tn * 128 * ldb, ldb, K, lds, [&](f32x4 (&acc)[3][4], int r0, int c0) __attribute__((always_inline)) {
#pragma unroll
      for (int mi = 0; mi < 3; ++mi) {
#pragma unroll
        for (int ni = 0; ni < 4; ++ni) {
          const f32x4 v = acc[mi][ni];
          *(uint2*)(stg + l15 * 144 + (ni * 16 + quad * 4) * 2) = make_uint2(pack2(v[0], v[1]), pack2(v[2], v[3]));
        }
#pragma unroll
        for (int j = 0; j < 2; ++j) {
          const int rr = (lane >> 3) + 8 * j;
          const uint4 w = *(const uint4*)(stg + rr * 144 + (lane & 7) * 16);
          *(uint4*)(Out + (size_t)(tm * 96 + r0 + mi * 16 + rr) * ldo + tn * 128 + c0 + (lane & 7) * 8) = w;
        }
      }
    });
  }
}

__device__ __forceinline__ void stg_store_bf16(char* stg, const f32x4 (&v)[4], bf16_t* dst, int ld, int lane) {
  const int l15 = lane & 15, quad = lane >> 4;
#pragma unroll
  for (int ni = 0; ni < 4; ++ni) *(uint2*)(stg + l15 * 144 + (ni * 16 + quad * 4) * 2) = make_uint2(pack2(v[ni][0], v[ni][1]), pack2(v[ni][2], v[ni][3]));
#pragma unroll
  for (int j = 0; j < 2; ++j) {
    const int rr = (lane >> 3) + 8 * j;
    const uint4 w = *(const uint4*)(stg + rr * 144 + (lane & 7) * 16);
    *(uint4*)(dst + (size_t)rr * ld + (lane & 7) * 8) = w;
  }
}
__device__ __forceinline__ void phase_chan_dft(const Params& p, char* lds) {
  PH_BEGIN
  LANE_VARS
  const bf16_t* H = (const bf16_t*)(ws_ + OFF_H);
  const bf16_t* TB = (const bf16_t*)(ws_ + OFF_DFTC);
  bf16_t* YT = (bf16_t*)(ws_ + OFF_YT);
  for (int t = bid_; t < 48 * 16; t += gridDim.x) {
    const int tm = t % 48, tn = t / 48, g = tn >> 1, half = tn & 1;
    const int trow = tm * 128;
    bf16_t* base; int n, pos0;
    if (trow < 4096) { n = 256; pos0 = trow & 255; base = YT + (size_t)(trow >> 8) * (1024 * 512); }
    else { n = 1024; pos0 = (trow - 4096) & 1023; base = YT + (size_t)16 * 1024 * 512 + (size_t)((trow - 4096) >> 10) * (1024 * 2048); }
    gemm_tile<false>(H + (size_t)trow * 1024 + g * 128, 1024, TB + (size_t)half * 128 * 128, 128, 128, lds, [&](ACC_T, int r0, int c0) __attribute__((always_inline)) {
#pragma unroll
      for (int mi = 0; mi < 4; ++mi)
#pragma unroll
        for (int ni = 0; ni < 4; ++ni) {
          const int pos = pos0 + r0 + mi * 16 + quad * 4, cp = c0 + ni * 16 + l15;
          const f32x4 v = acc[mi][ni];
          *(uint2*)(base + (size_t)(g * 128 + cp) * (2 * n) + half * n + pos) = make_uint2(pack2(v[0], v[1]), pack2(v[2], v[3]));
        }
    });
  }
}

__device__ __forceinline__ void phase_pos_dft(const Params& p, char* lds) {
  PH_BEGIN
  LANE_VARS
  const bf16_t* YT = (const bf16_t*)(ws_ + OFF_YT);
  bf16_t* F = (bf16_t*)(ws_ + OFF_F);
  for (int u = bid_; u < 384; u += gridDim.x) {
    const bf16_t *A, *Bt; int ld, K, orow, tn;
    if (u < 128) {
      const int s2 = u >> 6, tm = (u >> 3) & 7; tn = u & 7;
      A = (const bf16_t*)(ws_ + OFF_DFTP1024) + (size_t)tm * 128 * 2048; ld = 2048; K = 2048;
      Bt = YT + (size_t)16 * 1024 * 512 + (size_t)s2 * 1024 * 2048 + (size_t)tn * 128 * 2048;
      orow = 4096 + s2 * 1024 + tm * 128;
    } else {
      const int v = u - 128, s = v >> 4, tm = (v >> 3) & 1; tn = v & 7;
      A = (const bf16_t*)(ws_ + OFF_DFTP256) + (size_t)tm * 128 * 512; ld = 512; K = 512;
      Bt = YT + (size_t)s * 1024 * 512 + (size_t)tn * 128 * 512;
      orow = s * 256 + tm * 128;
    }
    gemm_tile<true>(A, ld, Bt, ld, K, lds, [&](ACC_T, int r0, int c0) __attribute__((always_inline)) {
#pragma unroll
      for (int mi = 0; mi < 4; ++mi) stg_store_bf16(lds + 32768 + (tid_ >> 6) * 8192, acc[mi], F + (size_t)(orow + r0 + mi * 16) * 1024 + tn * 128 + c0, 1024, lane);
    });
  }
  if (bid_ >= 128) {
    for (int d = bid_ - 128; d < N_DEFERRED_L1; d += (int)gridDim.x - 128) conv_deferred_l1(p, ws_, d, lds, tid_);
  }
}

__device__ __forceinline__ void phase_rwkv_gemm1(const Params& p, char* lds) {
  PH_BEGIN
  LANE_VARS
  const bf16_t* XM = (const bf16_t*)(ws_ + OFF_XM);
  const bf16_t* Bt = (const bf16_t*)(ws_ + OFF_RW1T);
  float* R = (float*)(ws_ + OFF_R); float* V = (float*)(ws_ + OFF_V); float* Kb = (float*)(ws_ + OFF_K); float* KK = (float*)(ws_ + OFF_KK);
  bf16_t* LB = (bf16_t*)(ws_ + OFF_LB);
  const float* k_k = p.in[29];
  for (int t = bid_; t < 48 * 27; t += gridDim.x) {
    const int tm = t % 48, tn = t / 48;
    int sel, kind;
    if (tn < 8) { sel = 0; kind = 0; } else if (tn < 16) { sel = 2; kind = 1; } else if (tn < 24) { sel = 3; kind = 2; }
    else { kind = 3; sel = tn == 24 ? 1 : (tn == 25 ? 4 : 5); }
    gemm_tile<true>(XM + (size_t)sel * SZ_ACT + (size_t)tm * 128 * 1024, 1024, Bt + (size_t)tn * 128 * 1024, 1024, 1024, lds, [&](ACC_T, int r0, int c0) __attribute__((always_inline)) {
      if (kind == 1) {
        const int cb = (tn - 8) * 128 + c0;
#pragma unroll
        for (int mi = 0; mi < 4; ++mi) {
          const int row = tm * 128 + r0 + mi * 16 + l15;
          f32x4 kk[4]; float ss = 0.f;
#pragma unroll
          for (int ni = 0; ni < 4; ++ni) {
            const int col = cb + ni * 16 + quad * 4;
            const f32x4 kkw = *(const f32x4*)(k_k + col);
            kk[ni] = acc[mi][ni] * kkw;
            ss += kk[ni][0] * kk[ni][0] + kk[ni][1] * kk[ni][1] + kk[ni][2] * kk[ni][2] + kk[ni][3] * kk[ni][3];
            *(f32x4*)(Kb + (size_t)row * 1024 + col) = acc[mi][ni];
          }
          ss += __shfl_xor(ss, 16); ss += __shfl_xor(ss, 32);
          const float rn = rsqrtf(ss + 1e-12f);
#pragma unroll
          for (int ni = 0; ni < 4; ++ni) *(f32x4*)(KK + (size_t)row * 1024 + cb + ni * 16 + quad * 4) = kk[ni] * rn;
          __builtin_amdgcn_sched_barrier(0);
        }
      } else if (kind == 3) {
        const int cb = (tn - 24) * 128 + c0;
#pragma unroll
        for (int mi = 0; mi < 4; ++mi)
#pragma unroll
          for (int ni = 0; ni < 4; ++ni) {
            const int row = tm * 128 + r0 + mi * 16 + l15, col = cb + ni * 16 + quad * 4;
            f32x4 v = acc[mi][ni];
            if (tn == 24) { v[0] = tanhf(v[0]); v[1] = tanhf(v[1]); v[2] = tanhf(v[2]); v[3] = tanhf(v[3]); }
            else if (tn == 26) { v[0] = sigmoidf_(v[0]); v[1] = sigmoidf_(v[1]); v[2] = sigmoidf_(v[2]); v[3] = sigmoidf_(v[3]); }
            *(uint2*)(LB + (size_t)row * 384 + col) = make_uint2(pack2(v[0], v[1]), pack2(v[2], v[3]));
            __builtin_amdgcn_sched_barrier(0);
          }
      } else {
        float* dst = kind == 0 ? R : V;
        const int cb = (kind == 0 ? tn : tn - 16) * 128 + c0;
#pragma unroll
        for (int mi = 0; mi < 4; ++mi)
#pragma unroll
          for (int ni = 0; ni < 4; ++ni)
            *(f32x4*)(dst + (size_t)(tm * 128 + r0 + mi * 16 + l15) * 1024 + cb + ni * 16 + quad * 4) = acc[mi][ni];
      }
    });
  }
}

__device__ __forceinline__ void phase_rwkv_gemm2(const Params& p, char* lds) {
  PH_BEGIN
  LANE_VARS
  const bf16_t* LB = (const bf16_t*)(ws_ + OFF_LB);
  const float* Kb = (const float*)(ws_ + OFF_K); const float* KK = (const float*)(ws_ + OFF_KK);
  float* WD = (float*)(ws_ + OFF_WDEC); float* G = (float*)(ws_ + OFF_G);
  bf16_t* KE = (bf16_t*)(ws_ + OFF_KEFF); bf16_t* NB = (bf16_t*)(ws_ + OFF_NB);
  const float* k_a = p.in[30];
  for (int t = bid_; t < 48 * 40; t += gridDim.x) {
    const int tm = t % 48, tq = t / 48, grp = tq >> 3, tn = tq & 7;
    const bf16_t* Bt; int K;
    if (grp < 2) { Bt = (const bf16_t*)(ws_ + OFF_RWW2T) + (size_t)grp * 1024 * 64; K = 64; }
    else if (grp < 4) { Bt = (const bf16_t*)(ws_ + OFF_RWA2T) + (size_t)(grp - 2) * 1024 * 64; K = 64; }
    else { Bt = (const bf16_t*)(ws_ + OFF_RWG2T); K = 128; }
    gemm_tile<true>(LB + (size_t)tm * 128 * 384 + grp * 64, 384, Bt + (size_t)tn * 128 * K, K, K, lds, [&](ACC_T, int r0, int c0) __attribute__((always_inline)) {
#pragma unroll
      for (int mi = 0; mi < 4; ++mi)
#pragma unroll
        for (int ni = 0; ni < 4; ++ni) {
          const int row = tm * 128 + r0 + mi * 16 + l15, col = tn * 128 + c0 + ni * 16 + quad * 4;
          const size_t idx = (size_t)row * 1024 + col;
          f32x4 v = acc[mi][ni];
          if (grp < 2) {
            const f32x4 w0 = *(const f32x4*)(p.in[21] + grp * 1024 + col);
            auto dec = [](float w0v, float vv) {
              const float z = -(w0v + vv);
              const float sp = fmaxf(z, 0.f) + __logf(1.f + __expf(-fabsf(z)));
              return __expf(-__expf(-sp - 0.5f));
            };
            *(f32x4*)(WD + (size_t)grp * SZ_ACT + idx) = (f32x4){dec(w0[0], v[0]), dec(w0[1], v[1]), dec(w0[2], v[2]), dec(w0[3], v[3])};
          } else if (grp < 4) {
            const int d = grp - 2;
            const f32x4 a0 = *(const f32x4*)(p.in[24] + d * 1024 + col), ka = *(const f32x4*)(k_a + col);
            const f32x4 kv = *(const f32x4*)(Kb + idx), kkv = *(const f32x4*)(KK + idx);
            const f32x4 a = (f32x4){sigmoidf_(a0[0] + v[0]), sigmoidf_(a0[1] + v[1]), sigmoidf_(a0[2] + v[2]), sigmoidf_(a0[3] + v[3])};
            const f32x4 ke = kv * (1.f + (a - 1.f) * ka);
            const f32x4 nb = -kkv * a;
            *(uint2*)(KE + (size_t)d * SZ_ACT + idx) = make_uint2(pack2(ke[0], ke[1]), pack2(ke[2], ke[3]));
            *(uint2*)(NB + (size_t)d * SZ_ACT + idx) = make_uint2(pack2(nb[0], nb[1]), pack2(nb[2], nb[3]));
          } else {
            *(f32x4*)(G + idx) = v;
          }
          __builtin_amdgcn_sched_barrier(0);
        }
    });
  }
}

__device__ __forceinline__ void phase_mla_up(const Params& p, char* lds) {
  PH_BEGIN
  LANE_VARS
  const bf16_t* QN = (const bf16_t*)(ws_ + OFF_QN);
  const bf16_t* CK = (const bf16_t*)(ws_ + OFF_CKVALL);
  bf16_t* Q = (bf16_t*)(ws_ + OFF_Q); bf16_t* KN = (bf16_t*)(ws_ + OFF_KN); bf16_t* VT = (bf16_t*)(ws_ + OFF_VT);
  const float qs = 0.07216878364870323f * 1.4426950408889634f;
  for (int t = bid_; t < 576 + 416 + 416; t += gridDim.x) {
    if (t < 576) {
      const int tm = t % 48, tn = t / 48;
      gemm_tile_1set<true>(QN + (size_t)tm * 128 * 384, 384, (const bf16_t*)(ws_ + OFF_MUQT) + (size_t)tn * 128 * 384, 384, 384, lds, [&](ACC_T, int r0, int c0) __attribute__((always_inline)) {
        const int cb = tn * 128 + c0;
        const bool ropeblk = (cb % 192) == 128;
#pragma unroll
        for (int mi = 0; mi < 4; ++mi) {
          const int row = tm * 128 + r0 + mi * 16 + l15;
          f32x4 v[4];
#pragma unroll
          for (int ni = 0; ni < 4; ++ni) v[ni] = acc[mi][ni] * qs;
          if (ropeblk && row >= 4096) {
            const int pp = (row - 4096) & 1023;
#pragma unroll
            for (int ax = 0; ax < 2; ++ax) {
              const float posv = ax ? (float)(pp & 63) : (float)(pp >> 6);
#pragma unroll
              for (int j = 0; j < 4; ++j) {
                const float inv = exp2f(-(float)(quad * 4 + j) * 0.8304820237218406f);
                const float rev = posv * inv * 0.15915494309189535f;
                const float sn = __builtin_amdgcn_sinf(rev), cs = __builtin_amdgcn_cosf(rev);
                const float x1 = v[2 * ax][j], x2 = v[2 * ax + 1][j];
                v[2 * ax][j] = x1 * cs - x2 * sn; v[2 * ax + 1][j] = x1 * sn + x2 * cs;
              }
            }
          }
          stg_store_bf16(lds + 32768 + (tid_ >> 6) * 8192, v, Q + (size_t)(tm * 128 + r0 + mi * 16) * 1536 + cb, 1536, lane);
        }
      });
    } else if (t < 576 + 416) {
      const int u = t - 576, tm = u % 52, tn = u / 52;
      gemm_tile_1set<true>(CK + (size_t)tm * 128 * 256, 256, (const bf16_t*)(ws_ + OFF_MUKT) + (size_t)tn * 128 * 256, 256, 256, lds, [&](ACC_T, int r0, int c0) __attribute__((always_inline)) {
#pragma unroll
        for (int mi = 0; mi < 4; ++mi)
#pragma unroll
          for (int ni = 0; ni < 4; ++ni) {
            const f32x4 v = acc[mi][ni];
            *(uint2*)(KN + knf_idx(tm * 128 + r0 + mi * 16 + l15, tn * 128 + c0 + ni * 16 + quad * 4)) = make_uint2(pack2(v[0], v[1]), pack2(v[2], v[3]));
          }
      });
    } else {
      const int u = t - 576 - 416, tm = u % 52, tn = u / 52;
      const int krow = tm * 128;
      bf16_t* base; int ldv, kp0;
      if (krow < 4096) { base = VT + (size_t)(krow >> 8) * 262144; ldv = 256; kp0 = krow & 255; }
      else { const int r = krow - 4096, s2 = r / 1280; base = VT + 4194304 + (size_t)s2 * 1310720; ldv = 1280; kp0 = r - s2 * 1280; }
      gemm_tile_1set<false>(CK + (size_t)tm * 128 * 256, 256, (const bf16_t*)(ws_ + OFF_MUVT) + (size_t)tn * 128 * 256, 256, 256, lds, [&](ACC_T, int r0, int c0) __attribute__((always_inline)) {
#pragma unroll
        for (int mi = 0; mi < 4; ++mi)
#pragma unroll
          for (int ni = 0; ni < 4; ++ni) {
            const f32x4 v = acc[mi][ni];
            const int n = tn * 128 + c0 + ni * 16 + l15, kp = kp0 + r0 + mi * 16 + quad * 4;
            *(uint2*)(VT + vf_idx(krow + r0 + mi * 16 + quad * 4, n)) = make_uint2(pack2(v[0], v[1]), pack2(v[2], v[3])); (void)base; (void)ldv; (void)kp;
          }
      });
    }
  }
}

__device__ __forceinline__ float row16_sum(float v) {
  v += __int_as_float(__builtin_amdgcn_update_dpp(0, __float_as_int(v), 0xB1, 0xF, 0xF, true));
  v += __int_as_float(__builtin_amdgcn_update_dpp(0, __float_as_int(v), 0x4E, 0xF, 0xF, true));
  v += __int_as_float(__builtin_amdgcn_update_dpp(0, __float_as_int(v), 0x141, 0xF, 0xF, true));
  v += __int_as_float(__builtin_amdgcn_update_dpp(0, __float_as_int(v), 0x140, 0xF, 0xF, true));
  return v;
}
template <int R>
__device__ __forceinline__ void scan_block(const Params& p, char* ws_, char* lds, int tid, int n, int tok0, int h, int dir, int sub, const float* sinit, float* sfin) {
  const int lane = tid & 63, wid = tid >> 6, rg = lane >> 4, kpos = lane & 15;
  const float* Rb = (const float*)(ws_ + OFF_R); const float* V = (const float*)(ws_ + OFF_V); const float* KK = (const float*)(ws_ + OFF_KK);
  const float* WD = (const float*)(ws_ + OFF_WDEC) + (size_t)dir * SZ_ACT;
  const bf16_t* KE = (const bf16_t*)(ws_ + OFF_KEFF) + (size_t)dir * SZ_ACT;
  const bf16_t* NB = (const bf16_t*)(ws_ + OFF_NB) + (size_t)dir * SZ_ACT;
  float* Y = (float*)(ws_ + (dir ? OFF_Y1 : OFF_Y0));
  float* vb = (float*)lds;
  float* yb = (float*)(lds + 49152);
  const int lsi = tid >> 4, lc4 = (tid & 15) * 4;
  const int row0 = sub * 16 * R + (wid * 4 + rg) * R;
  f32x4 S[R];
#pragma unroll
  for (int r = 0; r < R; ++r) S[r] = sinit ? *(const f32x4*)(sinit + (row0 + r) * 64 + kpos * 4) : (f32x4){0.f, 0.f, 0.f, 0.f};
  const int nch = n >> 4;
  f32x4 lr, lw, lke, lkk, lnb, lv;
  auto gload = [&](int c) {
    const int tt = c * 16 + lsi, tm = dir ? (n - 1 - tt) : tt;
    const size_t idx = (size_t)(tok0 + tm) * 1024 + h * 64 + lc4;
    lr = *(const f32x4*)(Rb + idx); lw = *(const f32x4*)(WD + idx); lkk = *(const f32x4*)(KK + idx); lv = *(const f32x4*)(V + idx);
    const uint2 a = *(const uint2*)(KE + idx), b = *(const uint2*)(NB + idx);
    lke = (f32x4){bflo(a.x), bfhi(a.x), bflo(a.y), bfhi(a.y)};
    lnb = (f32x4){bflo(b.x), bfhi(b.x), bflo(b.y), bfhi(b.y)};
  };
  auto lstore = [&](int buf) {
    float* d = vb + buf * 6144 + lsi * 384 + lc4;
    *(f32x4*)(d) = lr; *(f32x4*)(d + 64) = lw; *(f32x4*)(d + 128) = lke; *(f32x4*)(d + 192) = lkk; *(f32x4*)(d + 256) = lnb; *(f32x4*)(d + 320) = lv;
  };
  gload(0); lstore(0);
  __syncthreads();
  for (int c = 0; c < nch; ++c) {
    const int buf = c & 1;
    if (c + 1 < nch) gload(c + 1);
    const float* cb = vb + buf * 6144;
    float* ycb = yb + buf * 1024;
    f32x4 nr4, nw4, ne4, nk4, nb4; float nvv[R];
#define SC_LDS(s_) do { const float* sv_ = cb + (s_) * 384 + kpos * 4; nr4 = *(const f32x4*)(sv_); nw4 = *(const f32x4*)(sv_ + 64); ne4 = *(const f32x4*)(sv_ + 128); nk4 = *(const f32x4*)(sv_ + 192); nb4 = *(const f32x4*)(sv_ + 256); \
      if (R == 4) { const f32x4 v4_ = *(const f32x4*)(cb + (s_) * 384 + 320 + row0); nvv[0] = v4_[0]; nvv[1 % R] = v4_[1]; nvv[2 % R] = v4_[2]; nvv[3 % R] = v4_[3]; } \
      else { _Pragma("unroll") for (int r = 0; r < R; ++r) nvv[r] = cb[(s_) * 384 + 320 + row0 + r]; } } while (0)
    SC_LDS(0);
#pragma unroll
    for (int s = 0; s < 16; ++s) {
      const f32x4 r4 = nr4, w4 = nw4, e4 = ne4, k4 = nk4, b4 = nb4;
      float vv[R];
#pragma unroll
      for (int r = 0; r < R; ++r) vv[r] = nvv[r];
      if (s + 1 < 16) SC_LDS(s + 1);
      float sa[R];
#pragma unroll
      for (int r = 0; r < R; ++r) { const f32x4 t = S[r] * k4; sa[r] = row16_sum((t[0] + t[1]) + (t[2] + t[3])); }
      float ysel = 0.f;
#pragma unroll
      for (int r = 0; r < R; ++r) {
        S[r] = S[r] * w4 + sa[r] * b4 + vv[r] * e4;
        const f32x4 t = S[r] * r4;
        const float y = row16_sum((t[0] + t[1]) + (t[2] + t[3]));
        ysel = kpos == r ? y : ysel;
      }
      if (kpos < R) ycb[s * 64 + row0 + kpos] = ysel;
    }
    if (c + 1 < nch) lstore(buf ^ 1);
    __syncthreads();
    {
      const int tt = c * 16 + lsi, tm = dir ? (n - 1 - tt) : tt;
      if (R == 4) *(f32x4*)(Y + (size_t)(tok0 + tm) * 1024 + h * 64 + lc4) = *(const f32x4*)(ycb + lsi * 64 + lc4);
      else Y[(size_t)(tok0 + tm) * 1024 + h * 64 + sub * 16 + (tid & 15)] = ycb[lsi * 64 + sub * 16 + (tid & 15)];
    }
  }
  if (sfin) {
#pragma unroll
    for (int r = 0; r < R; ++r) *(f32x4*)(sfin + (row0 + r) * 64 + kpos * 4) = S[r];
  }
  __syncthreads();
}
__device__ __forceinline__ void scan_block_q2(const Params& p, char* ws_, char* lds, int tid, int jp) {
  const int lane = tid & 63, wid = tid >> 6, isel = wid >> 1, q = lane >> 2, kq = lane & 3;
  const int sq = jp >> 4, h = jp & 15, n = 256, tok0 = sq * 256;
  const float* Rb = (const float*)(ws_ + OFF_R); const float* V = (const float*)(ws_ + OFF_V); const float* KK = (const float*)(ws_ + OFF_KK);
  float* vb = (float*)lds;
  float* yb = (float*)(lds + 49152);
  const int lis = tid >> 7, lsi = (tid >> 4) & 7, lc4 = (tid & 15) * 4;
  const float* WDl = (const float*)(ws_ + OFF_WDEC) + (size_t)lis * SZ_ACT;
  const bf16_t* KEl = (const bf16_t*)(ws_ + OFF_KEFF) + (size_t)lis * SZ_ACT;
  const bf16_t* NBl = (const bf16_t*)(ws_ + OFF_NB) + (size_t)lis * SZ_ACT;
  float* Yl = (float*)(ws_ + (lis ? OFF_Y1 : OFF_Y0));
  const int row0 = (wid & 1) * 32 + q * 2;
  f32x4 S[2][4];
#pragma unroll
  for (int r = 0; r < 2; ++r)
#pragma unroll
    for (int i = 0; i < 4; ++i) S[r][i] = (f32x4){0.f, 0.f, 0.f, 0.f};
  f32x4 lr, lw, lke, lkk, lnb, lv;
  auto gload = [&](int c) {
    const int tt = c * 8 + lsi, tm = lis ? (n - 1 - tt) : tt;
    const size_t idx = (size_t)(tok0 + tm) * 1024 + h * 64 + lc4;
    lr = *(const f32x4*)(Rb + idx); lw = *(const f32x4*)(WDl + idx); lkk = *(const f32x4*)(KK + idx); lv = *(const f32x4*)(V + idx);
    const uint2 a = *(const uint2*)(KEl + idx), b = *(const uint2*)(NBl + idx);
    lke = (f32x4){bflo(a.x), bfhi(a.x), bflo(a.y), bfhi(a.y)};
    lnb = (f32x4){bflo(b.x), bfhi(b.x), bflo(b.y), bfhi(b.y)};
  };
  auto lstore = [&](int buf) {
    float* d = vb + buf * 6144 + lis * 3072 + lsi * 384 + lc4;
    *(f32x4*)(d) = lr; *(f32x4*)(d + 64) = lw; *(f32x4*)(d + 128) = lke; *(f32x4*)(d + 192) = lkk; *(f32x4*)(d + 256) = lnb; *(f32x4*)(d + 320) = lv;
  };
  gload(0); lstore(0);
  __syncthreads();
  for (int c = 0; c < 32; ++c) {
    const int buf = c & 1;
    if (c + 1 < 32) gload(c + 1);
    const float* cb = vb + buf * 6144 + isel * 3072;
    float* ycb = yb + buf * 1024 + isel * 512;
#pragma unroll 2
    for (int s = 0; s < 8; ++s) {
      const float* sv = cb + s * 384 + kq * 16;
      f32x4 k4[4], w4[4], b4[4], e4[4], r4[4];
#pragma unroll
      for (int i = 0; i < 4; ++i) { r4[i] = *(const f32x4*)(sv + 4 * i); w4[i] = *(const f32x4*)(sv + 64 + 4 * i); e4[i] = *(const f32x4*)(sv + 128 + 4 * i); k4[i] = *(const f32x4*)(sv + 192 + 4 * i); b4[i] = *(const f32x4*)(sv + 256 + 4 * i); }
      const f32x2 vv2 = *(const f32x2*)(cb + s * 384 + 320 + row0);
      float ysel = 0.f;
#pragma unroll
      for (int r = 0; r < 2; ++r) {
        const f32x4 t = (S[r][0] * k4[0] + S[r][1] * k4[1]) + (S[r][2] * k4[2] + S[r][3] * k4[3]);
        const float sa = quad_sum((t[0] + t[1]) + (t[2] + t[3]));
        const float vv = vv2[r];
#pragma unroll
        for (int i = 0; i < 4; ++i) S[r][i] = S[r][i] * w4[i] + sa * b4[i] + vv * e4[i];
        const f32x4 u = (S[r][0] * r4[0] + S[r][1] * r4[1]) + (S[r][2] * r4[2] + S[r][3] * r4[3]);
        const float y = quad_sum((u[0] + u[1]) + (u[2] + u[3]));
        ysel = kq == r ? y : ysel;
      }
      if (kq < 2) ycb[s * 64 + row0 + kq] = ysel;
    }
    if (c + 1 < 32) lstore(buf ^ 1);
    __syncthreads();
    {
      const int tt = c * 8 + lsi, tm = lis ? (n - 1 - tt) : tt;
      *(f32x4*)(Yl + (size_t)(tok0 + tm) * 1024 + h * 64 + lc4) = *(const f32x4*)(yb + buf * 1024 + lis * 512 + lsi * 64 + lc4);
    }
  }
  float* sfin = p.out + OUT_STATE + (size_t)((sq * 2 + isel) * 16 + h) * 4096;
#pragma unroll
  for (int r = 0; r < 2; ++r)
#pragma unroll
    for (int i = 0; i < 4; ++i) *(f32x4*)(sfin + (row0 + r) * 64 + kq * 16 + 4 * i) = S[r][i];
  __syncthreads();
}
__device__ __forceinline__ void phase_scan(const Params& p, char* lds, int cidx = 0) {
  PH_BEGIN
  const int tid = tid_;
  unsigned* ctr = (unsigned*)(ws_ + OFF_CTR) + cidx;
  volatile int& s_item = *(volatile int*)(lds + 57344);
  bool first = true;
  for (;;) {
    if (tid == 0) s_item = first ? (int)bid_ : (int)gridDim.x + (int)atomicAdd(ctr, 1u);
    first = false;
    __syncthreads();
    const int item = s_item;
    __syncthreads();
    if (item >= 512 + N_DEFERRED) break;
    if (item >= 512) { conv_deferred(p, ws_, item - 512, lds, tid); continue; }
    if (item < 256) {
      const int it = item >> 2, sub = item & 3, s2 = it >> 5, h = (it >> 1) & 15, dir = it & 1;
      __builtin_amdgcn_s_setprio(3);
      scan_block<1>(p, ws_, lds, tid, 1024, 4096 + s2 * 1024, h, dir, sub, p.in[2] + (size_t)((s2 * 2 + dir) * 16 + h) * 4096, nullptr);
      __builtin_amdgcn_s_setprio(0);
    } else {
      scan_block_q2(p, ws_, lds, tid, item - 256);
    }
  }
}

__device__ __forceinline__ void phase_attn(const Params& p, int cidx = 1) {
  PH_BEGIN
  const int lane = tid_ & 63, l15 = lane & 15, quad = lane >> 4;
  unsigned* ctr = (unsigned*)(ws_ + OFF_CTR) + cidx;
  const bf16_t* Q = (const bf16_t*)(ws_ + OFF_Q); const bf16_t* KN = (const bf16_t*)(ws_ + OFF_KN);
  const bf16_t* KR = (const bf16_t*)(ws_ + OFF_KRALL); const bf16_t* VT = (const bf16_t*)(ws_ + OFF_VT);
  bf16_t* OA = (bf16_t*)(ws_ + OFF_H);
  for (;;) {
    int item = 0;
    if (lane == 0) item = (int)atomicAdd(ctr, 1u);
    item = __builtin_amdgcn_readfirstlane(item);
    if (item >= 3072) break;
    int h, qrow0, nkeys, keybase; const bf16_t* vt;
    if (item < 1024) { const int s2 = item >> 9; h = (item >> 6) & 7; qrow0 = 4096 + s2 * 1024 + (item & 63) * 16; nkeys = 1280; keybase = 4096 + s2 * 1280; vt = VT + 4194304 + (size_t)s2 * 1310720; }
    else { const int j = item - 1024, s = j >> 7; h = (j >> 4) & 7; qrow0 = s * 256 + (j & 15) * 16; nkeys = 256; keybase = s * 256; vt = VT + (size_t)s * 262144; }
    vt += (size_t)(h * 128) * nkeys;
    bf16x8 qf[6];
#pragma unroll
    for (int ks = 0; ks < 6; ++ks) qf[ks] = *(const bf16x8*)(Q + (size_t)(qrow0 + l15) * 1536 + h * 192 + ks * 32 + quad * 8);
    f32x4 oacc[8];
#pragma unroll
    for (int i = 0; i < 8; ++i) oacc[i] = (f32x4){0.f, 0.f, 0.f, 0.f};
    float m = -1e30f, lsum = 0.f;
    const bf16_t* knp = KN + ((size_t)((keybase >> 4) * 8 + h) * 4 * 64 + lane) * 8;
    const bf16_t* krp = KR + ((size_t)((keybase >> 4) * 2) * 64 + lane) * 8;
    const bf16_t* vpp = VT + ((size_t)((keybase >> 5) * 8 + h) * 8 * 64 + lane) * 8;
    (void)vt;
    bf16x8 kf[12];
    bf16x8 vf[8];
#define AT_LOADK(c_) do { _Pragma("unroll") for (int kt = 0; kt < 2; ++kt) { const int c16 = ((c_) >> 4) + kt; \
        _Pragma("unroll") for (int ks = 0; ks < 4; ++ks) kf[kt * 6 + ks] = *(const bf16x8*)(knp + (size_t)(c16 * 32 + ks) * 512); \
        _Pragma("unroll") for (int ks = 0; ks < 2; ++ks) kf[kt * 6 + 4 + ks] = *(const bf16x8*)(krp + (size_t)(c16 * 2 + ks) * 512); } } while (0)
#define AT_LOADV(c_) do { _Pragma("unroll") for (int dvt = 0; dvt < 8; ++dvt) vf[dvt] = *(const bf16x8*)(vpp + (size_t)(((c_) >> 5) * 64 + dvt) * 512); } while (0)
    AT_LOADK(0);
    AT_LOADV(0);
    for (int c = 0; c < nkeys; c += 32) {
      f32x4 st[2];
#pragma unroll
      for (int kt = 0; kt < 2; ++kt) {
        st[kt] = (f32x4){0.f, 0.f, 0.f, 0.f};
#pragma unroll
        for (int ks = 0; ks < 6; ++ks) st[kt] = __builtin_amdgcn_mfma_f32_16x16x32_bf16(kf[kt * 6 + ks], qf[ks], st[kt], 0, 0, 0);
      }
      __builtin_amdgcn_sched_barrier(0);
      if (c + 32 < nkeys) AT_LOADK(c + 32);
      __builtin_amdgcn_sched_barrier(0);
      float cm = fmaxf(fmaxf(fmaxf(st[0][0], st[0][1]), fmaxf(st[0][2], st[0][3])), fmaxf(fmaxf(st[1][0], st[1][1]), fmaxf(st[1][2], st[1][3])));
      cm = fmaxf(cm, __shfl_xor(cm, 16)); cm = fmaxf(cm, __shfl_xor(cm, 32));
      const float mn = fmaxf(m, cm), alpha = exp2f(m - mn);
      m = mn;
      float pv[8], ps = 0.f;
#pragma unroll
      for (int e = 0; e < 8; ++e) { pv[e] = exp2f(st[e >> 2][e & 3] - mn); ps += pv[e]; }
      lsum = lsum * alpha + ps;
      union { bf16x8 v; unsigned u[4]; } pb;
      pb.u[0] = pack2(pv[0], pv[1]); pb.u[1] = pack2(pv[2], pv[3]); pb.u[2] = pack2(pv[4], pv[5]); pb.u[3] = pack2(pv[6], pv[7]);
#pragma unroll
      for (int dvt = 0; dvt < 8; ++dvt) oacc[dvt] = __builtin_amdgcn_mfma_f32_16x16x32_bf16(vf[dvt], pb.v, oacc[dvt] * alpha, 0, 0, 0);
      __builtin_amdgcn_sched_barrier(0);
      if (c + 32 < nkeys) AT_LOADV(c + 32);
      __builtin_amdgcn_sched_barrier(0);
    }
    lsum += __shfl_xor(lsum, 16); lsum += __shfl_xor(lsum, 32);
    const float il = 1.f / lsum;
#pragma unroll
    for (int dvt = 0; dvt < 8; ++dvt) {
      const f32x4 o = oacc[dvt] * il;
      *(uint2*)(OA + (size_t)(qrow0 + l15) * 1024 + h * 128 + dvt * 16 + quad * 4) = make_uint2(pack2(o[0], o[1]), pack2(o[2], o[3]));
    }
  }
}

#define SC_TOL 0.2f
#define DBG_MIXER_UPD true
#define SKIPMASK 0x0ull
#ifdef SELFCHECK
__device__ __forceinline__ unsigned hsh(unsigned x) { x ^= x >> 16; x *= 0x7feb352dU; x ^= x >> 15; x *= 0x846ca68bU; x ^= x >> 16; return x; }
__device__ __forceinline__ float b2f(bf16_t h) { return __uint_as_float(((unsigned)h) << 16); }
__device__ __forceinline__ void rep(const Params& p, int id, float got, float ref, float atol) {
  float e = fabsf(got - ref) / (fabsf(ref) + atol);
  if (!(e == e) || e > 1e9f) e = 1e9f;
  atomicMax((unsigned*)(p.ws + OFF_CTR) + 8 + id, __float_as_uint(e));
}
__device__ __forceinline__ float dotA(const bf16_t* a, const float* w, int ldw, int K) { float s = 0.f; for (int k = 0; k < K; ++k) s += b2f(a[k]) * w[(size_t)k * ldw]; return s; }
#define GID (bid_ * 256 + tid_)
#define NTHR (gridDim.x * 256)
__device__ __forceinline__ int seq_start(int row) { return row < 4096 ? (row & ~255) : 4096 + ((row - 4096) & ~1023); }
__device__ __forceinline__ int seq_len(int row) { return row < 4096 ? 256 : 1024; }
__device__ __forceinline__ int key_row(int row) { if (row < 4096) return row; const int r = row - 4096; return 4096 + (r >> 10) * 1280 + 256 + (r & 1023); }

__device__ __forceinline__ void chk_modv(const Params& p) {
  PH_BEGIN
  for (int i = GID; i < 4 * 3 * 6144; i += NTHR) {
    const int l = i / 18432, g = (i / 6144) % 3, n = i % 6144;
    float s = 0.f;
    for (int k = 0; k < 1024; ++k) { const float c = g == 0 ? p.in[6][k] : p.in[5][(g - 1) * 1024 + k]; s += c / (1.f + expf(-c)) * p.in[7][((size_t)l * 1024 + k) * 6144 + n]; }
    rep(p, 0, ((const float*)(ws_ + OFF_MOD))[i], s + p.in[8][l * 6144 + n], 0.2f);
  }
}
__device__ __forceinline__ void chk_h(const Params& p, int id, int l, int gi, int shi) {
  PH_BEGIN
  const int s = GID; if (s >= 512) return;
  const int row = hsh(s * 2 + id * 7919) % 6144, col = hsh(s * 2 + 1 + id * 7919) & 1023, g = row_group(row);
  const float* x = p.out + (size_t)row * 1024;
  float ss = 0.f; for (int k = 0; k < 1024; ++k) ss += x[k] * x[k];
  const float rs = 1.f / sqrtf(ss / 1024.f + 1e-6f);
  const float* mv = (const float*)(ws_ + OFF_MOD) + ((l * 3 + g) * 6 + shi) * 1024;
  const float ref = x[col] * rs * p.in[9][(l * 4 + gi) * 1024 + col] * (1.f + mv[1024 + col]) + mv[col];
  rep(p, id, b2f(((const bf16_t*)(ws_ + OFF_H))[(size_t)row * 1024 + col]), ref, 0.3f);
}
__device__ __forceinline__ void chk_o(const Params& p, int id, const bf16_t* A, int K, const float* W) {
  PH_BEGIN
  const int s = GID; if (s >= 512) return;
  const int row = hsh(s * 2 + id * 7919) % 6144, col = hsh(s * 2 + 1 + id * 7919) & 1023;
  rep(p, id, ((const float*)(ws_ + OFF_O))[(size_t)row * 1024 + col], dotA(A + (size_t)row * K, W + col, 1024, K), 0.3f);
}
__device__ __forceinline__ void chk_hid(const Params& p, int id, int l) {
  PH_BEGIN
  const int s = GID; if (s >= 512) return;
  const int row = hsh(s * 2 + id * 7919) % 6144, col = hsh(s * 2 + 1 + id * 7919) & 4095;
  float d = dotA((const bf16_t*)(ws_ + OFF_H) + (size_t)row * 1024, p.in[10] + (size_t)l * 1024 * 4096 + col, 4096, 1024);
  d = fmaxf(d, 0.f); d *= d;
  rep(p, id, b2f(((const bf16_t*)(ws_ + OFF_HID))[(size_t)row * 4096 + col]), d, 0.5f);
}
__device__ __forceinline__ void chk_fft(const Params& p, int id) {
  PH_BEGIN
  const int s = GID; if (s >= 128) return;
  const int row = hsh(s * 2 + id * 7919) % 6144, col = hsh(s * 2 + 1 + id * 7919) & 1023;
  const int s0 = seq_start(row), n = seq_len(row), tp = row - s0, g = col >> 7, cp = col & 127;
  const bf16_t* H = (const bf16_t*)(ws_ + OFF_H);
  float acc = 0.f;
  for (int t = 0; t < n; ++t) {
    const float a = (float)((t * tp) % n) / (float)n;
    for (int c = 0; c < 128; ++c) {
      const float b = (float)((c * cp) & 127) / 128.f;
      acc += b2f(H[(size_t)(s0 + t) * 1024 + g * 128 + c]) * cosf(6.283185307179586f * (a + b));
    }
  }
  rep(p, id, b2f(((const bf16_t*)(ws_ + OFF_F))[(size_t)row * 1024 + col]), acc / sqrtf(128.f * n), 0.3f);
}
__device__ __forceinline__ void chk_bcu(const Params& p, int id) {
  PH_BEGIN
  const int s = GID; if (s >= 512) return;
  const int row = hsh(s * 2 + id * 7919) % 6144, col = hsh(s * 2 + 1 + id * 7919) % 3072;
  rep(p, id, b2f(((const bf16_t*)(ws_ + OFF_BCU))[(size_t)row * 3072 + col]), dotA((const bf16_t*)(ws_ + OFF_H) + (size_t)row * 1024, p.in[13] + col, 3072, 1024), 0.3f);
}
__device__ __forceinline__ void chk_a2(const Params& p, int id) {
  PH_BEGIN
  const int s = GID; if (s >= 512) return;
  const int row = hsh(s * 2 + id * 7919) % 6144, col = hsh(s * 2 + 1 + id * 7919) & 1023;
  const bf16_t* B = (const bf16_t*)(ws_ + OFF_BCU);
  const int pos = row - seq_start(row), n = seq_len(row);
  auto z = [&](int r) { return b2f(B[(size_t)r * 3072 + 1024 + col]) * b2f(B[(size_t)r * 3072 + 2048 + col]); };
  float cv = z(row) * p.in[14][1024 + col];
  if (pos > 0) cv += z(row - 1) * p.in[14][col];
  if (pos < n - 1) cv += z(row + 1) * p.in[14][2048 + col];
  rep(p, id, b2f(((const bf16_t*)(ws_ + OFF_A2))[(size_t)row * 1024 + col]), b2f(B[(size_t)row * 3072 + col]) * cv, 0.3f);
}
__device__ __forceinline__ void chk_xm(const Params& p, int id) {
  PH_BEGIN
  const int s = GID; if (s >= 512) return;
  const int row = hsh(s * 2 + id * 7919) % 6144, col = hsh(s * 2 + 1 + id * 7919) & 1023, m = s % 6, g = row_group(row);
  const int pos = row - seq_start(row), n = seq_len(row);
  const float* mv = (const float*)(ws_ + OFF_MOD) + ((2 * 3 + g) * 6 + 0) * 1024;
  auto hval = [&](int r) {
    const float* x = p.out + (size_t)r * 1024; float ss = 0.f; for (int k = 0; k < 1024; ++k) ss += x[k] * x[k];
    return x[col] / sqrtf(ss / 1024.f + 1e-6f) * p.in[9][(2 * 4 + 0) * 1024 + col] * (1.f + mv[1024 + col]) + mv[col]; };
  const float hc = hval(row), hp = pos > 0 ? hval(row - 1) : 0.f, hn = pos < n - 1 ? hval(row + 1) : 0.f;
  const float ref = hc + (0.5f * (hp + hn) - hc) * p.in[16][m * 1024 + col];
  rep(p, id, b2f(((const bf16_t*)(ws_ + OFF_XM))[(size_t)m * SZ_ACT + (size_t)row * 1024 + col]), ref, 0.3f);
}
__device__ __forceinline__ void chk_rw1(const Params& p, int id0) {
  PH_BEGIN
  const int s = GID; if (s >= 512) return;
  const int row = hsh(s * 2 + id0 * 7919) % 6144, col = hsh(s * 2 + 1 + id0 * 7919) & 1023;
  const bf16_t* XM = (const bf16_t*)(ws_ + OFF_XM);
  rep(p, id0 + 0, ((const float*)(ws_ + OFF_R))[(size_t)row * 1024 + col], dotA(XM + 0 * SZ_ACT + (size_t)row * 1024, p.in[17] + col, 1024, 1024), 0.3f);
  rep(p, id0 + 1, ((const float*)(ws_ + OFF_K))[(size_t)row * 1024 + col], dotA(XM + 2 * SZ_ACT + (size_t)row * 1024, p.in[18] + col, 1024, 1024), 0.3f);
  rep(p, id0 + 2, ((const float*)(ws_ + OFF_V))[(size_t)row * 1024 + col], dotA(XM + 3 * SZ_ACT + (size_t)row * 1024, p.in[19] + col, 1024, 1024), 0.3f);
  const int lc = col % 384; float lr;
  if (lc < 128) lr = tanhf(dotA(XM + 1 * SZ_ACT + (size_t)row * 1024, p.in[22] + (size_t)(lc >> 6) * 1024 * 64 + (lc & 63), 64, 1024));
  else if (lc < 256) lr = dotA(XM + 4 * SZ_ACT + (size_t)row * 1024, p.in[25] + (size_t)((lc - 128) >> 6) * 1024 * 64 + (lc & 63), 64, 1024);
  else { lr = dotA(XM + 5 * SZ_ACT + (size_t)row * 1024, p.in[27] + (lc - 256), 128, 1024); lr = 1.f / (1.f + expf(-lr)); }
  rep(p, id0 + 3, b2f(((const bf16_t*)(ws_ + OFF_LB))[(size_t)row * 384 + lc]), lr, 0.2f);
  const float* Kb = (const float*)(ws_ + OFF_K) + (size_t)row * 1024 + (col & ~63);
  float ss = 0.f; for (int c = 0; c < 64; ++c) { const float v = Kb[c] * p.in[29][(col & ~63) + c]; ss += v * v; }
  rep(p, id0 + 4, ((const float*)(ws_ + OFF_KK))[(size_t)row * 1024 + col], Kb[col & 63] * p.in[29][col] / sqrtf(ss + 1e-12f), 0.03f);
}
__device__ __forceinline__ void chk_rw2(const Params& p, int id0) {
  PH_BEGIN
  const int s = GID; if (s >= 512) return;
  const int row = hsh(s * 2 + id0 * 7919) % 6144, col = hsh(s * 2 + 1 + id0 * 7919) & 1023, d = s & 1;
  const bf16_t* LB = (const bf16_t*)(ws_ + OFF_LB) + (size_t)row * 384;
  const size_t idx = (size_t)row * 1024 + col;
  const float z = p.in[21][d * 1024 + col] + dotA(LB + d * 64, p.in[23] + (size_t)d * 64 * 1024 + col, 1024, 64);
  const float logw = -log1pf(expf(-z)) - 0.5f;
  rep(p, id0 + 0, ((const float*)(ws_ + OFF_WDEC))[(size_t)d * SZ_ACT + idx], expf(-expf(logw)), 0.2f);
  const float a = 1.f / (1.f + expf(-(p.in[24][d * 1024 + col] + dotA(LB + 128 + d * 64, p.in[26] + (size_t)d * 64 * 1024 + col, 1024, 64))));
  const float kv = ((const float*)(ws_ + OFF_K))[idx], kkv = ((const float*)(ws_ + OFF_KK))[idx];
  rep(p, id0 + 1, b2f(((const bf16_t*)(ws_ + OFF_KEFF))[(size_t)d * SZ_ACT + idx]), kv * (1.f + (a - 1.f) * p.in[30][col]), 0.3f);
  rep(p, id0 + 2, b2f(((const bf16_t*)(ws_ + OFF_NB))[(size_t)d * SZ_ACT + idx]), -kkv * a, 0.02f);
  rep(p, id0 + 3, ((const float*)(ws_ + OFF_G))[idx], dotA(LB + 256, p.in[28] + col, 1024, 128), 0.2f);
}
__device__ __forceinline__ void chk_scan(const Params& p, int id0) {
  PH_BEGIN
  const int s = GID; if (s >= 64) return;
  const int item = s < 8 ? s * 7 : 64 + (hsh(s) % 512), v = hsh(s + 77) & 63;
  int n, tok0, h, dir; const float* sinit = nullptr; const float* sfin = nullptr;
  if (item < 64) { const int s2 = item >> 5; h = (item >> 1) & 15; dir = item & 1; n = 1024; tok0 = 4096 + s2 * 1024; sinit = p.in[2] + (size_t)((s2 * 2 + dir) * 16 + h) * 4096; }
  else { const int j = item - 64, sq = j >> 5; h = (j >> 1) & 15; dir = j & 1; n = 256; tok0 = sq * 256; sfin = p.out + OUT_STATE + (size_t)((sq * 2 + dir) * 16 + h) * 4096; }
  const float* R = (const float*)(ws_ + OFF_R); const float* V = (const float*)(ws_ + OFF_V); const float* KK = (const float*)(ws_ + OFF_KK);
  const float* WD = (const float*)(ws_ + OFF_WDEC) + (size_t)dir * SZ_ACT;
  const bf16_t* KE = (const bf16_t*)(ws_ + OFF_KEFF) + (size_t)dir * SZ_ACT; const bf16_t* NB = (const bf16_t*)(ws_ + OFF_NB) + (size_t)dir * SZ_ACT;
  const float* Y = (const float*)(ws_ + (dir ? OFF_Y1 : OFF_Y0));
  float S[64];
#pragma unroll
  for (int k = 0; k < 64; ++k) S[k] = sinit ? sinit[v * 64 + k] : 0.f;
  for (int tt = 0; tt < n; ++tt) {
    const int t = dir ? n - 1 - tt : tt; const size_t b = (size_t)(tok0 + t) * 1024 + h * 64;
    float sa = 0.f;
#pragma unroll
    for (int k = 0; k < 64; ++k) sa += S[k] * KK[b + k];
    const float vv = V[b + v]; float y = 0.f;
#pragma unroll
    for (int k = 0; k < 64; ++k) { S[k] = S[k] * WD[b + k] + sa * b2f(NB[b + k]) + vv * b2f(KE[b + k]); y += S[k] * R[b + k]; }
    rep(p, id0, Y[b + v], y, 0.05f);
  }
  if (sfin) {
#pragma unroll
    for (int k = 0; k < 64; ++k) rep(p, id0 + 1, sfin[v * 64 + k], S[k], 0.05f);
  }
}
__device__ __forceinline__ void chk_z(const Params& p, int id) {
  PH_BEGIN
  const int s = GID; if (s >= 512) return;
  const int row = hsh(s * 2 + id * 7919) % 6144, col = hsh(s * 2 + 1 + id * 7919) & 1023, hb = col & ~63;
  const size_t b = (size_t)row * 1024 + hb;
  const float* Y0 = (const float*)(ws_ + OFF_Y0); const float* Y1 = (const float*)(ws_ + OFF_Y1); const float* R = (const float*)(ws_ + OFF_R);
  const bf16_t* KE = (const bf16_t*)(ws_ + OFF_KEFF);
  float mean = 0.f, bon = 0.f;
  for (int c = 0; c < 64; ++c) { mean += Y0[b + c] + Y1[b + c]; bon += R[b + c] * (b2f(KE[b + c]) + b2f(KE[SZ_ACT + b + c])) * p.in[31][hb + c]; }
  mean /= 64.f; float var = 0.f;
  for (int c = 0; c < 64; ++c) { const float d = Y0[b + c] + Y1[b + c] - mean; var += d * d; }
  var /= 64.f;
  const size_t i = (size_t)row * 1024 + col;
  const float ref = ((Y0[i] + Y1[i] - mean) / sqrtf(var + 64e-5f) * p.in[32][col] + p.in[33][col] + bon * ((const float*)(ws_ + OFF_V))[i]) * ((const float*)(ws_ + OFF_G))[i];
  rep(p, id, b2f(((const bf16_t*)(ws_ + OFF_H))[i]), ref, 0.2f);
}
__device__ __forceinline__ void chk_qc(const Params& p, int id) {
  PH_BEGIN
  const int s = GID; if (s >= 512) return;
  const int row = hsh(s * 2 + id * 7919) % 6144, col = hsh(s * 2 + 1 + id * 7919) % 704;
  const bf16_t* a = (const bf16_t*)(ws_ + OFF_H) + (size_t)row * 1024;
  const float ref = col < 384 ? dotA(a, p.in[34] + col, 384, 1024) : dotA(a, p.in[37] + (col - 384), 320, 1024);
  rep(p, id, ((const float*)(ws_ + OFF_QC))[(size_t)row * 704 + col], ref, 0.3f);
}
__device__ __forceinline__ float rope_ref(float x, float partner, int r  , int pp) {
  const int ax = r >> 5, part = (r >> 4) & 1, i = r & 15;
  const float ang = (ax ? (float)(pp & 63) : (float)(pp >> 6)) * powf(10000.f, -(float)i / 16.f);
  return part == 0 ? x * cosf(ang) - partner * sinf(ang) : partner * sinf(ang) + x * cosf(ang);
}
__device__ __forceinline__ void chk_mlarows(const Params& p, int id0) {
  PH_BEGIN
  const int s = GID; if (s >= 512) return;
  const int row = hsh(s * 2 + id0 * 7919) % 6144, c0 = hsh(s * 2 + 1 + id0 * 7919);
  const float* q = (const float*)(ws_ + OFF_QC) + (size_t)row * 704;
  float ss = 0.f; for (int k = 0; k < 384; ++k) ss += q[k] * q[k];
  int col = c0 % 384;
  rep(p, id0, b2f(((const bf16_t*)(ws_ + OFF_QN))[(size_t)row * 384 + col]), q[col] / sqrtf(ss / 384.f + 1e-6f) * p.in[35][col], 0.3f);
  ss = 0.f; for (int k = 0; k < 256; ++k) ss += q[384 + k] * q[384 + k];
  col = c0 & 255;
  const float cr = q[384 + col] / sqrtf(ss / 256.f + 1e-6f) * p.in[38][col];
  rep(p, id0 + 1, b2f(((const bf16_t*)(ws_ + OFF_CKVALL))[(size_t)key_row(row) * 256 + col]), cr, 0.3f);
  if (row < 4096) rep(p, id0 + 1, p.out[OUT_CKV + (size_t)row * 256 + col], cr, 0.3f);
  col = c0 & 63;
  float kr = q[640 + col];
  if (row >= 4096) kr = rope_ref(kr, q[640 + (col ^ 16)], col, (row - 4096) & 1023);
  else rep(p, id0 + 2, p.out[OUT_KROPE + (size_t)row * 64 + col], kr, 0.3f);
  rep(p, id0 + 2, b2f(((const bf16_t*)(ws_ + OFF_KRALL))[(size_t)key_row(row) * 64 + col]), kr, 0.3f);
}
__device__ __forceinline__ void chk_up(const Params& p, int id0) {
  PH_BEGIN
  const int s = GID; if (s >= 512) return;
  const int row = hsh(s * 2 + id0 * 7919) % 6144, c0 = hsh(s * 2 + 1 + id0 * 7919);
  const float qs = 0.07216878364870323f * 1.4426950408889634f;
  int col = c0 % 1536;
  const bf16_t* qn = (const bf16_t*)(ws_ + OFF_QN) + (size_t)row * 384;
  float d = dotA(qn, p.in[36] + col, 1536, 384) * qs;
  const int r = col % 192 - 128;
  if (r >= 0 && row >= 4096) d = rope_ref(d, dotA(qn, p.in[36] + (col ^ 16), 1536, 384) * qs, r, (row - 4096) & 1023);
  rep(p, id0, b2f(((const bf16_t*)(ws_ + OFF_Q))[(size_t)row * 1536 + col]), d, 0.03f);
  const int kr = hsh(s + 1234567) % 6656; col = c0 & 1023;
  const bf16_t* ck = (const bf16_t*)(ws_ + OFF_CKVALL) + (size_t)kr * 256;
  rep(p, id0 + 1, b2f(((const bf16_t*)(ws_ + OFF_KN))[(size_t)kr * 1024 + col]), dotA(ck, p.in[39] + col, 1024, 256), 0.3f);
  const bf16_t* VT = (const bf16_t*)(ws_ + OFF_VT);
  size_t vi;
  if (kr < 4096) vi = (size_t)(kr >> 8) * 262144 + (size_t)col * 256 + (kr & 255);
  else { const int rr = kr - 4096, s2 = rr / 1280; vi = 4194304 + (size_t)s2 * 1310720 + (size_t)col * 1280 + (rr - s2 * 1280); }
  rep(p, id0 + 2, b2f(VT[vi]), dotA(ck, p.in[40] + col, 1024, 256), 0.3f);
}
__device__ __forceinline__ void chk_attn(const Params& p, int id) {
  PH_BEGIN
  const int s = GID; if (s >= 128) return;
  const int row = hsh(s * 2 + id * 7919) % 6144, c0 = hsh(s * 2 + 1 + id * 7919), h = c0 & 7, dv = (c0 >> 3) & 127;
  int kb, nk; const bf16_t* vt;
  const bf16_t* VT = (const bf16_t*)(ws_ + OFF_VT);
  if (row < 4096) { kb = row & ~255; nk = 256; vt = VT + (size_t)(row >> 8) * 262144 + (size_t)(h * 128 + dv) * 256; }
  else { const int s2 = (row - 4096) >> 10; kb = 4096 + s2 * 1280; nk = 1280; vt = VT + 4194304 + (size_t)s2 * 1310720 + (size_t)(h * 128 + dv) * 1280; }
  const bf16_t* q = (const bf16_t*)(ws_ + OFF_Q) + (size_t)row * 1536 + h * 192;
  const bf16_t* KN = (const bf16_t*)(ws_ + OFF_KN); const bf16_t* KR = (const bf16_t*)(ws_ + OFF_KRALL);
  float m = -1e30f, l = 0.f, o = 0.f;
  for (int j = 0; j < nk; ++j) {
    float sc = 0.f;
    for (int d = 0; d < 128; ++d) sc += b2f(q[d]) * b2f(KN[(size_t)(kb + j) * 1024 + h * 128 + d]);
    for (int d = 0; d < 64; ++d) sc += b2f(q[128 + d]) * b2f(KR[(size_t)(kb + j) * 64 + d]);
    const float mn = fmaxf(m, sc), al = exp2f(m - mn), pj = exp2f(sc - mn);
    l = l * al + pj; o = o * al + pj * b2f(vt[j]); m = mn;
  }
  rep(p, id, b2f(((const bf16_t*)(ws_ + OFF_H))[(size_t)row * 1024 + h * 128 + dv]), o / l, 0.03f);
}
__device__ __forceinline__ void chk_yt(const Params& p, int id) {
  PH_BEGIN
  const int s = GID; if (s >= 512) return;
  const int row = hsh(s * 2 + id * 7919) % 6144, col = hsh(s * 2 + 1 + id * 7919) & 1023, half = s & 1;
  const int s0 = seq_start(row), n = seq_len(row), pos = row - s0, g = col >> 7, cp = col & 127;
  const bf16_t* H = (const bf16_t*)(ws_ + OFF_H);
  float acc = 0.f;
  for (int c = 0; c < 128; ++c) { const float b = (float)((c * cp) & 127) / 128.f; acc += b2f(H[(size_t)row * 1024 + g * 128 + c]) * (half ? sinf(6.283185307179586f * b) : cosf(6.283185307179586f * b)); }
  const bf16_t* YT = (const bf16_t*)(ws_ + OFF_YT);
  const bf16_t* base = row < 4096 ? YT + (size_t)(row >> 8) * (1024 * 512) : YT + (size_t)16 * 1024 * 512 + (size_t)((row - 4096) >> 10) * (1024 * 2048);
  rep(p, id, b2f(base[(size_t)col * (2 * n) + half * n + pos]), acc / sqrtf(128.f), 0.3f);
}
__device__ __forceinline__ void chk_tab(const Params& p) {
  PH_BEGIN
  const int s = GID; if (s >= 2048) return;
  const unsigned hh = hsh(s * 3 + 11);
  { const int np = hh & 255, c = (hh >> 8) & 127, half = np >> 7, cp = np & 127; const float b = (float)((c * cp) & 127) / 128.f * 6.283185307179586f;
    rep(p, 45, b2f(((const bf16_t*)(ws_ + OFF_DFTC))[np * 128 + c]), (half ? sinf(b) : cosf(b)) / sqrtf(128.f), 0.02f); }
  { const int np = hh & 255, c = (hh >> 8) & 511, half = c >> 8, pos = c & 255; const float b = (float)((pos * np) & 255) / 256.f * 6.283185307179586f;
    rep(p, 46, b2f(((const bf16_t*)(ws_ + OFF_DFTP256))[np * 512 + c]), (half ? -sinf(b) : cosf(b)) / 16.f, 0.01f); }
  { const int np = hh & 1023, c = (hh >> 10) & 2047, half = c >> 10, pos = c & 1023; const float b = (float)((pos * np) & 1023) / 1024.f * 6.283185307179586f;
    rep(p, 47, b2f(((const bf16_t*)(ws_ + OFF_DFTP1024))[np * 2048 + c]), (half ? -sinf(b) : cosf(b)) / 32.f, 0.005f); }
}
#ifndef CHKMASK
#define CHKMASK 0x7F
#endif
#define CHK(grp, call) do { if (CHKMASK & (1 << (grp))) { call; GSYNC(); } } while (0)
#else
#define CHK(grp, call) do { } while (0)
#endif

__device__ __forceinline__ void phase_attn_blk(const Params& p, char* lds, int cidx = 1) {
  PH_BEGIN
  const int tid = tid_, lane = tid & 63, wid = tid >> 6, l15 = lane & 15, quad = lane >> 4;
  unsigned* ctr = (unsigned*)(ws_ + OFF_CTR) + cidx;
  const bf16_t* Q = (const bf16_t*)(ws_ + OFF_Q); const bf16_t* KN = (const bf16_t*)(ws_ + OFF_KN);
  const bf16_t* KR = (const bf16_t*)(ws_ + OFF_KRALL); const bf16_t* VT = (const bf16_t*)(ws_ + OFF_VT);
  bf16_t* OA = (bf16_t*)(ws_ + OFF_H);
  volatile int& s_item = *(volatile int*)(lds + 57344);
  for (;;) {
    if (tid == 0) s_item = (int)atomicAdd(ctr, 1u);
    __syncthreads();
    const int item = s_item;
    __syncthreads();
    if (item >= 768) break;
    int h, qrow0, nkeys, keybase;
    if (item < 256) { const int s2 = item >> 7; h = (item >> 4) & 7; qrow0 = 4096 + s2 * 1024 + (item & 15) * 64 + wid * 16; nkeys = 1280; keybase = 4096 + s2 * 1280; }
    else { const int j = item - 256, sq = j >> 5; h = (j >> 2) & 7; qrow0 = sq * 256 + (j & 3) * 64 + wid * 16; nkeys = 256; keybase = sq * 256; }
    bf16x8 qf[6];
#pragma unroll
    for (int ks = 0; ks < 6; ++ks) qf[ks] = *(const bf16x8*)(Q + (size_t)(qrow0 + l15) * 1536 + h * 192 + ks * 32 + quad * 8);
    f32x4 oacc[8];
#pragma unroll
    for (int i = 0; i < 8; ++i) oacc[i] = (f32x4){0.f, 0.f, 0.f, 0.f};
    float m = -1e30f, lsum = 0.f;
    const bf16_t* knp = KN + ((size_t)((keybase >> 4) * 8 + h) * 4 * 64 + lane) * 8;
    const bf16_t* krp = KR + ((size_t)((keybase >> 4) * 2) * 64 + lane) * 8;
    const bf16_t* vpp = VT + ((size_t)((keybase >> 5) * 8 + h) * 8 * 64 + lane) * 8;
    const bf16_t* pk0; const bf16_t* pk1; const bf16_t* pk2; int sk0, sk1, sk2;
    { const int pc = wid, kt = pc / 6, ks = pc - kt * 6; if (ks < 4) { pk0 = knp + (size_t)(kt * 32 + ks) * 512; sk0 = 64 * 512; } else { pk0 = krp + (size_t)(kt * 2 + ks - 4) * 512; sk0 = 4 * 512; } }
    { const int pc = wid + 4, kt = pc / 6, ks = pc - kt * 6; if (ks < 4) { pk1 = knp + (size_t)(kt * 32 + ks) * 512; sk1 = 64 * 512; } else { pk1 = krp + (size_t)(kt * 2 + ks - 4) * 512; sk1 = 4 * 512; } }
    { const int pc = wid + 8, kt = pc / 6, ks = pc - kt * 6; if (ks < 4) { pk2 = knp + (size_t)(kt * 32 + ks) * 512; sk2 = 64 * 512; } else { pk2 = krp + (size_t)(kt * 2 + ks - 4) * 512; sk2 = 4 * 512; } }
    const bf16_t* pv0 = vpp + (size_t)wid * 512; const bf16_t* pv1 = vpp + (size_t)(wid + 4) * 512;
    uint4 sa_, sb_, sc_, sd_, se_;
#define AB_GLOAD(c_) do { const size_t cc_ = (size_t)((c_) >> 5); sa_ = *(const uint4*)(pk0 + cc_ * sk0); sb_ = *(const uint4*)(pk1 + cc_ * sk1); sc_ = *(const uint4*)(pk2 + cc_ * sk2); \
      sd_ = *(const uint4*)(pv0 + cc_ * (64 * 512)); se_ = *(const uint4*)(pv1 + cc_ * (64 * 512)); } while (0)
#define AB_LSTORE(buf_) do { char* lb_ = lds + (buf_) * 20480 + lane * 16; *(uint4*)(lb_ + wid * 1024) = sa_; *(uint4*)(lb_ + (wid + 4) * 1024) = sb_; *(uint4*)(lb_ + (wid + 8) * 1024) = sc_; \
      *(uint4*)(lb_ + (wid + 12) * 1024) = sd_; *(uint4*)(lb_ + (wid + 16) * 1024) = se_; } while (0)
    AB_GLOAD(0); AB_LSTORE(0);
    __syncthreads();
    for (int c = 0; c < nkeys; c += 32) {
      const int buf = (c >> 5) & 1;
      if (c + 32 < nkeys) AB_GLOAD(c + 32);
      const char* cb = lds + buf * 20480 + lane * 16;
      f32x4 st[2];
      __builtin_amdgcn_s_setprio(1);
#pragma unroll
      for (int kt = 0; kt < 2; ++kt) {
        st[kt] = (f32x4){0.f, 0.f, 0.f, 0.f};
#pragma unroll
        for (int ks = 0; ks < 6; ++ks) st[kt] = __builtin_amdgcn_mfma_f32_16x16x32_bf16(*(const bf16x8*)(cb + (kt * 6 + ks) * 1024), qf[ks], st[kt], 0, 0, 0);
      }
      __builtin_amdgcn_s_setprio(0);
      float cm = fmaxf(fmaxf(fmaxf(st[0][0], st[0][1]), fmaxf(st[0][2], st[0][3])), fmaxf(fmaxf(st[1][0], st[1][1]), fmaxf(st[1][2], st[1][3])));
      cm = fmaxf(cm, __shfl_xor(cm, 16)); cm = fmaxf(cm, __shfl_xor(cm, 32));
      const float mn = fmaxf(m, cm), alpha = exp2f(m - mn);
      m = mn;
      float pv[8], ps = 0.f;
#pragma unroll
      for (int e = 0; e < 8; ++e) { pv[e] = exp2f(st[e >> 2][e & 3] - mn); ps += pv[e]; }
      lsum = lsum * alpha + ps;
      union { bf16x8 v; unsigned u[4]; } pb;
      pb.u[0] = pack2(pv[0], pv[1]); pb.u[1] = pack2(pv[2], pv[3]); pb.u[2] = pack2(pv[4], pv[5]); pb.u[3] = pack2(pv[6], pv[7]);
#pragma unroll
      for (int dvt = 0; dvt < 8; ++dvt) oacc[dvt] = __builtin_amdgcn_mfma_f32_16x16x32_bf16(*(const bf16x8*)(cb + (12 + dvt) * 1024), pb.v, oacc[dvt] * alpha, 0, 0, 0);
      if (c + 32 < nkeys) AB_LSTORE(buf ^ 1);
      __syncthreads();
    }
    lsum += __shfl_xor(lsum, 16); lsum += __shfl_xor(lsum, 32);
    const float il = 1.f / lsum;
#pragma unroll
    for (int dvt = 0; dvt < 8; ++dvt) {
      const f32x4 o = oacc[dvt] * il;
      *(uint2*)(OA + (size_t)(qrow0 + l15) * 1024 + h * 128 + dvt * 16 + quad * 4) = make_uint2(pack2(o[0], o[1]), pack2(o[2], o[3]));
    }
  }
}

#define XB_TMO      128
#define XB_XCNT(j)  (256  + 64 * (j))
#define XB_XSUB(j)  (1280 + 64 * (j))
#define XB_XGEN(j)  (2304 + 64 * (j))
#define XB_TOP      3328
#define XB_TOPGEN   3392
#define XCD_BAR_WORDS 3456
#define XB_SPIN_CAP (1u << 20)
#define LAS __attribute__((address_space(3)))
__device__ __forceinline__ unsigned xb_ld(unsigned* p)              { return __hip_atomic_load(p, __ATOMIC_RELAXED, __HIP_MEMORY_SCOPE_AGENT); }
__device__ __forceinline__ unsigned xb_add(unsigned* p, unsigned v) { return __hip_atomic_fetch_add(p, v, __ATOMIC_RELAXED, __HIP_MEMORY_SCOPE_AGENT); }
__device__ __forceinline__ unsigned xb_xcc_id() { return (unsigned)__builtin_amdgcn_s_getreg((3 << 11) | 20) & 0xFu; }
#define XB_SPIN(cond, bar) do { unsigned _sp = 0; while (cond) { __builtin_amdgcn_s_sleep(1); \
    if ((++_sp & 255u) == 0u) { if (xb_ld(&(bar)[XB_TMO])) break; if (_sp > XB_SPIN_CAP) { atomicAdd(&(bar)[XB_TMO], 1u); break; } } } } while (0)
struct XcdBarrier { unsigned* bar; unsigned x; volatile LAS unsigned* st; };
__device__ __forceinline__ XcdBarrier xcd_barrier_post(unsigned* bar, volatile LAS unsigned* st) {
    XcdBarrier b; b.bar = bar; b.x = xb_xcc_id(); b.st = st;
    if (threadIdx.x == 0) (void)xb_add(&bar[XB_XCNT(b.x)], 1u);
    return b;
}
__device__ __forceinline__ void xcd_barrier_complete(unsigned* bar, unsigned x, unsigned& nloc, unsigned& nx) {
    const unsigned G = gridDim.x * gridDim.y * gridDim.z;
    unsigned sum, cnt, mine, sp = 0u;
    for (;;) {
        sum = 0u; cnt = 0u; mine = 0u;
#pragma unroll
        for (unsigned j = 0; j < 16; ++j) { const unsigned c = xb_ld(&bar[XB_XCNT(j)]); sum += c; cnt += (c > 0u) ? 1u : 0u; mine = (j == x) ? c : mine; }
        if (sum == G) break;
        __builtin_amdgcn_s_sleep(1);
        if ((++sp & 255u) == 0u) { if (xb_ld(&bar[XB_TMO])) break; if (sp > XB_SPIN_CAP) { atomicAdd(&bar[XB_TMO], 1u); break; } }
    }
    nloc = mine > 0u ? mine : 1u; nx = cnt > 0u ? cnt : 1u;
}
__device__ __forceinline__ void xcd_barrier(const XcdBarrier& b) {
    asm volatile("s_waitcnt vmcnt(0)" ::: "memory");
    __syncthreads();
    if (threadIdx.x == 0) {
        unsigned* bar = b.bar;
        __builtin_amdgcn_s_waitcnt(0);
        unsigned nloc = b.st[0], nx = b.st[1];
        if (nloc == 0u) { xcd_barrier_complete(bar, b.x, nloc, nx); b.st[0] = nloc; b.st[1] = nx; }
        const unsigned old = xb_add(&bar[XB_XSUB(b.x)], 1u);
        const unsigned gen = old / nloc;
        if (old + 1u == (gen + 1u) * nloc) {
            __builtin_amdgcn_fence(__ATOMIC_RELEASE, "agent");
            asm volatile("s_waitcnt vmcnt(0)" ::: "memory");
            const unsigned og = xb_add(&bar[XB_TOP], 1u);
            const unsigned tg = og / nx;
            if (og + 1u == (tg + 1u) * nx) xb_add(&bar[XB_TOPGEN], 1u);
            else XB_SPIN(xb_ld(&bar[XB_TOPGEN]) == tg, bar);
            __builtin_amdgcn_fence(__ATOMIC_ACQUIRE, "agent");
            xb_add(&bar[XB_XGEN(b.x)], 1u);
            asm volatile("s_waitcnt vmcnt(0)" ::: "memory");
        } else {
            XB_SPIN(xb_ld(&bar[XB_XGEN(b.x)]) == gen, bar);
            __builtin_amdgcn_fence(__ATOMIC_ACQUIRE, "agent");
            asm volatile("s_waitcnt vmcnt(0)" ::: "memory");
        }
    }
    __syncthreads();
}

#ifndef PH_LO
#define PH_LO 0
#endif
#ifndef PH_HI
#define PH_HI 1000
#endif
__global__ void __launch_bounds__(256, 2) mega(Params p) {
  __shared__ __attribute__((aligned(16))) char lds[65536];
  cg::grid_group grid = cg::this_grid();
  __shared__ uint4 xb_words;
  if (threadIdx.x == 0) xb_words = make_uint4(0u, 0u, 0u, 0u);
  __syncthreads();
  const XcdBarrier xb = xcd_barrier_post((unsigned*)(p.ws + OFF_BAR), (volatile LAS unsigned*)&xb_words);
  if (p.out == nullptr) grid.sync();
#define GSYNC() xcd_barrier(xb)
#ifdef CLKPROBE
  unsigned long long ck0 = __builtin_readcyclecounter(), rt0 = wall_clock64();
#endif
  char* ws = p.ws;
  bf16_t* H = (bf16_t*)(ws + OFF_H);
  float* O = (float*)(ws + OFF_O);
  bf16_t* HID = (bf16_t*)(ws + OFF_HID);
#define DUPMASK 0
#define REP(bit, call) do { call; GSYNC(); if (DUPMASK & (bit)) { call; GSYNC(); } } while (0)
#define REP2(bit, call, call2) do { call; GSYNC(); if (DUPMASK & (bit)) { call2; GSYNC(); } } while (0)
#ifdef CLKPROBE
  phase_prep_a(p, lds); GSYNC();
  const unsigned long long rtA = wall_clock64();
  phase_prep_b(p, lds); GSYNC();
  const unsigned long long rtB = wall_clock64();
#else
  phase_prep_a(p, lds);
  REP(1, phase_prep_b(p, lds));
#endif
  CHK(0, chk_modv(p));
  CHK(0, chk_tab(p));
  REP(32, phase_row(p, true, false, 0, 0, 0, true, 0, 0, 0, true));
  CHK(0, chk_h(p, 1, 0, 0, 0));
  if (DUPMASK & 64) { for (int i = 0; i < 35; ++i) GSYNC(); }
#pragma unroll
  for (int l = 0; l < 4; ++l) {
    if (l == 0) {
      REP(4, phase_chan_dft(p, lds));
      CHK(1, chk_yt(p, 44));
      REP(4, phase_pos_dft(p, lds));
      CHK(1, chk_fft(p, 2));
      REP(4, phase_gemm_f32_m96((const bf16_t*)(ws + OFF_F), 1024, (const bf16_t*)(ws + OFF_FFTWT), 1024, 1024, O, lds));
      CHK(2, chk_o(p, 3, (const bf16_t*)(ws + OFF_F), 1024, p.in[12]));
    } else if (l == 1) {
      REP(4, phase_gemm_bf16_m96(H, 1024, (const bf16_t*)(ws + OFF_CINT), 1024, 1024, 24, (bf16_t*)(ws + OFF_BCU), 3072, lds));
      CHK(3, chk_bcu(p, 8));
      REP(32, phase_conv_elt(p));
      CHK(3, chk_a2(p, 9));
      REP(4, phase_gemm_f32_m96((const bf16_t*)(ws + OFF_A2), 1024, (const bf16_t*)(ws + OFF_COUTT), 1024, 1024, O, lds));
      CHK(2, chk_o(p, 10, (const bf16_t*)(ws + OFF_A2), 1024, p.in[15]));
    } else if (l == 2) {
      REP(32, phase_rwkv_mix(p));
      CHK(4, chk_xm(p, 14));
      REP(4, phase_rwkv_gemm1(p, lds));
      CHK(4, chk_rw1(p, 15));
      REP(4, phase_rwkv_gemm2(p, lds));
      CHK(4, chk_rw2(p, 20));
      REP2(8, phase_scan(p, lds, 0), phase_scan(p, lds, 2));
      CHK(5, chk_scan(p, 24));
      REP(32, phase_postscan(p));
      CHK(6, chk_z(p, 26));
      REP(4, phase_gemm_f32_m96(H, 1024, (const bf16_t*)(ws + OFF_RWOT), 1024, 1024, O, lds));
      CHK(2, chk_o(p, 27, H, 1024, p.in[20]));
    } else {
      REP(4, phase_gemm_f32(H, 1024, (const bf16_t*)(ws + OFF_MDQKVT), 1024, 1024, 48, 6, (float*)(ws + OFF_QC), 704, 704, lds));
      CHK(7, chk_qc(p, 32));
      REP(32, phase_mla_rows(p));
      CHK(7, chk_mlarows(p, 33));
      REP(4, phase_mla_up(p, lds));
      CHK(7, chk_up(p, 36));
      REP2(16, phase_attn_blk(p, lds, 1), phase_attn_blk(p, lds, 3));
      CHK(8, chk_attn(p, 39));
      REP(4, phase_gemm_f32_m96(H, 1024, (const bf16_t*)(ws + OFF_MOT), 1024, 1024, O, lds));
      CHK(2, chk_o(p, 40, H, 1024, p.in[41]));
    }
    REP2(32, phase_row(p, l == 0, DBG_MIXER_UPD, l, 2, 1, true, l, 2, 3), phase_row(p, false, false, l, 2, 1, true, l, 2, 3));
    CHK(0, chk_h(p, l == 0 ? 4 : (l == 1 ? 11 : (l == 2 ? 28 : 41)), l, 2, 3));
    REP(2, phase_gemm_bf16<1>(H, 1024, (const bf16_t*)(ws + OFF_W1T) + (size_t)l * 4096 * 1024, 1024, 1024, 48, 32, HID, 4096, lds));
    CHK(2, chk_hid(p, l == 0 ? 5 : (l == 1 ? 12 : (l == 2 ? 29 : 42)), l));
    REP(2, phase_gemm_f32_m96(HID, 4096, (const bf16_t*)(ws + OFF_W2T) + (size_t)l * 4096 * 1024, 4096, 4096, O, lds));
    CHK(2, chk_o(p, l == 0 ? 6 : (l == 1 ? 13 : (l == 2 ? 30 : 43)), HID, 4096, p.in[11] + (size_t)l * 4096 * 1024));
    phase_row(p, false, true, l, 5, 3, l < 3 && l != 1, l + 1, 0, 0);
    if (l < 3) GSYNC();
    if (l == 0 || l == 2) CHK(0, chk_h(p, l == 0 ? 7 : 31, l + 1, 0, 0));
  }
#ifdef CLKPROBE
  GSYNC();
  if (blockIdx.x == 0 && threadIdx.x == 0) { const unsigned long long ck1 = __builtin_readcyclecounter(), rt1 = wall_clock64(); p.out[0] += (float)(rtB - rtA) * 0.001f; (void)ck1; (void)rt1; (void)ck0; (void)rt0; }
#endif
#ifdef SELFCHECK
  GSYNC();
  for (size_t i = (size_t)blockIdx.x * 256 + threadIdx.x; i < 9699328; i += (size_t)gridDim.x * 256) { const float v = p.out[i]; if (!(fabsf(v) < 1e30f)) p.out[i] = 0.f; }
  GSYNC();
  if (blockIdx.x == 0 && threadIdx.x == 0) {
    const unsigned* errs = (const unsigned*)(ws + OFF_CTR) + 8;
    if (__uint_as_float(errs[45]) > SC_TOL) p.out[0] = 46000.f; else if (__uint_as_float(errs[46]) > SC_TOL) p.out[0] = 47000.f; else if (__uint_as_float(errs[47]) > SC_TOL) p.out[0] = 48000.f; else if (__uint_as_float(errs[44]) > SC_TOL) p.out[0] = 45000.f; else
    for (int id = 0; id < 48; ++id) if (!((SKIPMASK >> id) & 1ull) && __uint_as_float(errs[id]) > SC_TOL) { p.out[0] = 1000.f * (id + 1); break; }
  }
#endif
}

extern "C" void kernel_launch(void* const* d_in, const int* in_sizes, int n_in, void* d_out, int out_size, void* d_ws, size_t ws_size, hipStream_t stream) {
  static int grid_blocks = 0;
  if (!grid_blocks) {
    int dev = 0, cus = 0, per_cu = 0;
    (void)hipGetDevice(&dev);
    (void)hipDeviceGetAttribute(&cus, hipDeviceAttributeMultiprocessorCount, dev);
    (void)hipOccupancyMaxActiveBlocksPerMultiprocessor(&per_cu, mega, 256, 0);
    if (per_cu > 2) per_cu = 2;
    if (per_cu < 1) per_cu = 1;
    grid_blocks = cus * per_cu;
  }
  if (ws_size < WS_TOTAL) { fprintf(stderr, "workspace too small: %zu < %zu\n", ws_size, (size_t)WS_TOTAL); return; }
  Params p{};
  for (int i = 0; i < 42; ++i) p.in[i] = (const float*)d_in[i];
  p.out = (float*)d_out; p.ws = (char*)d_ws;
  (void)hipMemsetAsync((char*)d_ws + OFF_CTR, 0, 256 + 3456 * 4 + 256, stream);
  void* args[] = {&p};
  hipError_t e = hipLaunchCooperativeKernel((void*)mega, dim3(grid_blocks), dim3(256), args, 0, stream);
  if (e != hipSuccess) fprintf(stderr, "cooperative launch failed: %s (grid %d)\n", hipGetErrorString(e), grid_blocks);
}
```

```cpp
#include <hip/hip_runtime.h>
#include <hip/hip_cooperative_groups.h>
#include <cstdio>
#include <cstdint>
namespace cg = cooperative_groups;

typedef unsigned short bf16_t;
typedef short bf16x8 __attribute__((ext_vector_type(8)));
typedef float f32x4 __attribute__((ext_vector_type(4)));
typedef float f32x2 __attribute__((ext_vector_type(2)));

struct Params { const float* in[42]; float* out; char* ws; };

constexpr size_t SZ_ACT = 6144ull * 1024ull;
constexpr size_t OFF_MOD = 0;
constexpr size_t OFF_CTR = OFF_MOD + 4 * 3 * 6144 * 4;
constexpr size_t OFF_BAR = OFF_CTR + 256;
constexpr size_t OFF_W1T = OFF_BAR + 3456 * 4 + 256;
constexpr size_t OFF_W2T = OFF_W1T + 4ull * 4096 * 1024 * 2;
constexpr size_t OFF_FFTWT = OFF_W2T + 4ull * 4096 * 1024 * 2;
constexpr size_t OFF_CINT = OFF_FFTWT + 1024 * 1024 * 2;
constexpr size_t OFF_COUTT = OFF_CINT + 3072 * 1024 * 2;
constexpr size_t OFF_RW1T = OFF_COUTT + 1024 * 1024 * 2;
constexpr size_t OFF_RWW2T = OFF_RW1T + 3456 * 1024 * 2;
constexpr size_t OFF_RWA2T = OFF_RWW2T + 2 * 1024 * 64 * 2;
constexpr size_t OFF_RWG2T = OFF_RWA2T + 2 * 1024 * 64 * 2;
constexpr size_t OFF_RWOT = OFF_RWG2T + 1024 * 128 * 2;
constexpr size_t OFF_MDQKVT = OFF_RWOT + 1024 * 1024 * 2;
constexpr size_t OFF_MUQT = OFF_MDQKVT + 768 * 1024 * 2;
constexpr size_t OFF_MUKT = OFF_MUQT + 1536 * 384 * 2;
constexpr size_t OFF_MUVT = OFF_MUKT + 1024 * 256 * 2;
constexpr size_t OFF_MOT = OFF_MUVT + 1024 * 256 * 2;
constexpr size_t OFF_DFTC = OFF_MOT + 1024 * 1024 * 2;
constexpr size_t OFF_DFTP256 = OFF_DFTC + 256 * 128 * 2;
constexpr size_t OFF_DFTP1024 = OFF_DFTP256 + 256 * 512 * 2;
constexpr size_t OFF_CKVALL = OFF_DFTP1024 + 1024 * 2048 * 2;
constexpr size_t OFF_KRALL = OFF_CKVALL + 6656 * 256 * 2;
constexpr size_t OFF_H = OFF_KRALL + 6656 * 64 * 2;
constexpr size_t OFF_O = OFF_H + SZ_ACT * 2;
constexpr size_t OFF_HID = OFF_O + SZ_ACT * 4;
constexpr size_t OFF_RA = OFF_HID + SZ_ACT * 8;
constexpr size_t OFF_RB = OFF_RA + SZ_ACT * 12;
constexpr size_t OFF_LB = OFF_RB + SZ_ACT * 16;
constexpr size_t OFF_MODP = OFF_LB + 6144ull * 384 * 2;
constexpr size_t WS_TOTAL = OFF_MODP + 4ull * 73728 * 4;
constexpr size_t OFF_YT = OFF_RA;
constexpr size_t OFF_F = OFF_RA + SZ_ACT * 4;
constexpr size_t OFF_BCU = OFF_RA;
constexpr size_t OFF_A2 = OFF_RA + SZ_ACT * 6;
constexpr size_t OFF_XM = OFF_RA;
constexpr size_t OFF_KEFF = OFF_RA;
constexpr size_t OFF_NB = OFF_RA + SZ_ACT * 4;
constexpr size_t OFF_G = OFF_RA + SZ_ACT * 8;
constexpr size_t OFF_QC = OFF_RA;
constexpr size_t OFF_QN = OFF_QC + 6144ull * 704 * 4;
constexpr size_t OFF_Q = OFF_QN + 6144ull * 384 * 2;
constexpr size_t OFF_KN = OFF_Q + 6144ull * 1536 * 2;
constexpr size_t OFF_VT = OFF_KN + 6656ull * 1024 * 2;
constexpr size_t OFF_R = OFF_RB;
constexpr size_t OFF_V = OFF_RB + SZ_ACT * 4;
constexpr size_t OFF_K = OFF_RB + SZ_ACT * 8;
constexpr size_t OFF_KK = OFF_RB + SZ_ACT * 12;
constexpr size_t OFF_Y0 = OFF_K;
constexpr size_t OFF_Y1 = OFF_O;
constexpr size_t OFF_WDEC = OFF_HID;
constexpr size_t OUT_STATE = 6291456, OUT_CKV = 8388608, OUT_KROPE = 9437184;

__device__ __forceinline__ unsigned short f2bf(float f) { unsigned u = __float_as_uint(f); u += 0x7fffu + ((u >> 16) & 1u); return (unsigned short)(u >> 16); }
typedef __bf16 bf16x2_t __attribute__((ext_vector_type(2)));
__device__ __forceinline__ unsigned pack2(float a, float b) { const f32x2 v = {a, b}; const bf16x2_t r = __builtin_convertvector(v, bf16x2_t); return __builtin_bit_cast(unsigned, r); }
__device__ __forceinline__ float bflo(unsigned u) { return __uint_as_float(u << 16); }
__device__ __forceinline__ float bfhi(unsigned u) { return __uint_as_float(u & 0xffff0000u); }
__device__ __forceinline__ float wave_sum(float v) {
#pragma unroll
  for (int o = 32; o > 0; o >>= 1) v += __shfl_xor(v, o);
  return v;
}
__device__ __forceinline__ float quad_sum(float v) {
  v += __int_as_float(__builtin_amdgcn_update_dpp(0, __float_as_int(v), 0xB1, 0xF, 0xF, true));
  v += __int_as_float(__builtin_amdgcn_update_dpp(0, __float_as_int(v), 0x4E, 0xF, 0xF, true));
  return v;
}
__device__ __forceinline__ float sigmoidf_(float x) { return 1.f / (1.f + __expf(-x)); }
__device__ __forceinline__ f32x4 ldmod(const float* mp, int off) { return (*(const f32x4*)(mp + off) + *(const f32x4*)(mp + 73728 + off)) + (*(const f32x4*)(mp + 2 * 73728 + off) + *(const f32x4*)(mp + 3 * 73728 + off)); }
__device__ __forceinline__ size_t krf_idx(int key, int d) { return ((size_t)((key >> 4) * 2 + (d >> 5)) * 64 + ((d & 31) >> 3) * 16 + (key & 15)) * 8 + (d & 7); }
__device__ __forceinline__ size_t knf_idx(int key, int col) { const int h = col >> 7, dd = col & 127; return ((size_t)(((key >> 4) * 8 + h) * 4 + (dd >> 5)) * 64 + ((dd & 31) >> 3) * 16 + (key & 15)) * 8 + (dd & 7); }
__device__ __forceinline__ size_t vf_idx(int key, int n) { const int h = n >> 7, dvt = (n >> 4) & 7, kk = key & 31; return ((size_t)(((key >> 5) * 8 + h) * 8 + dvt) * 64 + ((kk & 15) >> 2) * 16 + (n & 15)) * 8 + (kk >> 4) * 4 + (kk & 3); }
__device__ __forceinline__ int row_group(int row) { return row < 4096 ? 0 : 1 + ((row - 4096) >> 10); }

template <bool SWAP, int MI, bool PIPE2 = true, class Epi>
__device__ __forceinline__ void gemm_tile_mi(const bf16_t* __restrict__ A, int lda, const bf16_t* __restrict__ Bt, int ldb, int K, char* lds, Epi&& epi) {
  int tid = threadIdx.x; asm volatile("" : "+v"(tid));
  const int lane = tid & 63, wid = tid >> 6, wr = wid >> 1, wc = wid & 1;
  const int lrow = tid >> 3, lch = tid & 7;
  const bf16_t* ap = A + (size_t)lrow * lda + lch * 8;
  const bf16_t* bp = Bt + (size_t)lrow * ldb + lch * 8;
  const int soff = lrow * 128 + ((lch ^ ((lrow >> 1) & 7)) << 4);
  const int quad = lane >> 4, l15 = lane & 15, sw = l15 >> 1;
  const int aoff = (wr * (MI * 16) + l15) * 128, boff = 16384 + (wc * 64 + l15) * 128;
  f32x4 acc[MI][4];
#pragma unroll
  for (int i = 0; i < MI; ++i)
#pragma unroll
    for (int j = 0; j < 4; ++j) acc[i][j] = (f32x4){0.f, 0.f, 0.f, 0.f};
  uint4 xa0, xa1, xa2, xa3, xb0, xb1, xb2, xb3;
  uint4 ya0, ya1, ya2, ya3, yb0, yb1, yb2, yb3;
#define GT_LOAD(P, kt_) do { const bf16_t* _a = ap + (size_t)(kt_) * 64; const bf16_t* _b = bp + (size_t)(kt_) * 64; \
    P##a0 = *(const uint4*)(_a); P##a1 = *(const uint4*)(_a + (size_t)32 * lda); P##a2 = *(const uint4*)(_a + (size_t)64 * lda); if (MI == 4) P##a3 = *(const uint4*)(_a + (size_t)96 * lda); \
    P##b0 = *(const uint4*)(_b); P##b1 = *(const uint4*)(_b + (size_t)32 * ldb); P##b2 = *(const uint4*)(_b + (size_t)64 * ldb); P##b3 = *(const uint4*)(_b + (size_t)96 * ldb); } while (0)
#define GT_STORE(P, base) do { char* _s = (base) + soff; *(uint4*)(_s) = P##a0; *(uint4*)(_s + 4096) = P##a1; *(uint4*)(_s + 8192) = P##a2; if (MI == 4) *(uint4*)(_s + 12288) = P##a3; \
    *(uint4*)(_s + 16384) = P##b0; *(uint4*)(_s + 20480) = P##b1; *(uint4*)(_s + 24576) = P##b2; *(uint4*)(_s + 28672) = P##b3; } while (0)
#define GT_COMPUTE(cur) do { __builtin_amdgcn_s_setprio(1); _Pragma("unroll") for (int ks = 0; ks < 2; ++ks) { \
      const int ch = ((ks * 4 + quad) ^ sw) << 4; \
      bf16x8 af[MI], bfr[4]; \
      _Pragma("unroll") for (int mi = 0; mi < MI; ++mi) af[mi] = *(const bf16x8*)((cur) + aoff + mi * 2048 + ch); \
      _Pragma("unroll") for (int ni = 0; ni < 4; ++ni) bfr[ni] = *(const bf16x8*)((cur) + boff + ni * 2048 + ch); \
      _Pragma("unroll") for (int mi = 0; mi < MI; ++mi) \
        _Pragma("unroll") for (int ni = 0; ni < 4; ++ni) \
          acc[mi][ni] = SWAP ? __builtin_amdgcn_mfma_f32_16x16x32_bf16(bfr[ni], af[mi], acc[mi][ni], 0, 0, 0) \
                             : __builtin_amdgcn_mfma_f32_16x16x32_bf16(af[mi], bfr[ni], acc[mi][ni], 0, 0, 0); } __builtin_amdgcn_s_setprio(0); } while (0)
  const int nk = K >> 6;
  GT_LOAD(x, 0);
  if (!PIPE2) {
    GT_STORE(x, lds);
    __syncthreads();
    for (int kt = 0; kt < nk; ++kt) {
      const bool more = kt + 1 < nk;
      if (more) GT_LOAD(x, kt + 1);
      GT_COMPUTE(lds + (kt & 1) * 32768);
      if (more) GT_STORE(x, lds + ((kt + 1) & 1) * 32768);
      __syncthreads();
    }
  } else if (nk == 1) {
    GT_STORE(x, lds);
    __syncthreads();
    GT_COMPUTE(lds);
    __syncthreads();
  } else {
    GT_LOAD(y, 1);
    GT_STORE(x, lds);
    if (nk > 2) GT_LOAD(x, 2);
    __syncthreads();
    int kt = 0;
#pragma nounroll
    for (; kt + 4 < nk; kt += 2) {
      GT_COMPUTE(lds);
      GT_STORE(y, lds + 32768);
      GT_LOAD(y, kt + 3);
      __syncthreads();
      GT_COMPUTE(lds + 32768);
      GT_STORE(x, lds);
      GT_LOAD(x, kt + 4);
      __syncthreads();
    }
    if (nk >= 4) {
      GT_COMPUTE(lds);
      GT_STORE(y, lds + 32768);
      GT_LOAD(y, kt + 3);
      __syncthreads();
      GT_COMPUTE(lds + 32768);
      GT_STORE(x, lds);
      __syncthreads();
      kt += 2;
    }
    GT_COMPUTE(lds);
    GT_STORE(y, lds + 32768);
    __syncthreads();
    GT_COMPUTE(lds + 32768);
    __syncthreads();
  }
  epi(acc, wr * (MI * 16), wc * 64);
}
template <bool SWAP, class Epi>
__device__ __forceinline__ void gemm_tile(const bf16_t* __restrict__ A, int lda, const bf16_t* __restrict__ Bt, int ldb, int K, char* lds, Epi&& epi) {
  gemm_tile_mi<SWAP, 4>(A, lda, Bt, ldb, K, lds, epi);
}
template <bool SWAP, class Epi>
__device__ __forceinline__ void gemm_tile_1set(const bf16_t* __restrict__ A, int lda, const bf16_t* __restrict__ Bt, int ldb, int K, char* lds, Epi&& epi) {
  gemm_tile_mi<SWAP, 4, false>(A, lda, Bt, ldb, K, lds, epi);
}

#define PH_BEGIN_NOWS int tid_ = threadIdx.x; int bid_ = blockIdx.x; asm volatile("" : "+v"(tid_), "+s"(bid_));
#define PH_BEGIN PH_BEGIN_NOWS size_t wz_ = 0; asm volatile("" : "+s"(wz_)); char* ws_ = p.ws + wz_;
__device__ __forceinline__ void conv_T(const float* __restrict__ src, int K, int N, bf16_t* __restrict__ dst, int ldd, int& base, char* lds) {
  PH_BEGIN_NOWS
  const int tn = N >> 6, nt = (K >> 6) * tn, G = gridDim.x, tid = tid_;
  float (*tile)[65] = (float (*)[65])lds;
  int first = ((int)bid_ - base) % G; if (first < 0) first += G;
  for (int t = first; t < nt; t += G) {
    const int kt = t / tn, nti = t - kt * tn;
    const float* s = src + (size_t)(kt * 64) * N + nti * 64;
    const int c = tid & 63, r0 = tid >> 6;
#pragma unroll
    for (int i = 0; i < 16; ++i) tile[r0 + 4 * i][c] = s[(size_t)(r0 + 4 * i) * N + c];
    __syncthreads();
    const int n = tid >> 2, kc = (tid & 3) * 16;
    unsigned w[8];
#pragma unroll
    for (int j = 0; j < 8; ++j) w[j] = pack2(tile[kc + 2 * j][n], tile[kc + 2 * j + 1][n]);
    bf16_t* d = dst + (size_t)(nti * 64 + n) * ldd + kt * 64 + kc;
    *(uint4*)d = make_uint4(w[0], w[1], w[2], w[3]);
    *(uint4*)(d + 8) = make_uint4(w[4], w[5], w[6], w[7]);
    __syncthreads();
  }
  base = (base + nt) % G;
}

__device__ __forceinline__ void conv_tile128(const float* __restrict__ src, int K, int N, bf16_t* __restrict__ dst, int ldd, int t, char* lds, int tid) {
  const int tn = N >> 7;
  bf16_t* tile = (bf16_t*)lds;
  const int kt = t / tn, nti = t - kt * tn;
  const float* s = src + (size_t)(kt * 128) * N + nti * 128;
  const int c4 = (tid & 31) * 4, r0 = tid >> 5;
  f32x4 v[16];
#pragma unroll
  for (int i = 0; i < 16; ++i) v[i] = __builtin_nontemporal_load((const f32x4*)(s + (size_t)(r0 + 8 * i) * N + c4));
#pragma unroll
  for (int i = 0; i < 16; ++i) *(uint2*)(tile + (r0 + 8 * i) * 132 + c4) = make_uint2(pack2(v[i][0], v[i][1]), pack2(v[i][2], v[i][3]));
  __syncthreads();
  const int n = tid >> 1, k0 = (tid & 1) * 64;
  bf16_t* d = dst + (size_t)(nti * 128 + n) * ldd + kt * 128 + k0;
#pragma unroll
  for (int j = 0; j < 8; ++j) {
    unsigned w[4];
#pragma unroll
    for (int q = 0; q < 4; ++q) w[q] = (unsigned)tile[(k0 + j * 8 + 2 * q) * 132 + n] | ((unsigned)tile[(k0 + j * 8 + 2 * q + 1) * 132 + n] << 16);
    *(uint4*)(d + j * 8) = make_uint4(w[0], w[1], w[2], w[3]);
  }
  __syncthreads();
}
__device__ __forceinline__ void conv_T128(const float* __restrict__ src, int K, int N, bf16_t* __restrict__ dst, int ldd, int& base, char* lds) {
  PH_BEGIN_NOWS
  const int nt = (K >> 7) * (N >> 7), G = gridDim.x;
  int first = ((int)bid_ - base) % G; if (first < 0) first += G;
  for (int t = first; t < nt; t += G) conv_tile128(src, K, N, dst, ldd, t, lds, tid_);
  base = (base + nt) % G;
}
__device__ __forceinline__ void conv_deferred(const Params& p, char* ws, int d, char* lds, int tid) {
  const float* src; bf16_t* dst; int K, N, ldd, t;
  if (d < 1024) {
    const int m = d >> 8, l = 2 + (m >> 1); t = d & 255;
    if ((m & 1) == 0) { src = p.in[10] + (size_t)l * 1024 * 4096; K = 1024; N = 4096; dst = (bf16_t*)(ws + OFF_W1T) + (size_t)l * 4096 * 1024; ldd = 1024; }
    else { src = p.in[11] + (size_t)l * 4096 * 1024; K = 4096; N = 1024; dst = (bf16_t*)(ws + OFF_W2T) + (size_t)l * 4096 * 1024; ldd = 4096; }
  } else {
    d -= 1024;
    if (d < 64) { src = p.in[20]; K = 1024; N = 1024; dst = (bf16_t*)(ws + OFF_RWOT); ldd = 1024; t = d; }
    else if (d < 88) { src = p.in[34]; K = 1024; N = 384; dst = (bf16_t*)(ws + OFF_MDQKVT); ldd = 1024; t = d - 64; }
    else if (d < 124) { src = p.in[36]; K = 384; N = 1536; dst = (bf16_t*)(ws + OFF_MUQT); ldd = 384; t = d - 88; }
    else if (d < 140) { src = p.in[39]; K = 256; N = 1024; dst = (bf16_t*)(ws + OFF_MUKT); ldd = 256; t = d - 124; }
    else if (d < 156) { src = p.in[40]; K = 256; N = 1024; dst = (bf16_t*)(ws + OFF_MUVT); ldd = 256; t = d - 140; }
    else { src = p.in[41]; K = 1024; N = 1024; dst = (bf16_t*)(ws + OFF_MOT); ldd = 1024; t = d - 156; }
  }
  conv_tile128(src, K, N, dst, ldd, t, lds, tid);
}
__device__ __forceinline__ void conv_deferred_l1(const Params& p, char* ws, int d, char* lds, int tid) {
  const float* src; bf16_t* dst; int K, N, ldd, t;
  bf16_t* r1 = (bf16_t*)(ws + OFF_RW1T);
  if (d < 256) { src = p.in[10] + (size_t)1024 * 4096; K = 1024; N = 4096; dst = (bf16_t*)(ws + OFF_W1T) + (size_t)4096 * 1024; ldd = 1024; t = d; }
  else if (d < 512) { src = p.in[11] + (size_t)4096 * 1024; K = 4096; N = 1024; dst = (bf16_t*)(ws + OFF_W2T) + (size_t)4096 * 1024; ldd = 4096; t = d - 256; }
  else if (d < 704) { src = p.in[13]; K = 1024; N = 3072; dst = (bf16_t*)(ws + OFF_CINT); ldd = 1024; t = d - 512; }
  else if (d < 768) { src = p.in[15]; K = 1024; N = 1024; dst = (bf16_t*)(ws + OFF_COUTT); ldd = 1024; t = d - 704; }
  else if (d < 832) { src = p.in[17]; K = 1024; N = 1024; dst = r1; ldd = 1024; t = d - 768; }
  else if (d < 896) { src = p.in[18]; K = 1024; N = 1024; dst = r1 + 1024 * 1024; ldd = 1024; t = d - 832; }
  else if (d < 960) { src = p.in[19]; K = 1024; N = 1024; dst = r1 + 2048 * 1024; ldd = 1024; t = d - 896; }
  else if (d < 968) { src = p.in[27]; K = 1024; N = 128; dst = r1 + (3072 + 256) * 1024; ldd = 1024; t = d - 960; }
  else { src = p.in[28]; K = 128; N = 1024; dst = (bf16_t*)(ws + OFF_RWG2T); ldd = 128; t = d - 968; }
  conv_tile128(src, K, N, dst, ldd, t, lds, tid);
}
constexpr int N_DEFERRED_L1 = 976;
constexpr int N_DEFERRED = 1024 + 64 + 24 + 36 + 16 + 16 + 64;

__device__ __forceinline__ void phase_prep_a(const Params& p, char* lds) {
  PH_BEGIN
  char* ws = ws_;
  const int tid = tid_, gt = bid_ * 256 + tid, nthr = gridDim.x * 256;
  if (bid_ == 0 && tid < 64) ((unsigned*)(ws + OFF_CTR))[tid] = 0u;
  {
    float* sl = (float*)lds;
    f32x4* red = (f32x4*)(lds + 12288);
    bool have = false;
    for (int item = bid_; item < 384; item += gridDim.x) {
      if (!have) {
        for (int i = tid; i < 3072; i += 256) {
          const int g = i >> 10, k = i & 1023;
          const float cv = g == 0 ? p.in[6][k] : p.in[5][(g - 1) * 1024 + k];
          sl[i] = cv / (1.f + __expf(-cv));
        }
        have = true;
        __syncthreads();
      }
      const int l = item / 96, r = item % 96, chunk = r >> 2, kq = r & 3, lane = tid & 63, w = tid >> 6;
      const int n0 = chunk * 256 + lane * 4, k0 = kq * 256 + w * 64;
      const float* mw = p.in[7] + (size_t)l * 1024 * 6144 + (size_t)k0 * 6144 + n0;
      f32x4 a0 = {0.f, 0.f, 0.f, 0.f}, a1 = a0, a2 = a0;
#pragma unroll 16
      for (int k = 0; k < 64; ++k) {
        const f32x4 wv = __builtin_nontemporal_load((const f32x4*)(mw + (size_t)k * 6144));
        a0 += sl[k0 + k] * wv; a1 += sl[1024 + k0 + k] * wv; a2 += sl[2048 + k0 + k] * wv;
      }
      red[(w * 3 + 0) * 64 + lane] = a0; red[(w * 3 + 1) * 64 + lane] = a1; red[(w * 3 + 2) * 64 + lane] = a2;
      __syncthreads();
      if (tid < 192) {
        const int g = tid >> 6;
        f32x4 sm = (red[(0 * 3 + g) * 64 + lane] + red[(1 * 3 + g) * 64 + lane]) + (red[(2 * 3 + g) * 64 + lane] + red[(3 * 3 + g) * 64 + lane]);
        if (kq == 0) sm += *(const f32x4*)(p.in[8] + l * 6144 + n0);
        *(f32x4*)((float*)(ws + OFF_MODP) + (size_t)kq * 73728 + (l * 3 + g) * 6144 + n0) = sm;
      }
      __syncthreads();
    }
    __syncthreads();
  }
  {
    bf16_t* dc = (bf16_t*)(ws + OFF_DFTC);
    for (int i = gt; i < 256 * 128; i += nthr) {
      const int np = i >> 7, c = i & 127, half = np >> 7, cp = np & 127, m = (c * cp) & 127;
      const float x = (float)m * (1.f / 128.f);
      const float v = half ? __builtin_amdgcn_sinf(x) : __builtin_amdgcn_cosf(x);
      dc[i] = f2bf(v * 0.08838834764831845f);
    }
    bf16_t* d256 = (bf16_t*)(ws + OFF_DFTP256);
    for (int i = gt; i < 256 * 512; i += nthr) {
      const int np = i >> 9, c = i & 511, half = c >> 8, pos = c & 255, m = (pos * np) & 255;
      const float x = (float)m * (1.f / 256.f);
      const float v = half ? -__builtin_amdgcn_sinf(x) : __builtin_amdgcn_cosf(x);
      d256[i] = f2bf(v * 0.0625f);
    }
    bf16_t* d1024 = (bf16_t*)(ws + OFF_DFTP1024);
    for (int i = gt; i < 1024 * 2048; i += nthr) {
      const int np = i >> 11, c = i & 2047, half = c >> 10, pos = c & 1023, m = (pos * np) & 1023;
      const float x = (float)m * (1.f / 1024.f);
      const float v = half ? -__builtin_amdgcn_sinf(x) : __builtin_amdgcn_cosf(x);
      d1024[i] = f2bf(v * 0.03125f);
    }
  }
  {
    bf16_t* ck = (bf16_t*)(ws + OFF_CKVALL);
    for (int i = gt; i < 2 * 256 * 256; i += nthr) {
      const int b = i >> 16, r = i & 65535;
      ck[(size_t)(4096 + b * 1280) * 256 + r] = f2bf(p.in[3][i]);
    }
    bf16_t* kr = (bf16_t*)(ws + OFF_KRALL);
    for (int i = gt; i < 2 * 256 * 64; i += nthr) {
      const int b = i >> 14, r = i & 16383;
      kr[krf_idx(4096 + b * 1280 + (r >> 6), r & 63)] = f2bf(p.in[4][i]);
    }
    bf16_t* pad = (bf16_t*)(ws + OFF_MDQKVT) + 704 * 1024;
    for (int i = gt; i < 64 * 1024; i += nthr) pad[i] = 0;
  }
}
__device__ __forceinline__ void phase_prep_b(const Params& p, char* lds) {
  PH_BEGIN
  char* ws = ws_;
  int base = 0;
  for (int l = 0; l < 1; ++l) {
    conv_T128(p.in[10] + (size_t)l * 1024 * 4096, 1024, 4096, (bf16_t*)(ws + OFF_W1T) + (size_t)l * 4096 * 1024, 1024, base, lds);
    conv_T128(p.in[11] + (size_t)l * 4096 * 1024, 4096, 1024, (bf16_t*)(ws + OFF_W2T) + (size_t)l * 4096 * 1024, 4096, base, lds);
  }
  conv_T128(p.in[12], 1024, 1024, (bf16_t*)(ws + OFF_FFTWT), 1024, base, lds);
  {
    bf16_t* r1 = (bf16_t*)(ws + OFF_RW1T);
    conv_T(p.in[22], 1024, 64, r1 + 3072 * 1024, 1024, base, lds);
    conv_T(p.in[22] + 1024 * 64, 1024, 64, r1 + (3072 + 64) * 1024, 1024, base, lds);
    conv_T(p.in[25], 1024, 64, r1 + (3072 + 128) * 1024, 1024, base, lds);
    conv_T(p.in[25] + 1024 * 64, 1024, 64, r1 + (3072 + 192) * 1024, 1024, base, lds);
    conv_T(p.in[23], 64, 1024, (bf16_t*)(ws + OFF_RWW2T), 64, base, lds);
    conv_T(p.in[23] + 64 * 1024, 64, 1024, (bf16_t*)(ws + OFF_RWW2T) + 1024 * 64, 64, base, lds);
    conv_T(p.in[26], 64, 1024, (bf16_t*)(ws + OFF_RWA2T), 64, base, lds);
    conv_T(p.in[26] + 64 * 1024, 64, 1024, (bf16_t*)(ws + OFF_RWA2T) + 1024 * 64, 64, base, lds);
  }
  conv_T(p.in[37], 1024, 320, (bf16_t*)(ws + OFF_MDQKVT) + 384 * 1024, 1024, base, lds);
}

__device__ __forceinline__ void phase_row(const Params& p, bool from_input, bool upd, int ul, int ugate, int ugn, bool wh, int hl, int hgn, int hshift, bool part = false) {
  PH_BEGIN
  const int lane = tid_ & 63, gw = bid_ * 4 + (tid_ >> 6), nw = gridDim.x * 4;
  float* X = p.out;
  const bf16_t* O = (const bf16_t*)(ws_ + OFF_O);
  bf16_t* H = (bf16_t*)(ws_ + OFF_H);
  const float* modv = (const float*)(ws_ + (part ? OFF_MODP : OFF_MOD));
  const float* ng = p.in[9];
  if (part) {
    const float* mp = (const float*)(ws_ + OFF_MODP); float* mf = (float*)(ws_ + OFF_MOD);
    for (int i = (bid_ * 256 + tid_) * 4; i < 73728; i += gridDim.x * 1024) *(f32x4*)(mf + i) = ldmod(mp, i);
  }
  auto xptr = [&](int row) { return from_input ? (row < 4096 ? p.in[0] + (size_t)row * 1024 : p.in[1] + (size_t)(row - 4096) * 1024) : (const float*)X + (size_t)row * 1024; };
  f32x4 xn[4], on[4];
  if (gw < 6144) {
    const float* xr = xptr(gw);
#pragma unroll
    for (int i = 0; i < 4; ++i) { xn[i] = *(const f32x4*)(xr + lane * 4 + 256 * i); if (upd) { const uint2 u_ = *(const uint2*)(O + (size_t)gw * 1024 + lane * 4 + 256 * i); on[i] = (f32x4){bflo(u_.x), bfhi(u_.x), bflo(u_.y), bfhi(u_.y)}; } }
  }
  for (int row = gw; row < 6144; row += nw) {
    const int g = row_group(row);
    f32x4 x[4], ov[4], gvu[4], gt[4], gvh[4], shv[4], scv[4];
#pragma unroll
    for (int i = 0; i < 4; ++i) { x[i] = xn[i]; if (upd) ov[i] = on[i]; }
    const float* gnu = ng + (ul * 4 + ugn) * 1024;
    const float* gate = modv + ((ul * 3 + g) * 6 + ugate) * 1024;
    const float* gnh = ng + (hl * 4 + hgn) * 1024;
    const float* sh = modv + ((hl * 3 + g) * 6 + hshift) * 1024;
#pragma unroll
    for (int i = 0; i < 4; ++i) {
      const int c = lane * 4 + 256 * i;
      if (upd) { gvu[i] = *(const f32x4*)(gnu + c); gt[i] = *(const f32x4*)(gate + c); }
      if (wh) { gvh[i] = *(const f32x4*)(gnh + c); shv[i] = part ? ldmod(sh, c) : *(const f32x4*)(sh + c); scv[i] = part ? ldmod(sh, 1024 + c) : *(const f32x4*)(sh + 1024 + c); }
    }
    if (row + nw < 6144) {
      const float* xr = xptr(row + nw);
#pragma unroll
      for (int i = 0; i < 4; ++i) { xn[i] = *(const f32x4*)(xr + lane * 4 + 256 * i); if (upd) { const uint2 u_ = *(const uint2*)(O + (size_t)(row + nw) * 1024 + lane * 4 + 256 * i); on[i] = (f32x4){bflo(u_.x), bfhi(u_.x), bflo(u_.y), bfhi(u_.y)}; } }
    }
    if (upd) {
      float ss = 0.f;
#pragma unroll
      for (int i = 0; i < 4; ++i) ss += ov[i][0] * ov[i][0] + ov[i][1] * ov[i][1] + ov[i][2] * ov[i][2] + ov[i][3] * ov[i][3];
      ss = wave_sum(ss);
      const float rs = rsqrtf(ss * (1.f / 1024.f) + 1e-6f);
#pragma unroll
      for (int i = 0; i < 4; ++i) x[i] += gt[i] * (ov[i] * rs * gvu[i]);
    }
    if (upd) {
#pragma unroll
      for (int i = 0; i < 4; ++i) *(f32x4*)(X + (size_t)row * 1024 + lane * 4 + 256 * i) = x[i];
    }
    if (wh) {
      float ss = 0.f;
#pragma unroll
      for (int i = 0; i < 4; ++i) ss += x[i][0] * x[i][0] + x[i][1] * x[i][1] + x[i][2] * x[i][2] + x[i][3] * x[i][3];
      ss = wave_sum(ss);
      const float rs = rsqrtf(ss * (1.f / 1024.f) + 1e-6f);
#pragma unroll
      for (int i = 0; i < 4; ++i) {
        const int c = lane * 4 + 256 * i;
        const f32x4 h = x[i] * rs * gvh[i] * (1.f + scv[i]) + shv[i];
        *(uint2*)(H + (size_t)row * 1024 + c) = make_uint2(pack2(h[0], h[1]), pack2(h[2], h[3]));
      }
    }
  }
}

__device__ __forceinline__ void phase_rwkv_mix(const Params& p) {
  PH_BEGIN
  const int lane = tid_ & 63, gw = bid_ * 4 + (tid_ >> 6), nw = gridDim.x * 4;
  const float* X = p.out;
  bf16_t* XM = (bf16_t*)(ws_ + OFF_XM);
  const float* modv = (const float*)(ws_ + OFF_MOD);
  const float* gn = p.in[9] + (2 * 4 + 0) * 1024;
  const float* mu = p.in[16];
  for (int row = gw; row < 6144; row += nw) {
    const int g = row_group(row);
    const int pos = row < 4096 ? (row & 255) : ((row - 4096) & 1023), n = row < 4096 ? 256 : 1024;
    const bool hasp = pos > 0, hasn = pos < n - 1;
    const float* sh = modv + ((2 * 3 + g) * 6 + 0) * 1024;
    f32x4 xc[4], xp[4], xn[4];
    float sc_ = 0.f, sp_ = 0.f, sn_ = 0.f;
#pragma unroll
    for (int i = 0; i < 4; ++i) {
      const int c = lane * 4 + 256 * i;
      xc[i] = *(const f32x4*)(X + (size_t)row * 1024 + c);
      xp[i] = hasp ? *(const f32x4*)(X + (size_t)(row - 1) * 1024 + c) : (f32x4){0.f, 0.f, 0.f, 0.f};
      xn[i] = hasn ? *(const f32x4*)(X + (size_t)(row + 1) * 1024 + c) : (f32x4){0.f, 0.f, 0.f, 0.f};
#pragma unroll
      for (int j = 0; j < 4; ++j) { sc_ += xc[i][j] * xc[i][j]; sp_ += xp[i][j] * xp[i][j]; sn_ += xn[i][j] * xn[i][j]; }
    }
    sc_ = wave_sum(sc_); sp_ = wave_sum(sp_); sn_ = wave_sum(sn_);
    const float rc = rsqrtf(sc_ * (1.f / 1024.f) + 1e-6f), rp = rsqrtf(sp_ * (1.f / 1024.f) + 1e-6f), rn = rsqrtf(sn_ * (1.f / 1024.f) + 1e-6f);
#pragma unroll
    for (int i = 0; i < 4; ++i) {
      const int c = lane * 4 + 256 * i;
      const f32x4 gv = *(const f32x4*)(gn + c), shv = *(const f32x4*)(sh + c), scv = *(const f32x4*)(sh + 1024 + c);
      const f32x4 gm = gv * (1.f + scv);
      const f32x4 hc = xc[i] * rc * gm + shv;
      f32x4 hp = xp[i] * rp * gm + shv, hn = xn[i] * rn * gm + shv;
      if (!hasp) hp = (f32x4){0.f, 0.f, 0.f, 0.f};
      if (!hasn) hn = (f32x4){0.f, 0.f, 0.f, 0.f};
      const f32x4 dx = 0.5f * (hp + hn) - hc;
#pragma unroll
      for (int m = 0; m < 6; ++m) {
        const f32x4 muv = *(const f32x4*)(mu + m * 1024 + c);
        const f32x4 o = hc + dx * muv;
        *(uint2*)(XM + (size_t)m * SZ_ACT + (size_t)row * 1024 + c) = make_uint2(pack2(o[0], o[1]), pack2(o[2], o[3]));
      }
    }
  }
}

__device__ __forceinline__ void phase_conv_elt(const Params& p) {
  PH_BEGIN
  const int lane = tid_ & 63, gw = bid_ * 4 + (tid_ >> 6), nw = gridDim.x * 4;
  const bf16_t* BCU = (const bf16_t*)(ws_ + OFF_BCU);
  bf16_t* A2 = (bf16_t*)(ws_ + OFF_A2);
  const float* cw = p.in[14];
  for (int row = gw; row < 6144; row += nw) {
    const int pos = row < 4096 ? (row & 255) : ((row - 4096) & 1023), n = row < 4096 ? 256 : 1024;
    const bool hasp = pos > 0, hasn = pos < n - 1;
#pragma unroll
    for (int i = 0; i < 2; ++i) {
      const int c = lane * 8 + 512 * i;
      const bf16_t* rb = BCU + (size_t)row * 3072 + c;
      const uint4 bg = *(const uint4*)rb, cg = *(const uint4*)(rb + 1024), u = *(const uint4*)(rb + 2048);
      uint4 cgp = make_uint4(0, 0, 0, 0), up = cgp, cgn = cgp, un = cgp;
      if (hasp) { cgp = *(const uint4*)(rb - 3072 + 1024); up = *(const uint4*)(rb - 3072 + 2048); }
      if (hasn) { cgn = *(const uint4*)(rb + 3072 + 1024); un = *(const uint4*)(rb + 3072 + 2048); }
      const unsigned bgw[4] = {bg.x, bg.y, bg.z, bg.w}, cgw[4] = {cg.x, cg.y, cg.z, cg.w}, uw[4] = {u.x, u.y, u.z, u.w};
      const unsigned cgpw[4] = {cgp.x, cgp.y, cgp.z, cgp.w}, upw[4] = {up.x, up.y, up.z, up.w}, cgnw[4] = {cgn.x, cgn.y, cgn.z, cgn.w}, unw[4] = {un.x, un.y, un.z, un.w};
      unsigned ow[4];
#pragma unroll
      for (int j = 0; j < 4; ++j) {
        const int cc = c + 2 * j;
        const float w00 = cw[cc], w01 = cw[cc + 1], w10 = cw[1024 + cc], w11 = cw[1024 + cc + 1], w20 = cw[2048 + cc], w21 = cw[2048 + cc + 1];
        const float z0 = bflo(cgw[j]) * bflo(uw[j]), z1 = bfhi(cgw[j]) * bfhi(uw[j]);
        const float zp0 = bflo(cgpw[j]) * bflo(upw[j]), zp1 = bfhi(cgpw[j]) * bfhi(upw[j]);
        const float zn0 = bflo(cgnw[j]) * bflo(unw[j]), zn1 = bfhi(cgnw[j]) * bfhi(unw[j]);
        const float o0 = bflo(bgw[j]) * (zp0 * w00 + z0 * w10 + zn0 * w20);
        const float o1 = bfhi(bgw[j]) * (zp1 * w01 + z1 * w11 + zn1 * w21);
        ow[j] = pack2(o0, o1);
      }
      *(uint4*)(A2 + (size_t)row * 1024 + c) = make_uint4(ow[0], ow[1], ow[2], ow[3]);
    }
  }
}

__device__ __forceinline__ void phase_postscan(const Params& p) {
  PH_BEGIN
  const int lane = tid_ & 63, gw = bid_ * 4 + (tid_ >> 6), nw = gridDim.x * 4;
  const float* Y0 = (const float*)(ws_ + OFF_Y0);
  const float* Y1 = (const float*)(ws_ + OFF_Y1);
  const float* R = (const float*)(ws_ + OFF_R);
  const float* V = (const float*)(ws_ + OFF_V);
  const float* G = (const float*)(ws_ + OFF_G);
  const bf16_t* KE = (const bf16_t*)(ws_ + OFF_KEFF);
  bf16_t* Z = (bf16_t*)(ws_ + OFF_H);
  const float* rk = p.in[31]; const float* lng = p.in[32]; const float* lnb = p.in[33];
  for (int row = gw; row < 6144; row += nw) {
    const size_t b = (size_t)row * 1024 + lane * 16;
    float y[16], bon = 0.f, s = 0.f;
    f32x4 vv4[4], gg4[4], lg4[4], lb4[4];
#pragma unroll
    for (int i = 0; i < 4; ++i) {
      vv4[i] = *(const f32x4*)(V + b + 4 * i); gg4[i] = *(const f32x4*)(G + b + 4 * i);
      lg4[i] = *(const f32x4*)(lng + lane * 16 + 4 * i); lb4[i] = *(const f32x4*)(lnb + lane * 16 + 4 * i);
    }
#pragma unroll
    for (int i = 0; i < 4; ++i) {
      const f32x4 a = *(const f32x4*)(Y0 + b + 4 * i), c = *(const f32x4*)(Y1 + b + 4 * i), r = *(const f32x4*)(R + b + 4 * i);
      const uint2 k0 = *(const uint2*)(KE + b + 4 * i), k1 = *(const uint2*)(KE + SZ_ACT + b + 4 * i);
      const f32x4 rkv = *(const f32x4*)(rk + lane * 16 + 4 * i);
      const float ke[4] = {bflo(k0.x) + bflo(k1.x), bfhi(k0.x) + bfhi(k1.x), bflo(k0.y) + bflo(k1.y), bfhi(k0.y) + bfhi(k1.y)};
#pragma unroll
      for (int j = 0; j < 4; ++j) { y[4 * i + j] = a[j] + c[j]; s += y[4 * i + j]; bon += r[j] * ke[j] * rkv[j]; }
    }
    s = quad_sum(s); bon = quad_sum(bon);
    const float mean = s * (1.f / 64.f);
    float vs = 0.f;
#pragma unroll
    for (int j = 0; j < 16; ++j) { const float d = y[j] - mean; vs += d * d; }
    vs = quad_sum(vs);
    const float rstd = rsqrtf(vs * (1.f / 64.f) + 64e-5f);
    unsigned ow[8];
#pragma unroll
    for (int i = 0; i < 4; ++i) {
      float o[4];
#pragma unroll
      for (int j = 0; j < 4; ++j) o[j] = ((y[4 * i + j] - mean) * rstd * lg4[i][j] + lb4[i][j] + bon * vv4[i][j]) * gg4[i][j];
      ow[2 * i] = pack2(o[0], o[1]); ow[2 * i + 1] = pack2(o[2], o[3]);
    }
    *(uint4*)(Z + b) = make_uint4(ow[0], ow[1], ow[2], ow[3]);
    *(uint4*)(Z + b + 8) = make_uint4(ow[4], ow[5], ow[6], ow[7]);
  }
}

__device__ __forceinline__ void phase_mla_rows(const Params& p) {
  PH_BEGIN
  const int lane = tid_ & 63, gw = bid_ * 4 + (tid_ >> 6), nw = gridDim.x * 4;
  const float* QC = (const float*)(ws_ + OFF_QC);
  bf16_t* QN = (bf16_t*)(ws_ + OFF_QN);
  bf16_t* CK = (bf16_t*)(ws_ + OFF_CKVALL);
  bf16_t* KR = (bf16_t*)(ws_ + OFF_KRALL);
  const float* gq = p.in[35]; const float* gkv = p.in[38];
  for (int row = gw; row < 6144; row += nw) {
    const float* q = QC + (size_t)row * 704;
    int keyrow = row;
    if (row >= 4096) { const int r = row - 4096; keyrow = 4096 + (r >> 10) * 1280 + 256 + (r & 1023); }
    float qv[6], ss = 0.f;
#pragma unroll
    for (int i = 0; i < 6; ++i) { qv[i] = q[lane + 64 * i]; ss += qv[i] * qv[i]; }
    ss = wave_sum(ss);
    float rs = rsqrtf(ss * (1.f / 384.f) + 1e-6f);
#pragma unroll
    for (int i = 0; i < 6; ++i) QN[(size_t)row * 384 + lane + 64 * i] = f2bf(qv[i] * rs * gq[lane + 64 * i]);
    float cv[4]; ss = 0.f;
#pragma unroll
    for (int i = 0; i < 4; ++i) { cv[i] = q[384 + lane + 64 * i]; ss += cv[i] * cv[i]; }
    ss = wave_sum(ss);
    rs = rsqrtf(ss * (1.f / 256.f) + 1e-6f);
#pragma unroll
    for (int i = 0; i < 4; ++i) {
      const float o = cv[i] * rs * gkv[lane + 64 * i];
      CK[(size_t)keyrow * 256 + lane + 64 * i] = f2bf(o);
      if (row < 4096) p.out[OUT_CKV + (size_t)row * 256 + lane + 64 * i] = o;
    }
    float kv = q[640 + lane];
    if (row < 4096) {
      p.out[OUT_KROPE + (size_t)row * 64 + lane] = kv;
    } else {
      const int pp = (row - 4096) & 1023;
      const float posv = (lane >> 5) ? (float)(pp & 63) : (float)(pp >> 6);
      const float inv = exp2f(-(float)(lane & 15) * 0.8304820237218406f);
      const float rev = posv * inv * 0.15915494309189535f;
      const float sn = __builtin_amdgcn_sinf(rev), cs = __builtin_amdgcn_cosf(rev);
      const float other = __shfl_xor(kv, 16);
      kv = (lane & 16) ? (other * sn + kv * cs) : (kv * cs - other * sn);
    }
    KR[krf_idx(keyrow, lane)] = f2bf(kv);
  }
}

#define ACC_T f32x4 (&acc)[4][4]
#define LANE_VARS const int lane = tid_ & 63, l15 = lane & 15, quad = lane >> 4; (void)l15; (void)quad;

__device__ __forceinline__ void phase_gemm_f32(const bf16_t* A, int lda, const bf16_t* Bt, int ldb, int K, int ntm, int ntn, float* Out, int ldo, int nvalid, char* lds) {
  PH_BEGIN_NOWS
  { size_t z_ = 0; asm volatile("" : "+s"(z_)); A += z_; Bt += z_; Out += z_; }
  LANE_VARS
  for (int t = bid_; t < ntm * ntn; t += gridDim.x) {
    const int tm = t % ntm, tn = t / ntm;
    gemm_tile<true>(A + (size_t)tm * 128 * lda, lda, Bt + (size_t)tn * 128 * ldb, ldb, K, lds, [&](ACC_T, int r0, int c0) __attribute__((always_inline)) {
#pragma unroll
      for (int mi = 0; mi < 4; ++mi)
#pragma unroll
        for (int ni = 0; ni < 4; ++ni) {
          const int row = tm * 128 + r0 + mi * 16 + l15, col = tn * 128 + c0 + ni * 16 + quad * 4;
          if (col < nvalid) *(f32x4*)(Out + (size_t)row * ldo + col) = acc[mi][ni];
        }
    });
  }
}

__device__ __forceinline__ void phase_gemm_f32_m96(const bf16_t* A, int lda, const bf16_t* Bt, int ldb, int K, float* Out, char* lds) {
  PH_BEGIN_NOWS
  { size_t z_ = 0; asm volatile("" : "+s"(z_)); A += z_; Bt += z_; Out += z_; }
  LANE_VARS
  char* stg = lds + 32768 + (tid_ >> 6) * 8192;
  bf16_t* Ob = (bf16_t*)Out;
  for (int t = bid_; t < 64 * 8; t += gridDim.x) {
    const int tm = t % 64, tn = t / 64;
    gemm_tile_mi<true, 3>(A + (size_t)tm * 96 * lda, lda, Bt + (size_t)tn * 128 * ldb, ldb, K, lds, [&](f32x4 (&acc)[3][4], int r0, int c0) __attribute__((always_inline)) {
#pragma unroll
      for (int mi = 0; mi < 3; ++mi) {
#pragma unroll
        for (int ni = 0; ni < 4; ++ni) {
          const f32x4 v = acc[mi][ni];
          *(uint2*)(stg + l15 * 144 + (ni * 16 + quad * 4) * 2) = make_uint2(pack2(v[0], v[1]), pack2(v[2], v[3]));
        }
#pragma unroll
        for (int j = 0; j < 2; ++j) {
          const int rr = (lane >> 3) + 8 * j;
          const uint4 w = *(const uint4*)(stg + rr * 144 + (lane & 7) * 16);
          *(uint4*)(Ob + (size_t)(tm * 96 + r0 + mi * 16 + rr) * 1024 + tn * 128 + c0 + (lane & 7) * 8) = w;
        }
      }
    });
  }
}

template <int ACT>
__device__ __forceinline__ void phase_gemm_bf16(const bf16_t* A, int lda, const bf16_t* Bt, int ldb, int K, int ntm, int ntn, bf16_t* Out, int ldo, char* lds) {
  PH_BEGIN_NOWS
  { size_t z_ = 0; asm volatile("" : "+s"(z_)); A += z_; Bt += z_; Out += z_; }
  LANE_VARS
  char* stg = lds + 32768 + (tid_ >> 6) * 8192;
  for (int t = bid_; t < ntm * ntn; t += gridDim.x) {
    const int tm = t % ntm, tn = t / ntm;
    gemm_tile<true>(A + (size_t)tm * 128 * lda, lda, Bt + (size_t)tn * 128 * ldb, ldb, K, lds, [&](ACC_T, int r0, int c0) __attribute__((always_inline)) {
#pragma unroll
      for (int ps = 0; ps < 2; ++ps) {
#pragma unroll
        for (int mi2 = 0; mi2 < 2; ++mi2)
#pragma unroll
          for (int ni = 0; ni < 4; ++ni) {
            f32x4 v = acc[ps * 2 + mi2][ni];
            if (ACT == 1) {
#pragma unroll
              for (int j = 0; j < 4; ++j) { const float r = fmaxf(v[j], 0.f); v[j] = r * r; }
            }
            *(uint2*)(stg + (mi2 * 16 + l15) * 144 + (ni * 16 + quad * 4) * 2) = make_uint2(pack2(v[0], v[1]), pack2(v[2], v[3]));
          }
#pragma unroll
        for (int j = 0; j < 4; ++j) {
          const int rr = (lane >> 3) + 8 * j;
          const uint4 w = *(const uint4*)(stg + rr * 144 + (lane & 7) * 16);
          *(uint4*)(Out + (size_t)(tm * 128 + r0 + ps * 32 + rr) * ldo + tn * 128 + c0 + (lane & 7) * 8) = w;
        }
      }
    });
  }
}

__device__ __forceinline__ void phase_gemm_bf16_m96(const bf16_t* A, int lda, const bf16_t* Bt, int ldb, int K, int ntn, bf16_t* Out, int ldo, char* lds) {
  PH_BEGIN_NOWS
  { size_t z_ = 0; asm volatile("" : "+s"(z_)); A += z_; Bt += z_; Out += z_; }
  LANE_VARS
  char* stg = lds + 32768 + (tid_ >> 6) * 8192;
  for (int t = bid_; t < 64 * ntn; t += gridDim.x) {
    const int tm = t % 64, tn = t / 64;
    gemm_tile_mi<true, 3>(A + (size_t)tm * 96 * lda, lda, Bt + (size_t)tn * 128 * ldb, ldb, K, lds, [&](f32x4 (&acc)[3][4], int r0, int c0) __attribute__((always_inline)) {
#pragma unroll
      for (int mi = 0; mi < 3; ++mi) {
#pragma unroll
        for (int ni = 0; ni < 4; ++ni) {
          const f32x4 v = acc[mi][ni];
          *(uint2*)(stg + l15 * 144 + (ni * 16 + quad * 4) * 2) = make_uint2(pack2(v[0], v[1]), pack2(v[2], v[3]));
        }
#pragma unroll
        for (int j = 0; j < 2; ++j) {
          const int rr = (lane >> 3) + 8 * j;
          const uint4 w = *(const uint4*)(stg + rr * 144 + (lane & 7) * 16);
          *(uint4*)(Out + (size_t)(tm * 96 + r0 + mi * 16 + rr) * ldo + tn * 128 + c0 + (lane & 7) * 8) = w;
        }
      }
    });
  }
}

__device__ __forceinline__ void stg_store_bf16(char* stg, const f32x4 (&v)[4], bf16_t* dst, int ld, int lane) {
  const int l15 = lane & 15, quad = lane >> 4;
#pragma unroll
  for (int ni = 0; ni < 4; ++ni) *(uint2*)(stg + l15 * 144 + (ni * 16 + quad * 4) * 2) = make_uint2(pack2(v[ni][0], v[ni][1]), pack2(v[ni][2], v[ni][3]));
#pragma unroll
  for (int j = 0; j < 2; ++j) {
    const int rr = (lane >> 3) + 8 * j;
    const uint4 w = *(const uint4*)(stg + rr * 144 + (lane & 7) * 16);
    *(uint4*)(dst + (size_t)rr * ld + (lane & 7) * 8) = w;
  }
}
__device__ __forceinline__ void phase_chan_dft(const Params& p, char* lds) {
  PH_BEGIN
  LANE_VARS
  const bf16_t* H = (const bf16_t*)(ws_ + OFF_H);
  const bf16_t* TB = (const bf16_t*)(ws_ + OFF_DFTC);
  bf16_t* YT = (bf16_t*)(ws_ + OFF_YT);
  for (int t = bid_; t < 48 * 16; t += gridDim.x) {
    const int tm = t % 48, tn = t / 48, g = tn >> 1, half = tn & 1;
    const int trow = tm * 128;
    bf16_t* base; int n, pos0;
    if (trow < 4096) { n = 256; pos0 = trow & 255; base = YT + (size_t)(trow >> 8) * (1024 * 512); }
    else { n = 1024; pos0 = (trow - 4096) & 1023; base = YT + (size_t)16 * 1024 * 512 + (size_t)((trow - 4096) >> 10) * (1024 * 2048); }
    gemm_tile<false>(H + (size_t)trow * 1024 + g * 128, 1024, TB + (size_t)half * 128 * 128, 128, 128, lds, [&](ACC_T, int r0, int c0) __attribute__((always_inline)) {
#pragma unroll
      for (int mi = 0; mi < 4; ++mi)
#pragma unroll
        for (int ni = 0; ni < 4; ++ni) {
          const int pos = pos0 + r0 + mi * 16 + quad * 4, cp = c0 + ni * 16 + l15;
          const f32x4 v = acc[mi][ni];
          *(uint2*)(base + (size_t)(g * 128 + cp) * (2 * n) + half * n + pos) = make_uint2(pack2(v[0], v[1]), pack2(v[2], v[3]));
        }
    });
  }
}

__device__ __forceinline__ void phase_pos_dft(const Params& p, char* lds) {
  PH_BEGIN
  LANE_VARS
  const bf16_t* YT = (const bf16_t*)(ws_ + OFF_YT);
  bf16_t* F = (bf16_t*)(ws_ + OFF_F);
  for (int u = bid_; u < 384; u += gridDim.x) {
    const bf16_t *A, *Bt; int ld, K, orow, tn;
    if (u < 128) {
      const int s2 = u >> 6, tm = (u >> 3) & 7; tn = u & 7;
      A = (const bf16_t*)(ws_ + OFF_DFTP1024) + (size_t)tm * 128 * 2048; ld = 2048; K = 2048;
      Bt = YT + (size_t)16 * 1024 * 512 + (size_t)s2 * 1024 * 2048 + (size_t)tn * 128 * 2048;
      orow = 4096 + s2 * 1024 + tm * 128;
    } else {
      const int v = u - 128, s = v >> 4, tm = (v >> 3) & 1; tn = v & 7;
      A = (const bf16_t*)(ws_ + OFF_DFTP256) + (size_t)tm * 128 * 512; ld = 512; K = 512;
      Bt = YT + (size_t)s * 1024 * 512 + (size_t)tn * 128 * 512;
      orow = s * 256 + tm * 128;
    }
    gemm_tile<true>(A, ld, Bt, ld, K, lds, [&](ACC_T, int r0, int c0) __attribute__((always_inline)) {
#pragma unroll
      for (int mi = 0; mi < 4; ++mi) stg_store_bf16(lds + 32768 + (tid_ >> 6) * 8192, acc[mi], F + (size_t)(orow + r0 + mi * 16) * 1024 + tn * 128 + c0, 1024, lane);
    });
  }
  if (bid_ >= 128) {
    for (int d = bid_ - 128; d < N_DEFERRED_L1; d += (int)gridDim.x - 128) conv_deferred_l1(p, ws_, d, lds, tid_);
  }
}

__device__ __forceinline__ void phase_rwkv_gemm1(const Params& p, char* lds) {
  PH_BEGIN
  LANE_VARS
  const bf16_t* XM = (const bf16_t*)(ws_ + OFF_XM);
  const bf16_t* Bt = (const bf16_t*)(ws_ + OFF_RW1T);
  float* R = (float*)(ws_ + OFF_R); float* V = (float*)(ws_ + OFF_V); float* Kb = (float*)(ws_ + OFF_K); float* KK = (float*)(ws_ + OFF_KK);
  bf16_t* LB = (bf16_t*)(ws_ + OFF_LB);
  const float* k_k = p.in[29];
  for (int t = bid_; t < 48 * 27; t += gridDim.x) {
    const int tm = t % 48, tn = t / 48;
    int sel, kind;
    if (tn < 8) { sel = 0; kind = 0; } else if (tn < 16) { sel = 2; kind = 1; } else if (tn < 24) { sel = 3; kind = 2; }
    else { kind = 3; sel = tn == 24 ? 1 : (tn == 25 ? 4 : 5); }
    gemm_tile<true>(XM + (size_t)sel * SZ_ACT + (size_t)tm * 128 * 1024, 1024, Bt + (size_t)tn * 128 * 1024, 1024, 1024, lds, [&](ACC_T, int r0, int c0) __attribute__((always_inline)) {
      if (kind == 1) {
        const int cb = (tn - 8) * 128 + c0;
#pragma unroll
        for (int mi = 0; mi < 4; ++mi) {
          const int row = tm * 128 + r0 + mi * 16 + l15;
          f32x4 kk[4]; float ss = 0.f;
#pragma unroll
          for (int ni = 0; ni < 4; ++ni) {
            const int col = cb + ni * 16 + quad * 4;
            const f32x4 kkw = *(const f32x4*)(k_k + col);
            kk[ni] = acc[mi][ni] * kkw;
            ss += kk[ni][0] * kk[ni][0] + kk[ni][1] * kk[ni][1] + kk[ni][2] * kk[ni][2] + kk[ni][3] * kk[ni][3];
            *(f32x4*)(Kb + (size_t)row * 1024 + col) = acc[mi][ni];
          }
          ss += __shfl_xor(ss, 16); ss += __shfl_xor(ss, 32);
          const float rn = rsqrtf(ss + 1e-12f);
#pragma unroll
          for (int ni = 0; ni < 4; ++ni) *(f32x4*)(KK + (size_t)row * 1024 + cb + ni * 16 + quad * 4) = kk[ni] * rn;
          __builtin_amdgcn_sched_barrier(0);
        }
      } else if (kind == 3) {
        const int cb = (tn - 24) * 128 + c0;
#pragma unroll
        for (int mi = 0; mi < 4; ++mi)
#pragma unroll
          for (int ni = 0; ni < 4; ++ni) {
            const int row = tm * 128 + r0 + mi * 16 + l15, col = cb + ni * 16 + quad * 4;
            f32x4 v = acc[mi][ni];
            if (tn == 24) { v[0] = tanhf(v[0]); v[1] = tanhf(v[1]); v[2] = tanhf(v[2]); v[3] = tanhf(v[3]); }
            else if (tn == 26) { v[0] = sigmoidf_(v[0]); v[1] = sigmoidf_(v[1]); v[2] = sigmoidf_(v[2]); v[3] = sigmoidf_(v[3]); }
            *(uint2*)(LB + (size_t)row * 384 + col) = make_uint2(pack2(v[0], v[1]), pack2(v[2], v[3]));
            __builtin_amdgcn_sched_barrier(0);
          }
      } else {
        float* dst = kind == 0 ? R : V;
        const int cb = (kind == 0 ? tn : tn - 16) * 128 + c0;
#pragma unroll
        for (int mi = 0; mi < 4; ++mi)
#pragma unroll
          for (int ni = 0; ni < 4; ++ni)
            *(f32x4*)(dst + (size_t)(tm * 128 + r0 + mi * 16 + l15) * 1024 + cb + ni * 16 + quad * 4) = acc[mi][ni];
      }
    });
  }
}

__device__ __forceinline__ void phase_rwkv_gemm2(const Params& p, char* lds) {
  PH_BEGIN
  LANE_VARS
  const bf16_t* LB = (const bf16_t*)(ws_ + OFF_LB);
  const float* Kb = (const float*)(ws_ + OFF_K); const float* KK = (const float*)(ws_ + OFF_KK);
  float* WD = (float*)(ws_ + OFF_WDEC); float* G = (float*)(ws_ + OFF_G);
  bf16_t* KE = (bf16_t*)(ws_ + OFF_KEFF); bf16_t* NB = (bf16_t*)(ws_ + OFF_NB);
  const float* k_a = p.in[30];
  for (int t = bid_; t < 48 * 40; t += gridDim.x) {
    const int tm = t % 48, tq = t / 48, grp = tq >> 3, tn = tq & 7;
    const bf16_t* Bt; int K;
    if (grp < 2) { Bt = (const bf16_t*)(ws_ + OFF_RWW2T) + (size_t)grp * 1024 * 64; K = 64; }
    else if (grp < 4) { Bt = (const bf16_t*)(ws_ + OFF_RWA2T) + (size_t)(grp - 2) * 1024 * 64; K = 64; }
    else { Bt = (const bf16_t*)(ws_ + OFF_RWG2T); K = 128; }
    gemm_tile<true>(LB + (size_t)tm * 128 * 384 + grp * 64, 384, Bt + (size_t)tn * 128 * K, K, K, lds, [&](ACC_T, int r0, int c0) __attribute__((always_inline)) {
#pragma unroll
      for (int mi = 0; mi < 4; ++mi) {
        f32x4 ke4_0 = {0.f, 0.f, 0.f, 0.f}, ke4_1 = ke4_0, ke4_2 = ke4_0, ke4_3 = ke4_0, nb4_0 = ke4_0, nb4_1 = ke4_0, nb4_2 = ke4_0, nb4_3 = ke4_0;
#pragma unroll
        for (int ni = 0; ni < 4; ++ni) {
          const int row = tm * 128 + r0 + mi * 16 + l15, col = tn * 128 + c0 + ni * 16 + quad * 4;
          const size_t idx = (size_t)row * 1024 + col;
          f32x4 v = acc[mi][ni];
          if (grp < 2) {
            const f32x4 w0 = *(const f32x4*)(p.in[21] + grp * 1024 + col);
            auto dec = [](float w0v, float vv) {
              const float z = -(w0v + vv);
              const float sp = fmaxf(z, 0.f) + __logf(1.f + __expf(-fabsf(z)));
              return __expf(-__expf(-sp - 0.5f));
            };
            *(f32x4*)(WD + (size_t)grp * SZ_ACT + idx) = (f32x4){dec(w0[0], v[0]), dec(w0[1], v[1]), dec(w0[2], v[2]), dec(w0[3], v[3])};
          } else if (grp < 4) {
            const int d = grp - 2;
            const f32x4 a0 = *(const f32x4*)(p.in[24] + d * 1024 + col), ka = *(const f32x4*)(k_a + col);
            const f32x4 kv = *(const f32x4*)(Kb + idx), kkv = *(const f32x4*)(KK + idx);
            const f32x4 a = (f32x4){sigmoidf_(a0[0] + v[0]), sigmoidf_(a0[1] + v[1]), sigmoidf_(a0[2] + v[2]), sigmoidf_(a0[3] + v[3])};
            const f32x4 ke = kv * (1.f + (a - 1.f) * ka);
            const f32x4 nb = -kkv * a;
            if (ni == 0) { ke4_0 = ke; nb4_0 = nb; } else if (ni == 1) { ke4_1 = ke; nb4_1 = nb; } else if (ni == 2) { ke4_2 = ke; nb4_2 = nb; } else { ke4_3 = ke; nb4_3 = nb; }
          } else {
            *(f32x4*)(G + idx) = v;
          }
          __builtin_amdgcn_sched_barrier(0);
        }
        if (grp >= 2 && grp < 4) {
          const size_t o_ = (size_t)(grp - 2) * SZ_ACT + (size_t)(tm * 128 + r0 + mi * 16) * 1024 + tn * 128 + c0;
          const f32x4 ke4[4] = {ke4_0, ke4_1, ke4_2, ke4_3}, nb4[4] = {nb4_0, nb4_1, nb4_2, nb4_3};
          stg_store_bf16(lds + 32768 + (tid_ >> 6) * 8192, ke4, KE + o_, 1024, lane);
          stg_store_bf16(lds + 32768 + (tid_ >> 6) * 8192, nb4, NB + o_, 1024, lane);
        }
      }
    });
  }
}

__device__ __forceinline__ void phase_mla_up(const Params& p, char* lds) {
  PH_BEGIN
  LANE_VARS
  const bf16_t* QN = (const bf16_t*)(ws_ + OFF_QN);
  const bf16_t* CK = (const bf16_t*)(ws_ + OFF_CKVALL);
  bf16_t* Q = (bf16_t*)(ws_ + OFF_Q); bf16_t* KN = (bf16_t*)(ws_ + OFF_KN); bf16_t* VT = (bf16_t*)(ws_ + OFF_VT);
  const float qs = 0.07216878364870323f * 1.4426950408889634f;
  for (int t = bid_; t < 576 + 416 + 416; t += gridDim.x) {
    if (t < 576) {
      const int tm = t % 48, tn = t / 48;
      gemm_tile_1set<true>(QN + (size_t)tm * 128 * 384, 384, (const bf16_t*)(ws_ + OFF_MUQT) + (size_t)tn * 128 * 384, 384, 384, lds, [&](ACC_T, int r0, int c0) __attribute__((always_inline)) {
        const int cb = tn * 128 + c0;
        const bool ropeblk = (cb % 192) == 128;
#pragma unroll
        for (int mi = 0; mi < 4; ++mi) {
          const int row = tm * 128 + r0 + mi * 16 + l15;
          f32x4 v[4];
#pragma unroll
          for (int ni = 0; ni < 4; ++ni) v[ni] = acc[mi][ni] * qs;
          if (ropeblk && row >= 4096) {
            const int pp = (row - 4096) & 1023;
#pragma unroll
            for (int ax = 0; ax < 2; ++ax) {
              const float posv = ax ? (float)(pp & 63) : (float)(pp >> 6);
#pragma unroll
              for (int j = 0; j < 4; ++j) {
                const float inv = exp2f(-(float)(quad * 4 + j) * 0.8304820237218406f);
                const float rev = posv * inv * 0.15915494309189535f;
                const float sn = __builtin_amdgcn_sinf(rev), cs = __builtin_amdgcn_cosf(rev);
                const float x1 = v[2 * ax][j], x2 = v[2 * ax + 1][j];
                v[2 * ax][j] = x1 * cs - x2 * sn; v[2 * ax + 1][j] = x1 * sn + x2 * cs;
              }
            }
          }
          stg_store_bf16(lds + 32768 + (tid_ >> 6) * 8192, v, Q + (size_t)(tm * 128 + r0 + mi * 16) * 1536 + cb, 1536, lane);
        }
      });
    } else if (t < 576 + 416) {
      const int u = t - 576, tm = u % 52, tn = u / 52;
      gemm_tile_1set<true>(CK + (size_t)tm * 128 * 256, 256, (const bf16_t*)(ws_ + OFF_MUKT) + (size_t)tn * 128 * 256, 256, 256, lds, [&](ACC_T, int r0, int c0) __attribute__((always_inline)) {
#pragma unroll
        for (int mi = 0; mi < 4; ++mi)
#pragma unroll
          for (int ni = 0; ni < 4; ++ni) {
            const f32x4 v = acc[mi][ni];
            *(uint2*)(KN + knf_idx(tm * 128 + r0 + mi * 16 + l15, tn * 128 + c0 + ni * 16 + quad * 4)) = make_uint2(pack2(v[0], v[1]), pack2(v[2], v[3]));
          }
      });
    } else {
      const int u = t - 576 - 416, tm = u % 52, tn = u / 52;
      const int krow = tm * 128;
      bf16_t* base; int ldv, kp0;
      if (krow < 4096) { base = VT + (size_t)(krow >> 8) * 262144; ldv = 256; kp0 = krow & 255; }
      else { const int r = krow - 4096, s2 = r / 1280; base = VT + 4194304 + (size_t)s2 * 1310720; ldv = 1280; kp0 = r - s2 * 1280; }
      gemm_tile_1set<false>(CK + (size_t)tm * 128 * 256, 256, (const bf16_t*)(ws_ + OFF_MUVT) + (size_t)tn * 128 * 256, 256, 256, lds, [&](ACC_T, int r0, int c0) __attribute__((always_inline)) {
#pragma unroll
        for (int mi = 0; mi < 4; ++mi)
#pragma unroll
          for (int ni = 0; ni < 4; ++ni) {
            const f32x4 v = acc[mi][ni];
            const int n = tn * 128 + c0 + ni * 16 + l15, kp = kp0 + r0 + mi * 16 + quad * 4;
            *(uint2*)(VT + vf_idx(krow + r0 + mi * 16 + quad * 4, n)) = make_uint2(pack2(v[0], v[1]), pack2(v[2], v[3])); (void)base; (void)ldv; (void)kp;
          }
      });
    }
  }
}

__device__ __forceinline__ float row16_sum(float v) {
  v += __int_as_float(__builtin_amdgcn_update_dpp(0, __float_as_int(v), 0xB1, 0xF, 0xF, true));
  v += __int_as_float(__builtin_amdgcn_update_dpp(0, __float_as_int(v), 0x4E, 0xF, 0xF, true));
  v += __int_as_float(__builtin_amdgcn_update_dpp(0, __float_as_int(v), 0x141, 0xF, 0xF, true));
  v += __int_as_float(__builtin_amdgcn_update_dpp(0, __float_as_int(v), 0x140, 0xF, 0xF, true));
  return v;
}
template <int R>
__device__ __forceinline__ void scan_block(const Params& p, char* ws_, char* lds, int tid, int n, int tok0, int h, int dir, int sub, const float* sinit, float* sfin) {
  const int lane = tid & 63, wid = tid >> 6, rg = lane >> 4, kpos = lane & 15;
  const float* Rb = (const float*)(ws_ + OFF_R); const float* V = (const float*)(ws_ + OFF_V); const float* KK = (const float*)(ws_ + OFF_KK);
  const float* WD = (const float*)(ws_ + OFF_WDEC) + (size_t)dir * SZ_ACT;
  const bf16_t* KE = (const bf16_t*)(ws_ + OFF_KEFF) + (size_t)dir * SZ_ACT;
  const bf16_t* NB = (const bf16_t*)(ws_ + OFF_NB) + (size_t)dir * SZ_ACT;
  float* Y = (float*)(ws_ + (dir ? OFF_Y1 : OFF_Y0));
  float* vb = (float*)lds;
  float* yb = (float*)(lds + 49152);
  const int lsi = tid >> 4, lc4 = (tid & 15) * 4;
  const int row0 = sub * 16 * R + (wid * 4 + rg) * R;
  f32x4 S[R];
#pragma unroll
  for (int r = 0; r < R; ++r) S[r] = sinit ? *(const f32x4*)(sinit + (row0 + r) * 64 + kpos * 4) : (f32x4){0.f, 0.f, 0.f, 0.f};
  const int nch = n >> 4;
  f32x4 lr, lw, lke, lkk, lnb, lv;
  auto gload = [&](int c) {
    const int tt = c * 16 + lsi, tm = dir ? (n - 1 - tt) : tt;
    const size_t idx = (size_t)(tok0 + tm) * 1024 + h * 64 + lc4;
    lr = *(const f32x4*)(Rb + idx); lw = *(const f32x4*)(WD + idx); lkk = *(const f32x4*)(KK + idx); lv = *(const f32x4*)(V + idx);
    const uint2 a = *(const uint2*)(KE + idx), b = *(const uint2*)(NB + idx);
    lke = (f32x4){bflo(a.x), bfhi(a.x), bflo(a.y), bfhi(a.y)};
    lnb = (f32x4){bflo(b.x), bfhi(b.x), bflo(b.y), bfhi(b.y)};
  };
  auto lstore = [&](int buf) {
    float* d = vb + buf * 6144 + lsi * 384 + lc4;
    *(f32x4*)(d) = lr; *(f32x4*)(d + 64) = lw; *(f32x4*)(d + 128) = lke; *(f32x4*)(d + 192) = lkk; *(f32x4*)(d + 256) = lnb; *(f32x4*)(d + 320) = lv;
  };
  gload(0); lstore(0);
  __syncthreads();
  for (int c = 0; c < nch; ++c) {
    const int buf = c & 1;
    if (c + 1 < nch) gload(c + 1);
    const float* cb = vb + buf * 6144;
    float* ycb = yb + buf * 1024;
    f32x4 nr4, nw4, ne4, nk4, nb4; float nvv[R];
#define SC_LDS(s_) do { const float* sv_ = cb + (s_) * 384 + kpos * 4; nr4 = *(const f32x4*)(sv_); nw4 = *(const f32x4*)(sv_ + 64); ne4 = *(const f32x4*)(sv_ + 128); nk4 = *(const f32x4*)(sv_ + 192); nb4 = *(const f32x4*)(sv_ + 256); \
      if (R == 4) { const f32x4 v4_ = *(const f32x4*)(cb + (s_) * 384 + 320 + row0); nvv[0] = v4_[0]; nvv[1 % R] = v4_[1]; nvv[2 % R] = v4_[2]; nvv[3 % R] = v4_[3]; } \
      else { _Pragma("unroll") for (int r = 0; r < R; ++r) nvv[r] = cb[(s_) * 384 + 320 + row0 + r]; } } while (0)
    SC_LDS(0);
#pragma unroll
    for (int s = 0; s < 16; ++s) {
      const f32x4 r4 = nr4, w4 = nw4, e4 = ne4, k4 = nk4, b4 = nb4;
      float vv[R];
#pragma unroll
      for (int r = 0; r < R; ++r) vv[r] = nvv[r];
      if (s + 1 < 16) SC_LDS(s + 1);
      float sa[R];
#pragma unroll
      for (int r = 0; r < R; ++r) { const f32x4 t = S[r] * k4; sa[r] = row16_sum((t[0] + t[1]) + (t[2] + t[3])); }
      float ysel = 0.f;
#pragma unroll
      for (int r = 0; r < R; ++r) {
        S[r] = S[r] * w4 + sa[r] * b4 + vv[r] * e4;
        const f32x4 t = S[r] * r4;
        const float y = row16_sum((t[0] + t[1]) + (t[2] + t[3]));
        ysel = kpos == r ? y : ysel;
      }
      if (kpos < R) ycb[s * 64 + row0 + kpos] = ysel;
    }
    if (c + 1 < nch) lstore(buf ^ 1);
    __syncthreads();
    {
      const int tt = c * 16 + lsi, tm = dir ? (n - 1 - tt) : tt;
      if (R == 4) *(f32x4*)(Y + (size_t)(tok0 + tm) * 1024 + h * 64 + lc4) = *(const f32x4*)(ycb + lsi * 64 + lc4);
      else Y[(size_t)(tok0 + tm) * 1024 + h * 64 + sub * 16 + (tid & 15)] = ycb[lsi * 64 + sub * 16 + (tid & 15)];
    }
  }
  if (sfin) {
#pragma unroll
    for (int r = 0; r < R; ++r) *(f32x4*)(sfin + (row0 + r) * 64 + kpos * 4) = S[r];
  }
  __syncthreads();
}
__device__ __forceinline__ void scan_block_q2(const Params& p, char* ws_, char* lds, int tid, int jp) {
  const int lane = tid & 63, wid = tid >> 6, isel = wid >> 1, q = lane >> 2, kq = lane & 3;
  const int sq = jp >> 4, h = jp & 15, n = 256, tok0 = sq * 256;
  const float* Rb = (const float*)(ws_ + OFF_R); const float* V = (const float*)(ws_ + OFF_V); const float* KK = (const float*)(ws_ + OFF_KK);
  float* vb = (float*)lds;
  float* yb = (float*)(lds + 49152);
  const int lis = tid >> 7, lsi = (tid >> 4) & 7, lc4 = (tid & 15) * 4;
  const float* WDl = (const float*)(ws_ + OFF_WDEC) + (size_t)lis * SZ_ACT;
  const bf16_t* KEl = (const bf16_t*)(ws_ + OFF_KEFF) + (size_t)lis * SZ_ACT;
  const bf16_t* NBl = (const bf16_t*)(ws_ + OFF_NB) + (size_t)lis * SZ_ACT;
  float* Yl = (float*)(ws_ + (lis ? OFF_Y1 : OFF_Y0));
  const int row0 = (wid & 1) * 32 + q * 2;
  f32x4 S[2][4];
#pragma unroll
  for (int r = 0; r < 2; ++r)
#pragma unroll
    for (int i = 0; i < 4; ++i) S[r][i] = (f32x4){0.f, 0.f, 0.f, 0.f};
  f32x4 lr, lw, lke, lkk, lnb, lv;
  auto gload = [&](int c) {
    const int tt = c * 8 + lsi, tm = lis ? (n - 1 - tt) : tt;
    const size_t idx = (size_t)(tok0 + tm) * 1024 + h * 64 + lc4;
    lr = *(const f32x4*)(Rb + idx); lw = *(const f32x4*)(WDl + idx); lkk = *(const f32x4*)(KK + idx); lv = *(const f32x4*)(V + idx);
    const uint2 a = *(const uint2*)(KEl + idx), b = *(const uint2*)(NBl + idx);
    lke = (f32x4){bflo(a.x), bfhi(a.x), bflo(a.y), bfhi(a.y)};
    lnb = (f32x4){bflo(b.x), bfhi(b.x), bflo(b.y), bfhi(b.y)};
  };
  auto lstore = [&](int buf) {
    float* d = vb + buf * 6144 + lis * 3072 + lsi * 384 + lc4;
    *(f32x4*)(d) = lr; *(f32x4*)(d + 64) = lw; *(f32x4*)(d + 128) = lke; *(f32x4*)(d + 192) = lkk; *(f32x4*)(d + 256) = lnb; *(f32x4*)(d + 320) = lv;
  };
  gload(0); lstore(0);
  __syncthreads();
  for (int c = 0; c < 32; ++c) {
    const int buf = c & 1;
    if (c + 1 < 32) gload(c + 1);
    const float* cb = vb + buf * 6144 + isel * 3072;
    float* ycb = yb + buf * 1024 + isel * 512;
#pragma unroll 2
    for (int s = 0; s < 8; ++s) {
      const float* sv = cb + s * 384 + kq * 16;
      f32x4 k4[4], w4[4], b4[4], e4[4], r4[4];
#pragma unroll
      for (int i = 0; i < 4; ++i) { r4[i] = *(const f32x4*)(sv + 4 * i); w4[i] = *(const f32x4*)(sv + 64 + 4 * i); e4[i] = *(const f32x4*)(sv + 128 + 4 * i); k4[i] = *(const f32x4*)(sv + 192 + 4 * i); b4[i] = *(const f32x4*)(sv + 256 + 4 * i); }
      const f32x2 vv2 = *(const f32x2*)(cb + s * 384 + 320 + row0);
      float ysel = 0.f;
#pragma unroll
      for (int r = 0; r < 2; ++r) {
        const f32x4 t = (S[r][0] * k4[0] + S[r][1] * k4[1]) + (S[r][2] * k4[2] + S[r][3] * k4[3]);
        const float sa = quad_sum((t[0] + t[1]) + (t[2] + t[3]));
        const float vv = vv2[r];
#pragma unroll
        for (int i = 0; i < 4; ++i) S[r][i] = S[r][i] * w4[i] + sa * b4[i] + vv * e4[i];
        const f32x4 u = (S[r][0] * r4[0] + S[r][1] * r4[1]) + (S[r][2] * r4[2] + S[r][3] * r4[3]);
        const float y = quad_sum((u[0] + u[1]) + (u[2] + u[3]));
        ysel = kq == r ? y : ysel;
      }
      if (kq < 2) ycb[s * 64 + row0 + kq] = ysel;
    }
    if (c + 1 < 32) lstore(buf ^ 1);
    __syncthreads();
    {
      const int tt = c * 8 + lsi, tm = lis ? (n - 1 - tt) : tt;
      *(f32x4*)(Yl + (size_t)(tok0 + tm) * 1024 + h * 64 + lc4) = *(const f32x4*)(yb + buf * 1024 + lis * 512 + lsi * 64 + lc4);
    }
  }
  float* sfin = p.out + OUT_STATE + (size_t)((sq * 2 + isel) * 16 + h) * 4096;
#pragma unroll
  for (int r = 0; r < 2; ++r)
#pragma unroll
    for (int i = 0; i < 4; ++i) *(f32x4*)(sfin + (row0 + r) * 64 + kq * 16 + 4 * i) = S[r][i];
  __syncthreads();
}
__device__ __forceinline__ void phase_scan(const Params& p, char* lds, int cidx = 0) {
  PH_BEGIN
  const int tid = tid_;
  unsigned* ctr = (unsigned*)(ws_ + OFF_CTR) + cidx;
  volatile int& s_item = *(volatile int*)(lds + 57344);
  bool first = true;
  for (;;) {
    if (tid == 0) s_item = first ? (int)bid_ : (int)gridDim.x + (int)atomicAdd(ctr, 1u);
    first = false;
    __syncthreads();
    const int item = s_item;
    __syncthreads();
    if (item >= 512 + N_DEFERRED) break;
    if (item >= 512) { conv_deferred(p, ws_, item - 512, lds, tid); continue; }
    if (item < 256) {
      const int it = item >> 2, sub = item & 3, s2 = it >> 5, h = (it >> 1) & 15, dir = it & 1;
      __builtin_amdgcn_s_setprio(3);
      scan_block<1>(p, ws_, lds, tid, 1024, 4096 + s2 * 1024, h, dir, sub, p.in[2] + (size_t)((s2 * 2 + dir) * 16 + h) * 4096, nullptr);
      __builtin_amdgcn_s_setprio(0);
    } else {
      scan_block_q2(p, ws_, lds, tid, item - 256);
    }
  }
}

__device__ __forceinline__ void phase_attn(const Params& p, int cidx = 1) {
  PH_BEGIN
  const int lane = tid_ & 63, l15 = lane & 15, quad = lane >> 4;
  unsigned* ctr = (unsigned*)(ws_ + OFF_CTR) + cidx;
  const bf16_t* Q = (const bf16_t*)(ws_ + OFF_Q); const bf16_t* KN = (const bf16_t*)(ws_ + OFF_KN);
  const bf16_t* KR = (const bf16_t*)(ws_ + OFF_KRALL); const bf16_t* VT = (const bf16_t*)(ws_ + OFF_VT);
  bf16_t* OA = (bf16_t*)(ws_ + OFF_H);
  for (;;) {
    int item = 0;
    if (lane == 0) item = (int)atomicAdd(ctr, 1u);
    item = __builtin_amdgcn_readfirstlane(item);
    if (item >= 3072) break;
    int h, qrow0, nkeys, keybase; const bf16_t* vt;
    if (item < 1024) { const int s2 = item >> 9; h = (item >> 6) & 7; qrow0 = 4096 + s2 * 1024 + (item & 63) * 16; nkeys = 1280; keybase = 4096 + s2 * 1280; vt = VT + 4194304 + (size_t)s2 * 1310720; }
    else { const int j = item - 1024, s = j >> 7; h = (j >> 4) & 7; qrow0 = s * 256 + (j & 15) * 16; nkeys = 256; keybase = s * 256; vt = VT + (size_t)s * 262144; }
    vt += (size_t)(h * 128) * nkeys;
    bf16x8 qf[6];
#pragma unroll
    for (int ks = 0; ks < 6; ++ks) qf[ks] = *(const bf16x8*)(Q + (size_t)(qrow0 + l15) * 1536 + h * 192 + ks * 32 + quad * 8);
    f32x4 oacc[8];
#pragma unroll
    for (int i = 0; i < 8; ++i) oacc[i] = (f32x4){0.f, 0.f, 0.f, 0.f};
    float m = -1e30f, lsum = 0.f;
    const bf16_t* knp = KN + ((size_t)((keybase >> 4) * 8 + h) * 4 * 64 + lane) * 8;
    const bf16_t* krp = KR + ((size_t)((keybase >> 4) * 2) * 64 + lane) * 8;
    const bf16_t* vpp = VT + ((size_t)((keybase >> 5) * 8 + h) * 8 * 64 + lane) * 8;
    (void)vt;
    bf16x8 kf[12];
    bf16x8 vf[8];
#define AT_LOADK(c_) do { _Pragma("unroll") for (int kt = 0; kt < 2; ++kt) { const int c16 = ((c_) >> 4) + kt; \
        _Pragma("unroll") for (int ks = 0; ks < 4; ++ks) kf[kt * 6 + ks] = *(const bf16x8*)(knp + (size_t)(c16 * 32 + ks) * 512); \
        _Pragma("unroll") for (int ks = 0; ks < 2; ++ks) kf[kt * 6 + 4 + ks] = *(const bf16x8*)(krp + (size_t)(c16 * 2 + ks) * 512); } } while (0)
#define AT_LOADV(c_) do { _Pragma("unroll") for (int dvt = 0; dvt < 8; ++dvt) vf[dvt] = *(const bf16x8*)(vpp + (size_t)(((c_) >> 5) * 64 + dvt) * 512); } while (0)
    AT_LOADK(0);
    AT_LOADV(0);
    for (int c = 0; c < nkeys; c += 32) {
      f32x4 st[2];
#pragma unroll
      for (int kt = 0; kt < 2; ++kt) {
        st[kt] = (f32x4){0.f, 0.f, 0.f, 0.f};
#pragma unroll
        for (int ks = 0; ks < 6; ++ks) st[kt] = __builtin_amdgcn_mfma_f32_16x16x32_bf16(kf[kt * 6 + ks], qf[ks], st[kt], 0, 0, 0);
      }
      __builtin_amdgcn_sched_barrier(0);
      if (c + 32 < nkeys) AT_LOADK(c + 32);
      __builtin_amdgcn_sched_barrier(0);
      float cm = fmaxf(fmaxf(fmaxf(st[0][0], st[0][1]), fmaxf(st[0][2], st[0][3])), fmaxf(fmaxf(st[1][0], st[1][1]), fmaxf(st[1][2], st[1][3])));
      cm = fmaxf(cm, __shfl_xor(cm, 16)); cm = fmaxf(cm, __shfl_xor(cm, 32));
      const float mn = fmaxf(m, cm), alpha = exp2f(m - mn);
      m = mn;
      float pv[8], ps = 0.f;
#pragma unroll
      for (int e = 0; e < 8; ++e) { pv[e] = exp2f(st[e >> 2][e & 3] - mn); ps += pv[e]; }
      lsum = lsum * alpha + ps;
      union { bf16x8 v; unsigned u[4]; } pb;
      pb.u[0] = pack2(pv[0], pv[1]); pb.u[1] = pack2(pv[2], pv[3]); pb.u[2] = pack2(pv[4], pv[5]); pb.u[3] = pack2(pv[6], pv[7]);
#pragma unroll
      for (int dvt = 0; dvt < 8; ++dvt) oacc[dvt] = __builtin_amdgcn_mfma_f32_16x16x32_bf16(vf[dvt], pb.v, oacc[dvt] * alpha, 0, 0, 0);
      __builtin_amdgcn_sched_barrier(0);
      if (c + 32 < nkeys) AT_LOADV(c + 32);
      __builtin_amdgcn_sched_barrier(0);
    }
    lsum += __shfl_xor(lsum, 16); lsum += __shfl_xor(lsum, 32);
    const float il = 1.f / lsum;
#pragma unroll
    for (int dvt = 0; dvt < 8; ++dvt) {
      const f32x4 o = oacc[dvt] * il;
      *(uint2*)(OA + (size_t)(qrow0 + l15) * 1024 + h * 128 + dvt * 16 + quad * 4) = make_uint2(pack2(o[0], o[1]), pack2(o[2], o[3]));
    }
  }
}

#define SC_TOL 0.2f
#define DBG_MIXER_UPD true
#define SKIPMASK 0x0ull
#ifdef SELFCHECK
__device__ __forceinline__ unsigned hsh(unsigned x) { x ^= x >> 16; x *= 0x7feb352dU; x ^= x >> 15; x *= 0x846ca68bU; x ^= x >> 16; return x; }
__device__ __forceinline__ float b2f(bf16_t h) { return __uint_as_float(((unsigned)h) << 16); }
__device__ __forceinline__ void rep(const Params& p, int id, float got, float ref, float atol) {
  float e = fabsf(got - ref) / (fabsf(ref) + atol);
  if (!(e == e) || e > 1e9f) e = 1e9f;
  atomicMax((unsigned*)(p.ws + OFF_CTR) + 8 + id, __float_as_uint(e));
}
__device__ __forceinline__ float dotA(const bf16_t* a, const float* w, int ldw, int K) { float s = 0.f; for (int k = 0; k < K; ++k) s += b2f(a[k]) * w[(size_t)k * ldw]; return s; }
#define GID (bid_ * 256 + tid_)
#define NTHR (gridDim.x * 256)
__device__ __forceinline__ int seq_start(int row) { return row < 4096 ? (row & ~255) : 4096 + ((row - 4096) & ~1023); }
__device__ __forceinline__ int seq_len(int row) { return row < 4096 ? 256 : 1024; }
__device__ __forceinline__ int key_row(int row) { if (row < 4096) return row; const int r = row - 4096; return 4096 + (r >> 10) * 1280 + 256 + (r & 1023); }

__device__ __forceinline__ void chk_modv(const Params& p) {
  PH_BEGIN
  for (int i = GID; i < 4 * 3 * 6144; i += NTHR) {
    const int l = i / 18432, g = (i / 6144) % 3, n = i % 6144;
    float s = 0.f;
    for (int k = 0; k < 1024; ++k) { const float c = g == 0 ? p.in[6][k] : p.in[5][(g - 1) * 1024 + k]; s += c / (1.f + expf(-c)) * p.in[7][((size_t)l * 1024 + k) * 6144 + n]; }
    rep(p, 0, ((const float*)(ws_ + OFF_MOD))[i], s + p.in[8][l * 6144 + n], 0.2f);
  }
}
__device__ __forceinline__ void chk_h(const Params& p, int id, int l, int gi, int shi) {
  PH_BEGIN
  const int s = GID; if (s >= 512) return;
  const int row = hsh(s * 2 + id * 7919) % 6144, col = hsh(s * 2 + 1 + id * 7919) & 1023, g = row_group(row);
  const float* x = p.out + (size_t)row * 1024;
  float ss = 0.f; for (int k = 0; k < 1024; ++k) ss += x[k] * x[k];
  const float rs = 1.f / sqrtf(ss / 1024.f + 1e-6f);
  const float* mv = (const float*)(ws_ + OFF_MOD) + ((l * 3 + g) * 6 + shi) * 1024;
  const float ref = x[col] * rs * p.in[9][(l * 4 + gi) * 1024 + col] * (1.f + mv[1024 + col]) + mv[col];
  rep(p, id, b2f(((const bf16_t*)(ws_ + OFF_H))[(size_t)row * 1024 + col]), ref, 0.3f);
}
__device__ __forceinline__ void chk_o(const Params& p, int id, const bf16_t* A, int K, const float* W) {
  PH_BEGIN
  const int s = GID; if (s >= 512) return;
  const int row = hsh(s * 2 + id * 7919) % 6144, col = hsh(s * 2 + 1 + id * 7919) & 1023;
  rep(p, id, ((const float*)(ws_ + OFF_O))[(size_t)row * 1024 + col], dotA(A + (size_t)row * K, W + col, 1024, K), 0.3f);
}
__device__ __forceinline__ void chk_hid(const Params& p, int id, int l) {
  PH_BEGIN
  const int s = GID; if (s >= 512) return;
  const int row = hsh(s * 2 + id * 7919) % 6144, col = hsh(s * 2 + 1 + id * 7919) & 4095;
  float d = dotA((const bf16_t*)(ws_ + OFF_H) + (size_t)row * 1024, p.in[10] + (size_t)l * 1024 * 4096 + col, 4096, 1024);
  d = fmaxf(d, 0.f); d *= d;
  rep(p, id, b2f(((const bf16_t*)(ws_ + OFF_HID))[(size_t)row * 4096 + col]), d, 0.5f);
}
__device__ __forceinline__ void chk_fft(const Params& p, int id) {
  PH_BEGIN
  const int s = GID; if (s >= 128) return;
  const int row = hsh(s * 2 + id * 7919) % 6144, col = hsh(s * 2 + 1 + id * 7919) & 1023;
  const int s0 = seq_start(row), n = seq_len(row), tp = row - s0, g = col >> 7, cp = col & 127;
  const bf16_t* H = (const bf16_t*)(ws_ + OFF_H);
  float acc = 0.f;
  for (int t = 0; t < n; ++t) {
    const float a = (float)((t * tp) % n) / (float)n;
    for (int c = 0; c < 128; ++c) {
      const float b = (float)((c * cp) & 127) / 128.f;
      acc += b2f(H[(size_t)(s0 + t) * 1024 + g * 128 + c]) * cosf(6.283185307179586f * (a + b));
    }
  }
  rep(p, id, b2f(((const bf16_t*)(ws_ + OFF_F))[(size_t)row * 1024 + col]), acc / sqrtf(128.f * n), 0.3f);
}
__device__ __forceinline__ void chk_bcu(const Params& p, int id) {
  PH_BEGIN
  const int s = GID; if (s >= 512) return;
  const int row = hsh(s * 2 + id * 7919) % 6144, col = hsh(s * 2 + 1 + id * 7919) % 3072;
  rep(p, id, b2f(((const bf16_t*)(ws_ + OFF_BCU))[(size_t)row * 3072 + col]), dotA((const bf16_t*)(ws_ + OFF_H) + (size_t)row * 1024, p.in[13] + col, 3072, 1024), 0.3f);
}
__device__ __forceinline__ void chk_a2(const Params& p, int id) {
  PH_BEGIN
  const int s = GID; if (s >= 512) return;
  const int row = hsh(s * 2 + id * 7919) % 6144, col = hsh(s * 2 + 1 + id * 7919) & 1023;
  const bf16_t* B = (const bf16_t*)(ws_ + OFF_BCU);
  const int pos = row - seq_start(row), n = seq_len(row);
  auto z = [&](int r) { return b2f(B[(size_t)r * 3072 + 1024 + col]) * b2f(B[(size_t)r * 3072 + 2048 + col]); };
  float cv = z(row) * p.in[14][1024 + col];
  if (pos > 0) cv += z(row - 1) * p.in[14][col];
  if (pos < n - 1) cv += z(row + 1) * p.in[14][2048 + col];
  rep(p, id, b2f(((const bf16_t*)(ws_ + OFF_A2))[(size_t)row * 1024 + col]), b2f(B[(size_t)row * 3072 + col]) * cv, 0.3f);
}
__device__ __forceinline__ void chk_xm(const Params& p, int id) {
  PH_BEGIN
  const int s = GID; if (s >= 512) return;
  const int row = hsh(s * 2 + id * 7919) % 6144, col = hsh(s * 2 + 1 + id * 7919) & 1023, m = s % 6, g = row_group(row);
  const int pos = row - seq_start(row), n = seq_len(row);
  const float* mv = (const float*)(ws_ + OFF_MOD) + ((2 * 3 + g) * 6 + 0) * 1024;
  auto hval = [&](int r) {
    const float* x = p.out + (size_t)r * 1024; float ss = 0.f; for (int k = 0; k < 1024; ++k) ss += x[k] * x[k];
    return x[col] / sqrtf(ss / 1024.f + 1e-6f) * p.in[9][(2 * 4 + 0) * 1024 + col] * (1.f + mv[1024 + col]) + mv[col]; };
  const float hc = hval(row), hp = pos > 0 ? hval(row - 1) : 0.f, hn = pos < n - 1 ? hval(row + 1) : 0.f;
  const float ref = hc + (0.5f * (hp + hn) - hc) * p.in[16][m * 1024 + col];
  rep(p, id, b2f(((const bf16_t*)(ws_ + OFF_XM))[(size_t)m * SZ_ACT + (size_t)row * 1024 + col]), ref, 0.3f);
}
__device__ __forceinline__ void chk_rw1(const Params& p, int id0) {
  PH_BEGIN
  const int s = GID; if (s >= 512) return;
  const int row = hsh(s * 2 + id0 * 7919) % 6144, col = hsh(s * 2 + 1 + id0 * 7919) & 1023;
  const bf16_t* XM = (const bf16_t*)(ws_ + OFF_XM);
  rep(p, id0 + 0, ((const float*)(ws_ + OFF_R))[(size_t)row * 1024 + col], dotA(XM + 0 * SZ_ACT + (size_t)row * 1024, p.in[17] + col, 1024, 1024), 0.3f);
  rep(p, id0 + 1, ((const float*)(ws_ + OFF_K))[(size_t)row * 1024 + col], dotA(XM + 2 * SZ_ACT + (size_t)row * 1024, p.in[18] + col, 1024, 1024), 0.3f);
  rep(p, id0 + 2, ((const float*)(ws_ + OFF_V))[(size_t)row * 1024 + col], dotA(XM + 3 * SZ_ACT + (size_t)row * 1024, p.in[19] + col, 1024, 1024), 0.3f);
  const int lc = col % 384; float lr;
  if (lc < 128) lr = tanhf(dotA(XM + 1 * SZ_ACT + (size_t)row * 1024, p.in[22] + (size_t)(lc >> 6) * 1024 * 64 + (lc & 63), 64, 1024));
  else if (lc < 256) lr = dotA(XM + 4 * SZ_ACT + (size_t)row * 1024, p.in[25] + (size_t)((lc - 128) >> 6) * 1024 * 64 + (lc & 63), 64, 1024);
  else { lr = dotA(XM + 5 * SZ_ACT + (size_t)row * 1024, p.in[27] + (lc - 256), 128, 1024); lr = 1.f / (1.f + expf(-lr)); }
  rep(p, id0 + 3, b2f(((const bf16_t*)(ws_ + OFF_LB))[(size_t)row * 384 + lc]), lr, 0.2f);
  const float* Kb = (const float*)(ws_ + OFF_K) + (size_t)row * 1024 + (col & ~63);
  float ss = 0.f; for (int c = 0; c < 64; ++c) { const float v = Kb[c] * p.in[29][(col & ~63) + c]; ss += v * v; }
  rep(p, id0 + 4, ((const float*)(ws_ + OFF_KK))[(size_t)row * 1024 + col], Kb[col & 63] * p.in[29][col] / sqrtf(ss + 1e-12f), 0.03f);
}
__device__ __forceinline__ void chk_rw2(const Params& p, int id0) {
  PH_BEGIN
  const int s = GID; if (s >= 512) return;
  const int row = hsh(s * 2 + id0 * 7919) % 6144, col = hsh(s * 2 + 1 + id0 * 7919) & 1023, d = s & 1;
  const bf16_t* LB = (const bf16_t*)(ws_ + OFF_LB) + (size_t)row * 384;
  const size_t idx = (size_t)row * 1024 + col;
  const float z = p.in[21][d * 1024 + col] + dotA(LB + d * 64, p.in[23] + (size_t)d * 64 * 1024 + col, 1024, 64);
  const float logw = -log1pf(expf(-z)) - 0.5f;
  rep(p, id0 + 0, ((const float*)(ws_ + OFF_WDEC))[(size_t)d * SZ_ACT + idx], expf(-expf(logw)), 0.2f);
  const float a = 1.f / (1.f + expf(-(p.in[24][d * 1024 + col] + dotA(LB + 128 + d * 64, p.in[26] + (size_t)d * 64 * 1024 + col, 1024, 64))));
  const float kv = ((const float*)(ws_ + OFF_K))[idx], kkv = ((const float*)(ws_ + OFF_KK))[idx];
  rep(p, id0 + 1, b2f(((const bf16_t*)(ws_ + OFF_KEFF))[(size_t)d * SZ_ACT + idx]), kv * (1.f + (a - 1.f) * p.in[30][col]), 0.3f);
  rep(p, id0 + 2, b2f(((const bf16_t*)(ws_ + OFF_NB))[(size_t)d * SZ_ACT + idx]), -kkv * a, 0.02f);
  rep(p, id0 + 3, ((const float*)(ws_ + OFF_G))[idx], dotA(LB + 256, p.in[28] + col, 1024, 128), 0.2f);
}
__device__ __forceinline__ void chk_scan(const Params& p, int id0) {
  PH_BEGIN
  const int s = GID; if (s >= 64) return;
  const int item = s < 8 ? s * 7 : 64 + (hsh(s) % 512), v = hsh(s + 77) & 63;
  int n, tok0, h, dir; const float* sinit = nullptr; const float* sfin = nullptr;
  if (item < 64) { const int s2 = item >> 5; h = (item >> 1) & 15; dir = item & 1; n = 1024; tok0 = 4096 + s2 * 1024; sinit = p.in[2] + (size_t)((s2 * 2 + dir) * 16 + h) * 4096; }
  else { const int j = item - 64, sq = j >> 5; h = (j >> 1) & 15; dir = j & 1; n = 256; tok0 = sq * 256; sfin = p.out + OUT_STATE + (size_t)((sq * 2 + dir) * 16 + h) * 4096; }
  const float* R = (const float*)(ws_ + OFF_R); const float* V = (const float*)(ws_ + OFF_V); const float* KK = (const float*)(ws_ + OFF_KK);
  const float* WD = (const float*)(ws_ + OFF_WDEC) + (size_t)dir * SZ_ACT;
  const bf16_t* KE = (const bf16_t*)(ws_ + OFF_KEFF) + (size_t)dir * SZ_ACT; const bf16_t* NB = (const bf16_t*)(ws_ + OFF_NB) + (size_t)dir * SZ_ACT;
  const float* Y = (const float*)(ws_ + (dir ? OFF_Y1 : OFF_Y0));
  float S[64];
#pragma unroll
  for (int k = 0; k < 64; ++k) S[k] = sinit ? sinit[v * 64 + k] : 0.f;
  for (int tt = 0; tt < n; ++tt) {
    const int t = dir ? n - 1 - tt : tt; const size_t b = (size_t)(tok0 + t) * 1024 + h * 64;
    float sa = 0.f;
#pragma unroll
    for (int k = 0; k < 64; ++k) sa += S[k] * KK[b + k];
    const float vv = V[b + v]; float y = 0.f;
#pragma unroll
    for (int k = 0; k < 64; ++k) { S[k] = S[k] * WD[b + k] + sa * b2f(NB[b + k]) + vv * b2f(KE[b + k]); y += S[k] * R[b + k]; }
    rep(p, id0, Y[b + v], y, 0.05f);
  }
  if (sfin) {
#pragma unroll
    for (int k = 0; k < 64; ++k) rep(p, id0 + 1, sfin[v * 64 + k], S[k], 0.05f);
  }
}
__device__ __forceinline__ void chk_z(const Params& p, int id) {
  PH_BEGIN
  const int s = GID; if (s >= 512) return;
  const int row = hsh(s * 2 + id * 7919) % 6144, col = hsh(s * 2 + 1 + id * 7919) & 1023, hb = col & ~63;
  const size_t b = (size_t)row * 1024 + hb;
  const float* Y0 = (const float*)(ws_ + OFF_Y0); const float* Y1 = (const float*)(ws_ + OFF_Y1); const float* R = (const float*)(ws_ + OFF_R);
  const bf16_t* KE = (const bf16_t*)(ws_ + OFF_KEFF);
  float mean = 0.f, bon = 0.f;
  for (int c = 0; c < 64; ++c) { mean += Y0[b + c] + Y1[b + c]; bon += R[b + c] * (b2f(KE[b + c]) + b2f(KE[SZ_ACT + b + c])) * p.in[31][hb + c]; }
  mean /= 64.f; float var = 0.f;
  for (int c = 0; c < 64; ++c) { const float d = Y0[b + c] + Y1[b + c] - mean; var += d * d; }
  var /= 64.f;
  const size_t i = (size_t)row * 1024 + col;
  const float ref = ((Y0[i] + Y1[i] - mean) / sqrtf(var + 64e-5f) * p.in[32][col] + p.in[33][col] + bon * ((const float*)(ws_ + OFF_V))[i]) * ((const float*)(ws_ + OFF_G))[i];
  rep(p, id, b2f(((const bf16_t*)(ws_ + OFF_H))[i]), ref, 0.2f);
}
__device__ __forceinline__ void chk_qc(const Params& p, int id) {
  PH_BEGIN
  const int s = GID; if (s >= 512) return;
  const int row = hsh(s * 2 + id * 7919) % 6144, col = hsh(s * 2 + 1 + id * 7919) % 704;
  const bf16_t* a = (const bf16_t*)(ws_ + OFF_H) + (size_t)row * 1024;
  const float ref = col < 384 ? dotA(a, p.in[34] + col, 384, 1024) : dotA(a, p.in[37] + (col - 384), 320, 1024);
  rep(p, id, ((const float*)(ws_ + OFF_QC))[(size_t)row * 704 + col], ref, 0.3f);
}
__device__ __forceinline__ float rope_ref(float x, float partner, int r  , int pp) {
  const int ax = r >> 5, part = (r >> 4) & 1, i = r & 15;
  const float ang = (ax ? (float)(pp & 63) : (float)(pp >> 6)) * powf(10000.f, -(float)i / 16.f);
  return part == 0 ? x * cosf(ang) - partner * sinf(ang) : partner * sinf(ang) + x * cosf(ang);
}
__device__ __forceinline__ void chk_mlarows(const Params& p, int id0) {
  PH_BEGIN
  const int s = GID; if (s >= 512) return;
  const int row = hsh(s * 2 + id0 * 7919) % 6144, c0 = hsh(s * 2 + 1 + id0 * 7919);
  const float* q = (const float*)(ws_ + OFF_QC) + (size_t)row * 704;
  float ss = 0.f; for (int k = 0; k < 384; ++k) ss += q[k] * q[k];
  int col = c0 % 384;
  rep(p, id0, b2f(((const bf16_t*)(ws_ + OFF_QN))[(size_t)row * 384 + col]), q[col] / sqrtf(ss / 384.f + 1e-6f) * p.in[35][col], 0.3f);
  ss = 0.f; for (int k = 0; k < 256; ++k) ss += q[384 + k] * q[384 + k];
  col = c0 & 255;
  const float cr = q[384 + col] / sqrtf(ss / 256.f + 1e-6f) * p.in[38][col];
  rep(p, id0 + 1, b2f(((const bf16_t*)(ws_ + OFF_CKVALL))[(size_t)key_row(row) * 256 + col]), cr, 0.3f);
  if (row < 4096) rep(p, id0 + 1, p.out[OUT_CKV + (size_t)row * 256 + col], cr, 0.3f);
  col = c0 & 63;
  float kr = q[640 + col];
  if (row >= 4096) kr = rope_ref(kr, q[640 + (col ^ 16)], col, (row - 4096) & 1023);
  else rep(p, id0 + 2, p.out[OUT_KROPE + (size_t)row * 64 + col], kr, 0.3f);
  rep(p, id0 + 2, b2f(((const bf16_t*)(ws_ + OFF_KRALL))[(size_t)key_row(row) * 64 + col]), kr, 0.3f);
}
__device__ __forceinline__ void chk_up(const Params& p, int id0) {
  PH_BEGIN
  const int s = GID; if (s >= 512) return;
  const int row = hsh(s * 2 + id0 * 7919) % 6144, c0 = hsh(s * 2 + 1 + id0 * 7919);
  const float qs = 0.07216878364870323f * 1.4426950408889634f;
  int col = c0 % 1536;
  const bf16_t* qn = (const bf16_t*)(ws_ + OFF_QN) + (size_t)row * 384;
  float d = dotA(qn, p.in[36] + col, 1536, 384) * qs;
  const int r = col % 192 - 128;
  if (r >= 0 && row >= 4096) d = rope_ref(d, dotA(qn, p.in[36] + (col ^ 16), 1536, 384) * qs, r, (row - 4096) & 1023);
  rep(p, id0, b2f(((const bf16_t*)(ws_ + OFF_Q))[(size_t)row * 1536 + col]), d, 0.03f);
  const int kr = hsh(s + 1234567) % 6656; col = c0 & 1023;
  const bf16_t* ck = (const bf16_t*)(ws_ + OFF_CKVALL) + (size_t)kr * 256;
  rep(p, id0 + 1, b2f(((const bf16_t*)(ws_ + OFF_KN))[(size_t)kr * 1024 + col]), dotA(ck, p.in[39] + col, 1024, 256), 0.3f);
  const bf16_t* VT = (const bf16_t*)(ws_ + OFF_VT);
  size_t vi;
  if (kr < 4096) vi = (size_t)(kr >> 8) * 262144 + (size_t)col * 256 + (kr & 255);
  else { const int rr = kr - 4096, s2 = rr / 1280; vi = 4194304 + (size_t)s2 * 1310720 + (size_t)col * 1280 + (rr - s2 * 1280); }
  rep(p, id0 + 2, b2f(VT[vi]), dotA(ck, p.in[40] + col, 1024, 256), 0.3f);
}
__device__ __forceinline__ void chk_attn(const Params& p, int id) {
  PH_BEGIN
  const int s = GID; if (s >= 128) return;
  const int row = hsh(s * 2 + id * 7919) % 6144, c0 = hsh(s * 2 + 1 + id * 7919), h = c0 & 7, dv = (c0 >> 3) & 127;
  int kb, nk; const bf16_t* vt;
  const bf16_t* VT = (const bf16_t*)(ws_ + OFF_VT);
  if (row < 4096) { kb = row & ~255; nk = 256; vt = VT + (size_t)(row >> 8) * 262144 + (size_t)(h * 128 + dv) * 256; }
  else { const int s2 = (row - 4096) >> 10; kb = 4096 + s2 * 1280; nk = 1280; vt = VT + 4194304 + (size_t)s2 * 1310720 + (size_t)(h * 128 + dv) * 1280; }
  const bf16_t* q = (const bf16_t*)(ws_ + OFF_Q) + (size_t)row * 1536 + h * 192;
  const bf16_t* KN = (const bf16_t*)(ws_ + OFF_KN); const bf16_t* KR = (const bf16_t*)(ws_ + OFF_KRALL);
  float m = -1e30f, l = 0.f, o = 0.f;
  for (int j = 0; j < nk; ++j) {
    float sc = 0.f;
    for (int d = 0; d < 128; ++d) sc += b2f(q[d]) * b2f(KN[(size_t)(kb + j) * 1024 + h * 128 + d]);
    for (int d = 0; d < 64; ++d) sc += b2f(q[128 + d]) * b2f(KR[(size_t)(kb + j) * 64 + d]);
    const float mn = fmaxf(m, sc), al = exp2f(m - mn), pj = exp2f(sc - mn);
    l = l * al + pj; o = o * al + pj * b2f(vt[j]); m = mn;
  }
  rep(p, id, b2f(((const bf16_t*)(ws_ + OFF_H))[(size_t)row * 1024 + h * 128 + dv]), o / l, 0.03f);
}
__device__ __forceinline__ void chk_yt(const Params& p, int id) {
  PH_BEGIN
  const int s = GID; if (s >= 512) return;
  const int row = hsh(s * 2 + id * 7919) % 6144, col = hsh(s * 2 + 1 + id * 7919) & 1023, half = s & 1;
  const int s0 = seq_start(row), n = seq_len(row), pos = row - s0, g = col >> 7, cp = col & 127;
  const bf16_t* H = (const bf16_t*)(ws_ + OFF_H);
  float acc = 0.f;
  for (int c = 0; c < 128; ++c) { const float b = (float)((c * cp) & 127) / 128.f; acc += b2f(H[(size_t)row * 1024 + g * 128 + c]) * (half ? sinf(6.283185307179586f * b) : cosf(6.283185307179586f * b)); }
  const bf16_t* YT = (const bf16_t*)(ws_ + OFF_YT);
  const bf16_t* base = row < 4096 ? YT + (size_t)(row >> 8) * (1024 * 512) : YT + (size_t)16 * 1024 * 512 + (size_t)((row - 4096) >> 10) * (1024 * 2048);
  rep(p, id, b2f(base[(size_t)col * (2 * n) + half * n + pos]), acc / sqrtf(128.f), 0.3f);
}
__device__ __forceinline__ void chk_tab(const Params& p) {
  PH_BEGIN
  const int s = GID; if (s >= 2048) return;
  const unsigned hh = hsh(s * 3 + 11);
  { const int np = hh & 255, c = (hh >> 8) & 127, half = np >> 7, cp = np & 127; const float b = (float)((c * cp) & 127) / 128.f * 6.283185307179586f;
    rep(p, 45, b2f(((const bf16_t*)(ws_ + OFF_DFTC))[np * 128 + c]), (half ? sinf(b) : cosf(b)) / sqrtf(128.f), 0.02f); }
  { const int np = hh & 255, c = (hh >> 8) & 511, half = c >> 8, pos = c & 255; const float b = (float)((pos * np) & 255) / 256.f * 6.283185307179586f;
    rep(p, 46, b2f(((const bf16_t*)(ws_ + OFF_DFTP256))[np * 512 + c]), (half ? -sinf(b) : cosf(b)) / 16.f, 0.01f); }
  { const int np = hh & 1023, c = (hh >> 10) & 2047, half = c >> 10, pos = c & 1023; const float b = (float)((pos * np) & 1023) / 1024.f * 6.283185307179586f;
    rep(p, 47, b2f(((const bf16_t*)(ws_ + OFF_DFTP1024))[np * 2048 + c]), (half ? -sinf(b) : cosf(b)) / 32.f, 0.005f); }
}
#ifndef CHKMASK
#define CHKMASK 0x7F
#endif
#define CHK(grp, call) do { if (CHKMASK & (1 << (grp))) { call; GSYNC(); } } while (0)
#else
#define CHK(grp, call) do { } while (0)
#endif

__device__ __forceinline__ void phase_attn_blk(const Params& p, char* lds, int cidx = 1) {
  PH_BEGIN
  const int tid = tid_, lane = tid & 63, wid = tid >> 6, l15 = lane & 15, quad = lane >> 4;
  unsigned* ctr = (unsigned*)(ws_ + OFF_CTR) + cidx;
  const bf16_t* Q = (const bf16_t*)(ws_ + OFF_Q); const bf16_t* KN = (const bf16_t*)(ws_ + OFF_KN);
  const bf16_t* KR = (const bf16_t*)(ws_ + OFF_KRALL); const bf16_t* VT = (const bf16_t*)(ws_ + OFF_VT);
  bf16_t* OA = (bf16_t*)(ws_ + OFF_H);
  volatile int& s_item = *(volatile int*)(lds + 57344);
  for (;;) {
    if (tid == 0) s_item = (int)atomicAdd(ctr, 1u);
    __syncthreads();
    const int item = s_item;
    __syncthreads();
    if (item >= 768) break;
    int h, qrow0, nkeys, keybase;
    if (item < 256) { const int s2 = item >> 7; h = (item >> 4) & 7; qrow0 = 4096 + s2 * 1024 + (item & 15) * 64 + wid * 16; nkeys = 1280; keybase = 4096 + s2 * 1280; }
    else { const int j = item - 256, sq = j >> 5; h = (j >> 2) & 7; qrow0 = sq * 256 + (j & 3) * 64 + wid * 16; nkeys = 256; keybase = sq * 256; }
    bf16x8 qf[6];
#pragma unroll
    for (int ks = 0; ks < 6; ++ks) qf[ks] = *(const bf16x8*)(Q + (size_t)(qrow0 + l15) * 1536 + h * 192 + ks * 32 + quad * 8);
    f32x4 oacc[8];
#pragma unroll
    for (int i = 0; i < 8; ++i) oacc[i] = (f32x4){0.f, 0.f, 0.f, 0.f};
    float m = -1e30f, lsum = 0.f;
    const bf16_t* knp = KN + ((size_t)((keybase >> 4) * 8 + h) * 4 * 64 + lane) * 8;
    const bf16_t* krp = KR + ((size_t)((keybase >> 4) * 2) * 64 + lane) * 8;
    const bf16_t* vpp = VT + ((size_t)((keybase >> 5) * 8 + h) * 8 * 64 + lane) * 8;
    const bf16_t* pk0; const bf16_t* pk1; const bf16_t* pk2; int sk0, sk1, sk2;
    { const int pc = wid, kt = pc / 6, ks = pc - kt * 6; if (ks < 4) { pk0 = knp + (size_t)(kt * 32 + ks) * 512; sk0 = 64 * 512; } else { pk0 = krp + (size_t)(kt * 2 + ks - 4) * 512; sk0 = 4 * 512; } }
    { const int pc = wid + 4, kt = pc / 6, ks = pc - kt * 6; if (ks < 4) { pk1 = knp + (size_t)(kt * 32 + ks) * 512; sk1 = 64 * 512; } else { pk1 = krp + (size_t)(kt * 2 + ks - 4) * 512; sk1 = 4 * 512; } }
    { const int pc = wid + 8, kt = pc / 6, ks = pc - kt * 6; if (ks < 4) { pk2 = knp + (size_t)(kt * 32 + ks) * 512; sk2 = 64 * 512; } else { pk2 = krp + (size_t)(kt * 2 + ks - 4) * 512; sk2 = 4 * 512; } }
    const bf16_t* pv0 = vpp + (size_t)wid * 512; const bf16_t* pv1 = vpp + (size_t)(wid + 4) * 512;
    uint4 sa_, sb_, sc_, sd_, se_;
#define AB_GLOAD(c_) do { const size_t cc_ = (size_t)((c_) >> 5); sa_ = *(const uint4*)(pk0 + cc_ * sk0); sb_ = *(const uint4*)(pk1 + cc_ * sk1); sc_ = *(const uint4*)(pk2 + cc_ * sk2); \
      sd_ = *(const uint4*)(pv0 + cc_ * (64 * 512)); se_ = *(const uint4*)(pv1 + cc_ * (64 * 512)); } while (0)
#define AB_LSTORE(buf_) do { char* lb_ = lds + (buf_) * 20480 + lane * 16; *(uint4*)(lb_ + wid * 1024) = sa_; *(uint4*)(lb_ + (wid + 4) * 1024) = sb_; *(uint4*)(lb_ + (wid + 8) * 1024) = sc_; \
      *(uint4*)(lb_ + (wid + 12) * 1024) = sd_; *(uint4*)(lb_ + (wid + 16) * 1024) = se_; } while (0)
    AB_GLOAD(0); AB_LSTORE(0);
    __syncthreads();
    for (int c = 0; c < nkeys; c += 32) {
      const int buf = (c >> 5) & 1;
      if (c + 32 < nkeys) AB_GLOAD(c + 32);
      const char* cb = lds + buf * 20480 + lane * 16;
      f32x4 st[2];
      __builtin_amdgcn_s_setprio(1);
#pragma unroll
      for (int kt = 0; kt < 2; ++kt) {
        st[kt] = (f32x4){0.f, 0.f, 0.f, 0.f};
#pragma unroll
        for (int ks = 0; ks < 6; ++ks) st[kt] = __builtin_amdgcn_mfma_f32_16x16x32_bf16(*(const bf16x8*)(cb + (kt * 6 + ks) * 1024), qf[ks], st[kt], 0, 0, 0);
      }
      __builtin_amdgcn_s_setprio(0);
      float cm = fmaxf(fmaxf(fmaxf(st[0][0], st[0][1]), fmaxf(st[0][2], st[0][3])), fmaxf(fmaxf(st[1][0], st[1][1]), fmaxf(st[1][2], st[1][3])));
      cm = fmaxf(cm, __shfl_xor(cm, 16)); cm = fmaxf(cm, __shfl_xor(cm, 32));
      const float mn = fmaxf(m, cm), alpha = exp2f(m - mn);
      m = mn;
      float pv[8], ps = 0.f;
#pragma unroll
      for (int e = 0; e < 8; ++e) { pv[e] = exp2f(st[e >> 2][e & 3] - mn); ps += pv[e]; }
      lsum = lsum * alpha + ps;
      union { bf16x8 v; unsigned u[4]; } pb;
      pb.u[0] = pack2(pv[0], pv[1]); pb.u[1] = pack2(pv[2], pv[3]); pb.u[2] = pack2(pv[4], pv[5]); pb.u[3] = pack2(pv[6], pv[7]);
#pragma unroll
      for (int dvt = 0; dvt < 8; ++dvt) oacc[dvt] = __builtin_amdgcn_mfma_f32_16x16x32_bf16(*(const bf16x8*)(cb + (12 + dvt) * 1024), pb.v, oacc[dvt] * alpha, 0, 0, 0);
      if (c + 32 < nkeys) AB_LSTORE(buf ^ 1);
      __syncthreads();
    }
    lsum += __shfl_xor(lsum, 16); lsum += __shfl_xor(lsum, 32);
    const float il = 1.f / lsum;
#pragma unroll
    for (int dvt = 0; dvt < 8; ++dvt) {
      const f32x4 o = oacc[dvt] * il;
      *(uint2*)(OA + (size_t)(qrow0 + l15) * 1024 + h * 128 + dvt * 16 + quad * 4) = make_uint2(pack2(o[0], o[1]), pack2(o[2], o[3]));
    }
  }
}

#define XB_TMO      128
#define XB_XCNT(j)  (256  + 64 * (j))
#define XB_XSUB(j)  (1280 + 64 * (j))
#define XB_XGEN(j)  (2304 + 64 * (j))
#define XB_TOP      3328
#define XB_TOPGEN   3392
#define XCD_BAR_WORDS 3456
#define XB_SPIN_CAP (1u << 20)
#define LAS __attribute__((address_space(3)))
__device__ __forceinline__ unsigned xb_ld(unsigned* p)              { return __hip_atomic_load(p, __ATOMIC_RELAXED, __HIP_MEMORY_SCOPE_AGENT); }
__device__ __forceinline__ unsigned xb_add(unsigned* p, unsigned v) { return __hip_atomic_fetch_add(p, v, __ATOMIC_RELAXED, __HIP_MEMORY_SCOPE_AGENT); }
__device__ __forceinline__ unsigned xb_xcc_id() { return (unsigned)__builtin_amdgcn_s_getreg((3 << 11) | 20) & 0xFu; }
#define XB_SPIN(cond, bar) do { unsigned _sp = 0; while (cond) { __builtin_amdgcn_s_sleep(1); \
    if ((++_sp & 255u) == 0u) { if (xb_ld(&(bar)[XB_TMO])) break; if (_sp > XB_SPIN_CAP) { atomicAdd(&(bar)[XB_TMO], 1u); break; } } } } while (0)
struct XcdBarrier { unsigned* bar; unsigned x; volatile LAS unsigned* st; };
__device__ __forceinline__ XcdBarrier xcd_barrier_post(unsigned* bar, volatile LAS unsigned* st) {
    XcdBarrier b; b.bar = bar; b.x = xb_xcc_id(); b.st = st;
    if (threadIdx.x == 0) (void)xb_add(&bar[XB_XCNT(b.x)], 1u);
    return b;
}
__device__ __forceinline__ void xcd_barrier_complete(unsigned* bar, unsigned x, unsigned& nloc, unsigned& nx) {
    const unsigned G = gridDim.x * gridDim.y * gridDim.z;
    unsigned sum, cnt, mine, sp = 0u;
    for (;;) {
        sum = 0u; cnt = 0u; mine = 0u;
#pragma unroll
        for (unsigned j = 0; j < 16; ++j) { const unsigned c = xb_ld(&bar[XB_XCNT(j)]); sum += c; cnt += (c > 0u) ? 1u : 0u; mine = (j == x) ? c : mine; }
        if (sum == G) break;
        __builtin_amdgcn_s_sleep(1);
        if ((++sp & 255u) == 0u) { if (xb_ld(&bar[XB_TMO])) break; if (sp > XB_SPIN_CAP) { atomicAdd(&bar[XB_TMO], 1u); break; } }
    }
    nloc = mine > 0u ? mine : 1u; nx = cnt > 0u ? cnt : 1u;
}
__device__ __forceinline__ void xcd_barrier(const XcdBarrier& b) {
    asm volatile("s_waitcnt vmcnt(0)" ::: "memory");
    __syncthreads();
    if (threadIdx.x == 0) {
        unsigned* bar = b.bar;
        __builtin_amdgcn_s_waitcnt(0);
        unsigned nloc = b.st[0], nx = b.st[1];
        if (nloc == 0u) { xcd_barrier_complete(bar, b.x, nloc, nx); b.st[0] = nloc; b.st[1] = nx; }
        const unsigned old = xb_add(&bar[XB_XSUB(b.x)], 1u);
        const unsigned gen = old / nloc;
        if (old + 1u == (gen + 1u) * nloc) {
            __builtin_amdgcn_fence(__ATOMIC_RELEASE, "agent");
            asm volatile("s_waitcnt vmcnt(0)" ::: "memory");
            const unsigned og = xb_add(&bar[XB_TOP], 1u);
            const unsigned tg = og / nx;
            if (og + 1u == (tg + 1u) * nx) xb_add(&bar[XB_TOPGEN], 1u);
            else XB_SPIN(xb_ld(&bar[XB_TOPGEN]) == tg, bar);
            __builtin_amdgcn_fence(__ATOMIC_ACQUIRE, "agent");
            xb_add(&bar[XB_XGEN(b.x)], 1u);
            asm volatile("s_waitcnt vmcnt(0)" ::: "memory");
        } else {
            XB_SPIN(xb_ld(&bar[XB_XGEN(b.x)]) == gen, bar);
            __builtin_amdgcn_fence(__ATOMIC_ACQUIRE, "agent");
            asm volatile("s_waitcnt vmcnt(0)" ::: "memory");
        }
    }
    __syncthreads();
}

#ifndef PH_LO
#define PH_LO 0
#endif
#ifndef PH_HI
#define PH_HI 1000
#endif
__global__ void __launch_bounds__(256, 2) mega(Params p) {
  __shared__ __attribute__((aligned(16))) char lds[65536];
  cg::grid_group grid = cg::this_grid();
  __shared__ uint4 xb_words;
  if (threadIdx.x == 0) xb_words = make_uint4(0u, 0u, 0u, 0u);
  __syncthreads();
  const XcdBarrier xb = xcd_barrier_post((unsigned*)(p.ws + OFF_BAR), (volatile LAS unsigned*)&xb_words);
  if (p.out == nullptr) grid.sync();
#define GSYNC() xcd_barrier(xb)
#ifdef CLKPROBE
  unsigned long long ck0 = __builtin_readcyclecounter(), rt0 = wall_clock64();
#endif
  char* ws = p.ws;
  bf16_t* H = (bf16_t*)(ws + OFF_H);
  float* O = (float*)(ws + OFF_O);
  bf16_t* HID = (bf16_t*)(ws + OFF_HID);
#define DUPMASK 0
#define REP(bit, call) do { call; GSYNC(); if (DUPMASK & (bit)) { call; GSYNC(); } } while (0)
#define REP2(bit, call, call2) do { call; GSYNC(); if (DUPMASK & (bit)) { call2; GSYNC(); } } while (0)
#ifdef CLKPROBE
  phase_prep_a(p, lds); GSYNC();
  const unsigned long long rtA = wall_clock64();
  phase_prep_b(p, lds); GSYNC();
  const unsigned long long rtB = wall_clock64();
#else
  phase_prep_a(p, lds);
  REP(1, phase_prep_b(p, lds));
#endif
  CHK(0, chk_modv(p));
  CHK(0, chk_tab(p));
  REP(32, phase_row(p, true, false, 0, 0, 0, true, 0, 0, 0, true));
  CHK(0, chk_h(p, 1, 0, 0, 0));
  if (DUPMASK & 64) { for (int i = 0; i < 35; ++i) GSYNC(); }
#pragma unroll
  for (int l = 0; l < 4; ++l) {
    if (l == 0) {
      REP(4, phase_chan_dft(p, lds));
      CHK(1, chk_yt(p, 44));
      REP(4, phase_pos_dft(p, lds));
      CHK(1, chk_fft(p, 2));
      REP(4, phase_gemm_f32_m96((const bf16_t*)(ws + OFF_F), 1024, (const bf16_t*)(ws + OFF_FFTWT), 1024, 1024, O, lds));
      CHK(2, chk_o(p, 3, (const bf16_t*)(ws + OFF_F), 1024, p.in[12]));
    } else if (l == 1) {
      REP(4, phase_gemm_bf16_m96(H, 1024, (const bf16_t*)(ws + OFF_CINT), 1024, 1024, 24, (bf16_t*)(ws + OFF_BCU), 3072, lds));
      CHK(3, chk_bcu(p, 8));
      REP(32, phase_conv_elt(p));
      CHK(3, chk_a2(p, 9));
      REP(4, phase_gemm_f32_m96((const bf16_t*)(ws + OFF_A2), 1024, (const bf16_t*)(ws + OFF_COUTT), 1024, 1024, O, lds));
      CHK(2, chk_o(p, 10, (const bf16_t*)(ws + OFF_A2), 1024, p.in[15]));
    } else if (l == 2) {
      REP(32, phase_rwkv_mix(p));
      CHK(4, chk_xm(p, 14));
      REP(4, phase_rwkv_gemm1(p, lds));
      CHK(4, chk_rw1(p, 15));
      REP(4, phase_rwkv_gemm2(p, lds));
      CHK(4, chk_rw2(p, 20));
      REP2(8, phase_scan(p, lds, 0), phase_scan(p, lds, 2));
      CHK(5, chk_scan(p, 24));
      REP(32, phase_postscan(p));
      CHK(6, chk_z(p, 26));
      REP(4, phase_gemm_f32_m96(H, 1024, (const bf16_t*)(ws + OFF_RWOT), 1024, 1024, O, lds));
      CHK(2, chk_o(p, 27, H, 1024, p.in[20]));
    } else {
      REP(4, phase_gemm_f32(H, 1024, (const bf16_t*)(ws + OFF_MDQKVT), 1024, 1024, 48, 6, (float*)(ws + OFF_QC), 704, 704, lds));
      CHK(7, chk_qc(p, 32));
      REP(32, phase_mla_rows(p));
      CHK(7, chk_mlarows(p, 33));
      REP(4, phase_mla_up(p, lds));
      CHK(7, chk_up(p, 36));
      REP2(16, phase_attn_blk(p, lds, 1), phase_attn_blk(p, lds, 3));
      CHK(8, chk_attn(p, 39));
      REP(4, phase_gemm_f32_m96(H, 1024, (const bf16_t*)(ws + OFF_MOT), 1024, 1024, O, lds));
      CHK(2, chk_o(p, 40, H, 1024, p.in[41]));
    }
    REP2(32, phase_row(p, l == 0, DBG_MIXER_UPD, l, 2, 1, true, l, 2, 3), phase_row(p, false, false, l, 2, 1, true, l, 2, 3));
    CHK(0, chk_h(p, l == 0 ? 4 : (l == 1 ? 11 : (l == 2 ? 28 : 41)), l, 2, 3));
    REP(2, phase_gemm_bf16<1>(H, 1024, (const bf16_t*)(ws + OFF_W1T) + (size_t)l * 4096 * 1024, 1024, 1024, 48, 32, HID, 4096, lds));
    CHK(2, chk_hid(p, l == 0 ? 5 : (l == 1 ? 12 : (l == 2 ? 29 : 42)), l));
    REP(2, phase_gemm_f32_m96(HID, 4096, (const bf16_t*)(ws + OFF_W2T) + (size_t)l * 4096 * 1024, 4096, 4096, O, lds));
    CHK(2, chk_o(p, l == 0 ? 6 : (l == 1 ? 13 : (l == 2 ? 30 : 43)), HID, 4096, p.in[11] + (size_t)l * 4096 * 1024));
    phase_row(p, false, true, l, 5, 3, l < 3 && l != 1, l + 1, 0, 0);
    if (l < 3) GSYNC();
    if (l == 0 || l == 2) CHK(0, chk_h(p, l == 0 ? 7 : 31, l + 1, 0, 0));
  }
#ifdef CLKPROBE
  GSYNC();
  if (blockIdx.x == 0 && threadIdx.x == 0) { const unsigned long long ck1 = __builtin_readcyclecounter(), rt1 = wall_clock64(); p.out[0] += (float)(rtB - rtA) * 0.001f; (void)ck1; (void)rt1; (void)ck0; (void)rt0; }
#endif
#ifdef SELFCHECK
  GSYNC();
  for (size_t i = (size_t)blockIdx.x * 256 + threadIdx.x; i < 9699328; i += (size_t)gridDim.x * 256) { const float v = p.out[i]; if (!(fabsf(v) < 1e30f)) p.out[i] = 0.f; }
  GSYNC();
  if (blockIdx.x == 0 && threadIdx.x == 0) {
    const unsigned* errs = (const unsigned*)(ws + OFF_CTR) + 8;
    if (__uint_as_float(errs[45]) > SC_TOL) p.out[0] = 46000.f; else if (__uint_as_float(errs[46]) > SC_TOL) p.out[0] = 47000.f; else if (__uint_as_float(errs[47]) > SC_TOL) p.out[0] = 48000.f; else if (__uint_as_float(errs[44]) > SC_TOL) p.out[0] = 45000.f; else
    for (int id = 0; id < 48; ++id) if (!((SKIPMASK >> id) & 1ull) && __uint_as_float(errs[id]) > SC_TOL) { p.out[0] = 1000.f * (id + 1); break; }
  }
#endif
}

extern "C" void kernel_launch(void* const* d_in, const int* in_sizes, int n_in, void* d_out, int out_size, void* d_ws, size_t ws_size, hipStream_t stream) {
  static int grid_blocks = 0;
  if (!grid_blocks) {
    int dev = 0, cus = 0, per_cu = 0;
    (void)hipGetDevice(&dev);
    (void)hipDeviceGetAttribute(&cus, hipDeviceAttributeMultiprocessorCount, dev);
    (void)hipOccupancyMaxActiveBlocksPerMultiprocessor(&per_cu, mega, 256, 0);
    if (per_cu > 2) per_cu = 2;
    if (per_cu < 1) per_cu = 1;
    grid_blocks = cus * per_cu;
  }
  if (ws_size < WS_TOTAL) { fprintf(stderr, "workspace too small: %zu < %zu\n", ws_size, (size_t)WS_TOTAL); return; }
  Params p{};
  for (int i = 0; i < 42; ++i) p.in[i] = (const float*)d_in[i];
  p.out = (float*)d_out; p.ws = (char*)d_ws;
  (void)hipMemsetAsync((char*)d_ws + OFF_CTR, 0, 256 + 3456 * 4 + 256, stream);
  void* args[] = {&p};
  hipError_t e = hipLaunchCooperativeKernel((void*)mega, dim3(grid_blocks), dim3(256), args, 0, stream);
  if (e != hipSuccess) fprintf(stderr, "cooperative launch failed: %s (grid %d)\n", hipGetErrorString(e), grid_blocks);
}
```
